# Optimizing an MI355X kernel written in HIP

```python
import math
import jax, jax.numpy as jnp
from jax import lax
import numpy as np

D_MODEL = 4096
BATCH = 4
SEQ = 4096
DEPTH = 2
DEC_BATCH = 16
DEC_SEQ = 32
PAST_LEN = 2048

CHUNK = 64
N_MIXERS = 2
N_A = (DEPTH + 1) // 2
N_B = DEPTH // 2
MLSTM_PF = 2
INNER = MLSTM_PF * D_MODEL
N_HEADS = 8
DK = INNER // N_HEADS
DV = INNER // N_HEADS
QKV_BLOCK = 4
N_QKV_BLOCKS = INNER // QKV_BLOCK
MCONV_W = 4
CONV_CH = D_MODEL
CONV_W = 31
ALPHA = (2 * DEPTH) ** 0.25
BETA = (8 * DEPTH) ** -0.25
LN_EPS = 1e-5

kernel_name = "mlstm_conformer_conv_stream_step"


def _layernorm(x, g, b=None):
    xf = x.astype(jnp.float32)
    mu = jnp.mean(xf, axis=-1, keepdims=True)
    var = jnp.mean(jnp.square(xf - mu), axis=-1, keepdims=True)
    y = (xf - mu) * lax.rsqrt(var + LN_EPS) * g.astype(jnp.float32)
    if b is not None:
        y = y + b.astype(jnp.float32)
    return y.astype(x.dtype)


def _causal_dwconv(x, hist, w, b):
    W = w.shape[0]
    T = x.shape[1]
    xp = jnp.concatenate([hist.astype(x.dtype), x], axis=1)
    wc = w.astype(x.dtype)
    y = sum(xp[:, j:j + T] * wc[j] for j in range(W))
    return y + b.astype(x.dtype), xp[:, xp.shape[1] - (W - 1):]


def _headwise(x, w):
    B, T, _ = x.shape
    xb = x.reshape(B, T, N_QKV_BLOCKS, QKV_BLOCK)
    return jnp.einsum('btnd,nde->btne', xb, w.astype(x.dtype)).reshape(B, T, INNER)


def _mlstm_cell(q, k, v, ig, lf, C0, n0, m0):
    B, H, T, _ = q.shape
    L = min(CHUNK, T)
    NC = T // L

    def to_chunks(a):
        return jnp.moveaxis(a.reshape(a.shape[:2] + (NC, L) + a.shape[3:]), 2, 0)

    causal = jnp.tril(jnp.ones((L, L), dtype=bool))

    def step(carry, inp):
        C, n, m = carry
        qc, kc, vc, ic, fc = inp
        b = jnp.cumsum(fc, axis=-1)
        logD = jnp.where(causal, b[..., :, None] - b[..., None, :] + ic[..., None, :], -jnp.inf)
        g = b + m[..., None]
        m_t = jnp.maximum(g, jnp.max(logD, axis=-1))
        Dm = jnp.exp(logD - m_t[..., None])
        inter = jnp.exp(g - m_t)
        S = jnp.einsum('bhtd,bhsd->bhts', qc, kc) * Dm
        num = jnp.einsum('bhts,bhsv->bhtv', S, vc) + inter[..., None] * jnp.einsum('bhtd,bhdv->bhtv', qc, C)
        den = jnp.sum(S, axis=-1) + inter * jnp.einsum('bhtd,bhd->bht', qc, n)
        h = num / jnp.maximum(jnp.abs(den), jnp.exp(-m_t))[..., None]
        bL = b[..., -1]
        logw = bL[..., None] - b + ic
        decay = bL + m
        m_new = jnp.maximum(decay, jnp.max(logw, axis=-1))
        wk = kc * jnp.exp(logw - m_new[..., None])[..., None]
        sc = jnp.exp(decay - m_new)
        C_new = sc[..., None, None] * C + jnp.einsum('bhsd,bhsv->bhdv', wk, vc)
        n_new = sc[..., None] * n + jnp.sum(wk, axis=2)
        return (C_new, n_new, m_new), h

    (C, n, m), hs = lax.scan(step, (C0, n0, m0), tuple(map(to_chunks, (q, k, v, ig, lf))))
    h = jnp.moveaxis(hs, 0, 2).reshape(B, H, T, DV)
    return h, C, n, m


def _mlstm_mixer(x, C0, n0, m0, hist, w_up, w_mconv, b_mconv, w_q, w_k, w_v, w_gate, b_gate, mh_gain, skip, w_down):
    B, T, _ = x.shape
    f32 = jnp.float32
    up = x @ w_up.astype(x.dtype)
    xm, z = jnp.split(up, 2, axis=-1)
    xc, hist_new = _causal_dwconv(xm, hist, w_mconv, b_mconv)
    xa = jax.nn.silu(xc)
    q = _headwise(xa, w_q)
    k = _headwise(xa, w_k)
    v = _headwise(xm, w_v)
    wg = w_gate.astype(x.dtype)
    gates = (q @ wg[0] + k @ wg[1] + v @ wg[2]).astype(f32) + b_gate.astype(f32)
    ig = jnp.transpose(gates[..., :N_HEADS], (0, 2, 1))
    lf = jnp.transpose(jax.nn.log_sigmoid(gates[..., N_HEADS:]), (0, 2, 1))

    def heads(a):
        return a.reshape(B, T, N_HEADS, -1).transpose(0, 2, 1, 3).astype(f32)

    h, C, n, m = _mlstm_cell(heads(q), heads(k) * (DK ** -0.5), heads(v), ig, lf,
                             C0.astype(f32), n0.astype(f32), m0.astype(f32))
    hn = _layernorm(h, mh_gain.reshape(N_HEADS, 1, DV))
    hn = hn.transpose(0, 2, 1, 3).reshape(B, T, INNER).astype(x.dtype)
    out = ((hn + skip.astype(x.dtype) * xa) * jax.nn.silu(z)) @ w_down.astype(x.dtype)
    return out, C, n, m, hist_new


def _conv_mixer(x, hist, w_cin, b_cin, w_dw, b_dw, cln_g, cln_b, w_cout, b_cout):
    proj = x @ w_cin.astype(x.dtype) + b_cin.astype(x.dtype)
    a, gl, zg = jnp.split(proj, 3, axis=-1)
    u = a * jax.nn.sigmoid(gl)
    c, hist_new = _causal_dwconv(u, hist, w_dw, b_dw)
    c = jax.nn.silu(_layernorm(c, cln_g, cln_b))
    out = (c * jax.nn.silu(zg)) @ w_cout.astype(x.dtype) + b_cout.astype(x.dtype)
    return out, hist_new


def _trunk(x, st_C, st_n, st_m, st_mconv, st_cconv,
           w_up, w_mconv, b_mconv, w_q, w_k, w_v, w_gate, b_gate, mh_gain, skip, w_down,
           w_cin, b_cin, w_dw, b_dw, cln_g, cln_b, w_cout, b_cout, post_ln_g, post_ln_b):
    Cs, ns, ms, mcs, ccs = [], [], [], [], []
    for i in range(DEPTH):
        j = i // N_MIXERS
        if i % N_MIXERS == 0:
            out, C, n, m, hc = _mlstm_mixer(x, st_C[j], st_n[j], st_m[j], st_mconv[j],
                                            w_up[j], w_mconv[j], b_mconv[j], w_q[j], w_k[j], w_v[j],
                                            w_gate[j], b_gate[j], mh_gain[j], skip[j], w_down[j])
            Cs.append(C); ns.append(n); ms.append(m); mcs.append(hc)
        else:
            out, hc = _conv_mixer(x, st_cconv[j], w_cin[j], b_cin[j], w_dw[j], b_dw[j],
                                  cln_g[j], cln_b[j], w_cout[j], b_cout[j])
            ccs.append(hc)
        x = _layernorm(ALPHA * x + out, post_ln_g[i], post_ln_b[i])
    dt = x.dtype
    return (x, jnp.stack(Cs).astype(dt), jnp.stack(ns).astype(dt), jnp.stack(ms).astype(dt),
            jnp.stack(mcs).astype(dt), jnp.stack(ccs).astype(dt))


def setup_inputs(seed: int = 0) -> dict:
    key = jax.random.key(seed)
    ks = jax.random.split(key, 32)
    nrm = jax.random.normal
    f = jnp.float32
    b_gate = jnp.concatenate([
        0.1 * nrm(ks[10], (N_A, N_HEADS), f),
        jnp.broadcast_to(jnp.linspace(3.0, 6.0, N_HEADS, dtype=f), (N_A, N_HEADS)) + 0.01 * nrm(ks[11], (N_A, N_HEADS), f),
    ], axis=-1)
    return {
        "x_prompt": nrm(ks[0], (BATCH, SEQ, D_MODEL), f),
        "x_sample": nrm(ks[1], (DEC_BATCH, DEC_SEQ, D_MODEL), f),
        "state_mlstm_C": 0.02 * nrm(ks[2], (N_A, DEC_BATCH, N_HEADS, DK, DV), f),
        "state_mlstm_n": 0.02 * nrm(ks[3], (N_A, DEC_BATCH, N_HEADS, DK), f),
        "state_mlstm_m": nrm(ks[4], (N_A, DEC_BATCH, N_HEADS), f),
        "state_mlstm_conv": nrm(ks[5], (N_A, DEC_BATCH, MCONV_W - 1, INNER), f),
        "state_conformer_conv": 0.5 * nrm(ks[6], (N_B, DEC_BATCH, CONV_W - 1, CONV_CH), f),
        "w_up": nrm(ks[7], (N_A, D_MODEL, 2 * INNER), f) * D_MODEL ** -0.5,
        "w_mconv": nrm(ks[8], (N_A, MCONV_W, INNER), f) * MCONV_W ** -0.5,
        "b_mconv": 0.01 * nrm(ks[9], (N_A, INNER), f),
        "w_q": nrm(ks[12], (N_A, N_QKV_BLOCKS, QKV_BLOCK, QKV_BLOCK), f) * QKV_BLOCK ** -0.5,
        "w_k": nrm(ks[13], (N_A, N_QKV_BLOCKS, QKV_BLOCK, QKV_BLOCK), f) * QKV_BLOCK ** -0.5,
        "w_v": nrm(ks[14], (N_A, N_QKV_BLOCKS, QKV_BLOCK, QKV_BLOCK), f) * QKV_BLOCK ** -0.5,
        "w_gate": nrm(ks[15], (N_A, 3, INNER, 2 * N_HEADS), f) * (0.1 * (3 * INNER) ** -0.5),
        "b_gate": b_gate,
        "mh_gain": 1.0 + 0.01 * nrm(ks[16], (N_A, INNER), f),
        "skip": 1.0 + 0.01 * nrm(ks[17], (N_A, INNER), f),
        "w_down": nrm(ks[18], (N_A, INNER, D_MODEL), f) * (INNER ** -0.5 * BETA),
        "w_cin": nrm(ks[19], (N_B, D_MODEL, 3 * CONV_CH), f) * D_MODEL ** -0.5,
        "b_cin": 0.01 * nrm(ks[20], (N_B, 3 * CONV_CH), f),
        "w_dw": nrm(ks[21], (N_B, CONV_W, CONV_CH), f) * CONV_W ** -0.5,
        "b_dw": 0.01 * nrm(ks[22], (N_B, CONV_CH), f),
        "cln_g": 1.0 + 0.01 * nrm(ks[23], (N_B, CONV_CH), f),
        "cln_b": 0.01 * nrm(ks[24], (N_B, CONV_CH), f),
        "w_cout": nrm(ks[25], (N_B, CONV_CH, D_MODEL), f) * (CONV_CH ** -0.5 * BETA),
        "b_cout": 0.01 * nrm(ks[26], (N_B, D_MODEL), f),
        "post_ln_g": 1.0 + 0.01 * nrm(ks[27], (DEPTH, D_MODEL), f),
        "post_ln_b": 0.01 * nrm(ks[28], (DEPTH, D_MODEL), f),
    }


def reference(x_prompt, x_sample, state_mlstm_C, state_mlstm_n, state_mlstm_m, state_mlstm_conv, state_conformer_conv,
              w_up, w_mconv, b_mconv, w_q, w_k, w_v, w_gate, b_gate, mh_gain, skip, w_down,
              w_cin, b_cin, w_dw, b_dw, cln_g, cln_b, w_cout, b_cout, post_ln_g, post_ln_b):
    params = (w_up, w_mconv, b_mconv, w_q, w_k, w_v, w_gate, b_gate, mh_gain, skip, w_down,
              w_cin, b_cin, w_dw, b_dw, cln_g, cln_b, w_cout, b_cout, post_ln_g, post_ln_b)
    B = x_prompt.shape[0]
    f32 = jnp.float32
    z_C = jnp.zeros((N_A, B, N_HEADS, DK, DV), f32)
    z_n = jnp.zeros((N_A, B, N_HEADS, DK), f32)
    z_m = jnp.zeros((N_A, B, N_HEADS), f32)
    z_mc = jnp.zeros((N_A, B, MCONV_W - 1, INNER), x_prompt.dtype)
    z_cc = jnp.zeros((N_B, B, CONV_W - 1, CONV_CH), x_prompt.dtype)
    y_prompt, p_C, p_n, p_m, p_mc, p_cc = _trunk(x_prompt, z_C, z_n, z_m, z_mc, z_cc, *params)
    y_sample, s_C, s_n, s_m, s_mc, s_cc = _trunk(x_sample, state_mlstm_C, state_mlstm_n, state_mlstm_m,
                                                 state_mlstm_conv, state_conformer_conv, *params)
    return (y_prompt, y_sample, p_C, p_n, p_m, p_mc, p_cc, s_C, s_n, s_m, s_mc, s_cc)
```

```cpp
#include <hip/hip_runtime.h>
#include <cstdio>
#include <cstdint>

#ifndef MK_LAUNCHES
#define MK_LAUNCHES 1
#endif

#define LAS __attribute__((address_space(3)))
typedef unsigned short bf16_t;
typedef short bf16x8 __attribute__((ext_vector_type(8)));
typedef float f32x4 __attribute__((ext_vector_type(4)));
typedef float f32x16 __attribute__((ext_vector_type(16)));
typedef unsigned u32x4 __attribute__((ext_vector_type(4)));
typedef unsigned u32x2 __attribute__((ext_vector_type(2)));
#define DI __device__ __forceinline__

constexpr int DM = 4096, INNER = 8192, NH = 8, DKV = 1024;
constexpr int TPP = 16384 + 64;
constexpr int TP = 16384, TS = 512, TT = TP + TS;
constexpr float ALPHA = 1.41421356237309515f, LN_EPS = 1e-5f;
constexpr int NWAVES = 8, NTHR = 512;

constexpr size_t O_YP = 0, O_YS = 67108864, O_PC = 69206016, O_PN = 102760448, O_PM = 102793216, O_PMC = 102793248, O_PCC = 102891552,
                 O_SC = 103383072, O_SN = 237600800, O_SM = 237731872, O_SMC = 237732000, O_SCC = 238125216, O_END = 240091296;

constexpr size_t MiB = 1u << 20;
constexpr size_t O8_Q8 = 0, O8_XA8 = (size_t)TP * INNER;
constexpr size_t WS_BAR = 0;
constexpr size_t WS_GATES = 64 * 1024;
constexpr size_t WS_DEN = WS_GATES + (size_t)TT * 16 * 4;
constexpr size_t WS_STATS = WS_DEN + (size_t)TP * 8 * 4;
constexpr size_t WS_RST0 = WS_STATS + (size_t)TT * 2 * 4, WS_RST1 = WS_RST0 + (size_t)TP * 2 * 4;
constexpr size_t WS_ZERO_BYTES = 3 * MiB;
static_assert(WS_RST1 + (size_t)TP * 2 * 4 <= WS_ZERO_BYTES, "zero region");
constexpr size_t WS_CS = 3 * MiB, WS_MX = WS_CS + 512 * 1024, WS_EM = WS_MX + 512 * 1024;
constexpr size_t WS_MXL = WS_EM + 512 * 1024;
constexpr size_t WS_GT = 5 * MiB;
constexpr size_t WS_WDOWN = 8 * MiB;
constexpr size_t WS_SZ = 72 * MiB;
constexpr size_t WS_XA = 336 * MiB;
constexpr size_t WS_QP = 600 * MiB;
constexpr size_t WS_KWT = 856 * MiB;
constexpr size_t WS_VT = 1113 * MiB;
constexpr size_t WS_XM = 1370 * MiB;
constexpr size_t WS_XB = 600 * MiB, WS_WUP = 732 * MiB, WS_H = 600 * MiB, WS_PRE = 864 * MiB, WS_S = 1370 * MiB, WS_R = 1392 * MiB;
constexpr size_t WS_WCIN = 1656 * MiB, WS_WCOUT = 1752 * MiB, WS_X1F = 72 * MiB, WS_X1B = 336 * MiB, WS_U = 468 * MiB, WS_SZG = 600 * MiB, WS_C = 732 * MiB,
                 WS_PRE2 = 864 * MiB, WS_R2 = 1128 * MiB;
constexpr size_t WS_XQ = 864 * MiB, WS_WZQ = 930 * MiB;
constexpr size_t WS_X1Q = 996 * MiB, WS_WCINQ = 1062 * MiB;
constexpr size_t WS_LNST = 88 * MiB;
constexpr size_t WS_PART = 1784 * MiB;
constexpr size_t WS_S8 = 1370 * MiB, WS_S16 = 1580 * MiB, WS_VT8 = 1704 * MiB;
constexpr size_t S8_BH = (size_t)105 * 65536, S16_BH = (size_t)31 * 131072;
constexpr int P8 = 16384 + 128;
constexpr size_t WS_SMALL = 1914 * MiB;
constexpr size_t WS_SSP = WS_SMALL;
constexpr size_t WS_SQT = WS_SMALL + 1 * MiB;
constexpr size_t WS_SWK = WS_SMALL + 9 * MiB;
constexpr size_t WS_SVT = WS_SMALL + 17 * MiB;
constexpr size_t WS_HS = WS_SMALL + 25 * MiB;
constexpr size_t WS_END = WS_SMALL + 33 * MiB;
static_assert(WS_S + 544 * MiB <= WS_SMALL && WS_END <= 2048 * MiB, "ws map");

typedef __bf16 bf16v2_t __attribute__((ext_vector_type(2)));
typedef float f32v2_t __attribute__((ext_vector_type(2)));
DI unsigned pk_bf16(float lo, float hi) { const f32v2_t f = {lo, hi}; const bf16v2_t t = __builtin_convertvector(f, bf16v2_t); return __builtin_bit_cast(unsigned, t); }
DI float bf_lo(unsigned u) { return __uint_as_float(u << 16); }
DI float bf_hi(unsigned u) { return __uint_as_float(u & 0xffff0000u); }
DI float bf1(bf16_t b) { return __uint_as_float((unsigned)b << 16); }
DI bf16_t f2bf(float f) { return (bf16_t)(pk_bf16(f, 0.f) & 0xffffu); }
DI void unpack8(const u32x4 v, float (&f)[8]) { f[0] = bf_lo(v.x); f[1] = bf_hi(v.x); f[2] = bf_lo(v.y); f[3] = bf_hi(v.y); f[4] = bf_lo(v.z); f[5] = bf_hi(v.z); f[6] = bf_lo(v.w); f[7] = bf_hi(v.w); }
DI u32x4 pack8(const float (&f)[8]) { u32x4 v; v.x = pk_bf16(f[0], f[1]); v.y = pk_bf16(f[2], f[3]); v.z = pk_bf16(f[4], f[5]); v.w = pk_bf16(f[6], f[7]); return v; }
constexpr float FP8_SA_PRE = 8.0f, FP8_SA_PRE2 = 16.0f, FP8_SB_W = 4096.0f, FP8_SA_X1 = 16.0f, FP8_SB_WCIN = 1024.0f, FP8_SA_X = 16.0f, FP8_SB_WZ = 1024.0f, FP8_SA_Q = 1024.0f, FP8_SA_XA = 16.0f, FP8_SA_S = 64.0f, FP8_SA_V = 16.0f;
DI unsigned pk_fp8x4(float a, float b, float c, float d) {
    a = fminf(fmaxf(a, -448.f), 448.f); b = fminf(fmaxf(b, -448.f), 448.f); c = fminf(fmaxf(c, -448.f), 448.f); d = fminf(fmaxf(d, -448.f), 448.f);
    int r = 0; r = __builtin_amdgcn_cvt_pk_fp8_f32(a, b, r, false); r = __builtin_amdgcn_cvt_pk_fp8_f32(c, d, r, true); return (unsigned)r; }
DI float fexp(float x) { return __builtin_amdgcn_exp2f(x * 1.44269504088896341f); }
DI float frcp(float x) { return __builtin_amdgcn_rcpf(x); }
DI float fsilu(float x) { return x * frcp(1.0f + fexp(-x)); }
DI float fsigm(float x) { return frcp(1.0f + fexp(-x)); }
DI float logsig(float x) { return fminf(x, 0.f) - log1pf(expf(-fabsf(x))); }
#define LDS_BARRIER() do { asm volatile("s_waitcnt lgkmcnt(0)" ::: "memory"); __builtin_amdgcn_s_barrier(); asm volatile("" ::: "memory"); } while (0)
DI int lane_id() { int l; asm volatile("v_mbcnt_lo_u32_b32 %0, -1, 0\n\tv_mbcnt_hi_u32_b32 %0, -1, %0" : "=v"(l)); return l; }
template <class T> DI T ld_nt(const T* p) { return __builtin_nontemporal_load(p); }
template <class T> DI void st_nt(T* p, const T v) { __builtin_nontemporal_store(v, p); }
DI float wave_sum(float v) {
#pragma unroll
    for (int o = 1; o < 64; o <<= 1) v += __shfl_xor(v, o);
    return v;
}

#define XB_TMO      128
#define XB_XCNT(j)  (256  + 64 * (j))
#define XB_XSUB(j)  (1280 + 64 * (j))
#define XB_XGEN(j)  (2304 + 64 * (j))
#define XB_TOP      3328
#define XB_TOPGEN   3392
#define XCD_BAR_WORDS 3456
#define XB_SPIN_CAP (1u << 22)
__device__ __forceinline__ unsigned xb_ld(unsigned* p)              { return __hip_atomic_load(p, __ATOMIC_RELAXED, __HIP_MEMORY_SCOPE_AGENT); }
__device__ __forceinline__ unsigned xb_add(unsigned* p, unsigned v) { return __hip_atomic_fetch_add(p, v, __ATOMIC_RELAXED, __HIP_MEMORY_SCOPE_AGENT); }
__device__ __forceinline__ unsigned xb_xcc_id() { return (unsigned)__builtin_amdgcn_s_getreg((3 << 11) | 20) & 0xFu; }
#define XB_SPIN(cond, bar) do { unsigned _sp = 0; while (cond) { __builtin_amdgcn_s_sleep(1); \
    if ((++_sp & 255u) == 0u) { if (xb_ld(&(bar)[XB_TMO])) break; if (_sp > XB_SPIN_CAP) { atomicAdd(&(bar)[XB_TMO], 1u); break; } } } } while (0)
struct XcdBarrier { unsigned* bar; unsigned x; volatile LAS unsigned* st; int wave; };
__device__ __forceinline__ XcdBarrier xcd_barrier_post(unsigned* bar, volatile LAS unsigned* st, int wave) {
    XcdBarrier b; b.bar = bar; b.x = xb_xcc_id(); b.st = st; b.wave = wave;
    if (wave == 0 && lane_id() == 0) (void)xb_add(&bar[XB_XCNT(b.x)], 1u);
    return b;
}
__device__ __forceinline__ void xcd_barrier_complete(unsigned* bar, unsigned x, unsigned& nloc, unsigned& nx) {
    const unsigned G = gridDim.x * gridDim.y * gridDim.z;
    unsigned sum, cnt, mine, sp = 0u;
    for (;;) {
        sum = 0u; cnt = 0u; mine = 0u;
#pragma unroll
        for (unsigned j = 0; j < 16; ++j) { const unsigned c = xb_ld(&bar[XB_XCNT(j)]); sum += c; cnt += (c > 0u) ? 1u : 0u; mine = (j == x) ? c : mine; }
        if (sum == G) break;
        __builtin_amdgcn_s_sleep(1);
        if ((++sp & 255u) == 0u) { if (xb_ld(&bar[XB_TMO])) break; if (sp > XB_SPIN_CAP) { atomicAdd(&bar[XB_TMO], 1u); break; } }
    }
    nloc = mine > 0u ? mine : 1u; nx = cnt > 0u ? cnt : 1u;
}
__device__ __forceinline__ void xcd_barrier(const XcdBarrier& b) {
    asm volatile("s_waitcnt vmcnt(0)" ::: "memory");
    __syncthreads();
    if (b.wave == 0 && lane_id() == 0) {
        unsigned* bar = b.bar;
        __builtin_amdgcn_s_waitcnt(0);
        unsigned nloc = b.st[0], nx = b.st[1];
        if (nloc == 0u) { xcd_barrier_complete(bar, b.x, nloc, nx); b.st[0] = nloc; b.st[1] = nx; }
        const unsigned old = xb_add(&bar[XB_XSUB(b.x)], 1u);
        const unsigned gen = old / nloc;
        if (old + 1u == (gen + 1u) * nloc) {
            __builtin_amdgcn_fence(__ATOMIC_RELEASE, "agent");
            asm volatile("s_waitcnt vmcnt(0)" ::: "memory");
            const unsigned og = xb_add(&bar[XB_TOP], 1u);
            const unsigned tg = og / nx;
            if (og + 1u == (tg + 1u) * nx) xb_add(&bar[XB_TOPGEN], 1u);
            else XB_SPIN(xb_ld(&bar[XB_TOPGEN]) == tg, bar);
            __builtin_amdgcn_fence(__ATOMIC_ACQUIRE, "agent");
            xb_add(&bar[XB_XGEN(b.x)], 1u);
            asm volatile("s_waitcnt vmcnt(0)" ::: "memory");
        } else {
            XB_SPIN(xb_ld(&bar[XB_XGEN(b.x)]) == gen, bar);
            __builtin_amdgcn_fence(__ATOMIC_ACQUIRE, "agent");
            asm volatile("s_waitcnt vmcnt(0)" ::: "memory");
        }
    }
    __syncthreads();
}

namespace g8 {
constexpr int BM = 256, BK = 64, HALF = 128, HTB = HALF * BK * 2, STAGE_BYTES = 8 * HTB, NXCD = 8, WGM = 8;
__host__ __device__ __forceinline__ int lds_byte(int r, int c) { const int st = (r >> 4) * 2 + (c >> 5), rr = r & 15, cc = c & 31, ob = rr * 64 + cc * 2; return st * 1024 + (ob ^ (((ob >> 9) & 1) << 5)); }
__host__ __device__ __forceinline__ void stage_rc(int b, int& R, int& C) { const int st = b / 1024, sb = b % 1024, swz = sb ^ (((sb >> 9) & 1) << 5); R = (st >> 1) * 16 + swz / 64; C = (st & 1) * 32 + (swz % 64) / 2; }
__host__ __device__ __forceinline__ int perm32(int rho) { const int n = rho >> 4, i = rho & 15; return 8 * (i >> 2) + 4 * n + (i & 3); }

typedef int i32x8 __attribute__((ext_vector_type(8)));
DI i32x8 cat8(const bf16x8 lo, const bf16x8 hi) { const u32x4 a = __builtin_bit_cast(u32x4, lo), b = __builtin_bit_cast(u32x4, hi); i32x8 r; r[0] = (int)a.x; r[1] = (int)a.y; r[2] = (int)a.z; r[3] = (int)a.w; r[4] = (int)b.x; r[5] = (int)b.y; r[6] = (int)b.z; r[7] = (int)b.w; return r; }
struct GUnit { const char* A; const char* B; int nt; int i0, i1, i2; };

struct DenseSched {
    int wave;
    const char* A; const char* B; size_t tstepA, tstepB; int nM, nN, nMf, ksp, G, c, nt, pmode;
    DI void init(const void* A_, const void* B_, int M, int N, int Kbytes, int G_, int c_, int nMfull = -1, int ksp_ = 0) { A = (const char*)A_; B = (const char*)B_; tstepA = (size_t)BM * Kbytes; tstepB = (size_t)BM * Kbytes; nM = M / BM; nN = N / BM;
        nMf = nMfull < 0 ? nM : nMfull; ksp = ksp_; G = G_; c = c_; nt = Kbytes / 128; pmode = 0; }
    int rag_r0 = -1, rag_w1 = 0, rag_w2 = 0, rag_w3 = 0;
    DI bool next(int i, GUnit& u) const {
        long L = (long)i * G + c; const int nwg = nMf * nN;
        if (rag_r0 >= 0 && i >= rag_r0) { if (i == rag_r0) { if (c >= rag_w1) return false; } else if (i == rag_r0 + 1) { if (c >= rag_w2) return false; L = (long)rag_r0 * G + rag_w1 + c; }
            else if (i == rag_r0 + 2) { if (c >= rag_w3) return false; L = (long)rag_r0 * G + rag_w1 + rag_w2 + c; } else return false; }
        if (L >= nwg) {
            if (!ksp) return false;
            const int L2 = (int)(L - nwg); if (L2 >= (nM - nMf) * nN * ksp) return false;
            const int sp = L2 % ksp, uu = L2 / ksp, pm = nMf + uu / nN, pn = uu % nN, ntu = nt / ksp;
            u.A = A + (size_t)pm * tstepA + (size_t)sp * ntu * 128; u.B = B + (size_t)pn * tstepB + (size_t)sp * ntu * 128; u.nt = ntu; u.i0 = 1 + sp; u.i1 = pm; u.i2 = pn; return true; }
        int wgid = (int)L; { const int q = nwg / NXCD, r = nwg % NXCD, xcd = wgid % NXCD, off = wgid / NXCD; wgid = (xcd < r ? xcd * (q + 1) : r * (q + 1) + (xcd - r) * q) + off; }
        const int nig = WGM * nN, gid = wgid / nig, fm = gid * WGM, gsz = (nMf - fm) < WGM ? (nMf - fm) : WGM;
        int pm = fm + ((wgid % nig) % gsz); const int pn = (wgid % nig) / gsz;
        if (pmode == 1) pm += pm / 15; else if (pmode == 2) pm = pm < 4 ? 16 * pm + 15 : 60 + pm;
        u.A = A + (size_t)pm * tstepA; u.B = B + (size_t)pn * tstepB; u.nt = nt; u.i0 = 0; u.i1 = pm; u.i2 = pn; return true;
    }
};

template <class Epi, class Sched, bool ATILED, bool FP8 = false>
__device__ __forceinline__ void gemm_phase(LAS unsigned char* lds, const unsigned ldaB, const unsigned ldbB, const Sched& S, const Epi& E, const int fp8_scale_a = 0x7f7f7f7f, const int fp8_scale_b = 0x7f7f7f7f) {
    const int wid = __builtin_amdgcn_readfirstlane(S.wave);
    int tid = wid * 64 + lane_id(); asm volatile("" : "+v"(tid));
    const int lane = tid & 63, wr = wid >> 2, wc = wid & 3, fr = lane & 15, fq = lane >> 4;
    unsigned voffA[2], voffB[2];
#pragma unroll
    for (int i = 0; i < 2; ++i) { int R, C; stage_rc(tid * 16 + i * 8192, R, C); const int Rb = Epi::PERM ? ((R & ~31) + perm32(R & 31)) : R;
        voffA[i] = (unsigned)R * ldaB + (unsigned)C * 2u; voffB[i] = (unsigned)Rb * ldbB + (unsigned)C * 2u; }
    const size_t kstep = (size_t)(BK * 2);
    const size_t hstepA = (size_t)HALF * ldaB, hstepB = (size_t)HALF * ldbB;
    const unsigned ldsw = (unsigned)wid * 1024u;
    const int aoff = lds_byte(wr * 64 + fr, fq * 8), boff = lds_byte(wc * 32 + fr, fq * 8);
#define G8_KA(p, kt) (ATILED ? ((p) + (size_t)((kt) >> 2) * 131072u + (size_t)((kt) & 3) * 128u) : ((p) + (size_t)(kt) * 128u))
#define G8_SA(b, h) (((b) * 2 + (h)) * HTB)
#define G8_SB(b, h) ((4 + (b) * 2 + (h)) * HTB)
#define G8_STAGE(bufoff, gbase, voff) do { _Pragma("unroll") for (int _i = 0; _i < 2; ++_i) \
        __builtin_amdgcn_global_load_lds((const unsigned*)((const char*)(gbase) + (voff)[_i]), (LAS unsigned*)(lds + (bufoff) + ldsw + _i * 8192), 16, 0, 0); } while (0)
#define G8_RDA(b, h, m, k) (*(const LAS bf16x8*)(lds + G8_SA(b, h) + aoff + (m) * 2048 + (k) * 1024))
#define G8_RDB(b, h, n, k) (*(const LAS bf16x8*)(lds + G8_SB(b, h) + boff + (n) * 2048 + (k) * 1024))
#define G8_LDA(dst, b, h) do { _Pragma("unroll") for (int m = 0; m < 4; ++m) { if constexpr (FP8) dst##8[m] = cat8(G8_RDA(b, h, m, 0), G8_RDA(b, h, m, 1)); else { dst[m][0] = G8_RDA(b, h, m, 0); dst[m][1] = G8_RDA(b, h, m, 1); } } } while (0)
#define G8_LDB(dst, b, h) do { _Pragma("unroll") for (int n = 0; n < 2; ++n) { if constexpr (FP8) dst##8[n] = cat8(G8_RDB(b, h, n, 0), G8_RDB(b, h, n, 1)); else { dst[n][0] = G8_RDB(b, h, n, 0); dst[n][1] = G8_RDB(b, h, n, 1); } } } while (0)
#define G8_MMA(ai, bj, At, Bt) do { __builtin_amdgcn_s_setprio(1); _Pragma("unroll") for (int m = 0; m < 4; ++m) _Pragma("unroll") for (int n = 0; n < 2; ++n) { \
        if constexpr (FP8) { asm volatile("v_mfma_scale_f32_16x16x128_f8f6f4 %0, %1, %2, %0, %3, %4 op_sel_hi:[0,0,0]" : "+v"(acc[ai][bj][m][n]) : "v"(Bt##8[n]), "v"(At##8[m]), "v"(fp8_sb_v), "v"(fp8_sa_v)); } \
        else { _Pragma("unroll") for (int k = 0; k < 2; ++k) acc[ai][bj][m][n] = __builtin_amdgcn_mfma_f32_16x16x32_bf16(Bt[n][k], At[m][k], acc[ai][bj][m][n], 0, 0, 0); } } \
        __builtin_amdgcn_s_setprio(0); } while (0)
#define G8_WAIT_V(n) asm volatile("s_waitcnt vmcnt(" #n ")" ::: "memory")
#define G8_WAIT_L(n) asm volatile("s_waitcnt lgkmcnt(" #n ")" ::: "memory")
#define G8_BAR __builtin_amdgcn_s_barrier()
#define G8_SCHED __builtin_amdgcn_sched_barrier(0)
    GUnit cur, nxt; int ui = 0;
    if (!S.next(0, cur)) return;
    f32x4 acc[2][2][4][2];
#pragma unroll
    for (int a = 0; a < 2; ++a)
#pragma unroll
        for (int b = 0; b < 2; ++b)
#pragma unroll
            for (int m = 0; m < 4; ++m)
#pragma unroll
                for (int n = 0; n < 2; ++n) acc[a][b][m][n] = (f32x4){0.f, 0.f, 0.f, 0.f};
    const int fp8_sb_v = fp8_scale_b, fp8_sa_v = fp8_scale_a;
    bf16x8 At[4][2], B0[2][2], B1[2][2]; i32x8 At8[4], B08[2], B18[2];
    const char* cA = cur.A; const char* cB = cur.B;
    G8_STAGE(G8_SB(0, 0), cB, voffB); G8_STAGE(G8_SB(0, 1), cB + hstepB, voffB); G8_STAGE(G8_SA(0, 0), cA, voffA); G8_STAGE(G8_SA(0, 1), cA + hstepA, voffA);
    if (wr == 1) G8_BAR;
    G8_WAIT_V(2); G8_BAR;
    G8_STAGE(G8_SB(1, 0), cB + kstep, voffB); G8_STAGE(G8_SA(1, 0), G8_KA(cA, 1), voffA); G8_STAGE(G8_SB(1, 1), cB + hstepB + kstep, voffB);
    G8_WAIT_V(6); G8_BAR;
    for (;;) {
        const bool has_next = S.next(ui + 1, nxt);
        const char* nA = has_next ? nxt.A : cA; const char* nB = has_next ? nxt.B : cB;
        const int nt = cur.nt;
        for (int t = 0; t < nt; t += 2) {
            const bool last = (t == nt - 2);
            const char* a1 = G8_KA(cA, t + 1);
            const char* a2 = last ? nA : G8_KA(cA, t + 2); const char* b2 = last ? nB : cB + (size_t)(t + 2) * kstep;
            const char* a3 = a2 + kstep; const char* b3 = b2 + kstep;
            G8_LDB(B0, 0, 0); G8_LDB(B1, 0, 1); G8_SCHED; G8_LDA(At, 0, 0); G8_STAGE(G8_SA(1, 1), a1 + hstepA, voffA);
            G8_WAIT_V(8); G8_WAIT_L(0); G8_BAR; G8_MMA(0, 0, At, B0); G8_MMA(0, 1, At, B1); G8_BAR; G8_SCHED;
            G8_LDA(At, 0, 1); G8_STAGE(G8_SB(0, 0), b2, voffB); G8_STAGE(G8_SB(0, 1), b2 + hstepB, voffB); G8_STAGE(G8_SA(0, 0), a2, voffA);
            G8_WAIT_V(8); G8_WAIT_L(0); G8_BAR; G8_MMA(1, 0, At, B0); G8_MMA(1, 1, At, B1); G8_BAR; G8_SCHED;
            G8_LDB(B0, 1, 0); G8_LDB(B1, 1, 1); G8_SCHED; G8_LDA(At, 1, 0); G8_STAGE(G8_SA(0, 1), a2 + hstepA, voffA);
            G8_WAIT_V(8); G8_WAIT_L(0); G8_BAR; G8_MMA(0, 0, At, B0); G8_MMA(0, 1, At, B1); G8_BAR; G8_SCHED;
            G8_LDA(At, 1, 1); G8_STAGE(G8_SB(1, 0), b3, voffB); G8_STAGE(G8_SB(1, 1), b3 + hstepB, voffB); G8_STAGE(G8_SA(1, 0), a3, voffA);
            G8_WAIT_V(8); G8_WAIT_L(0); G8_BAR; G8_MMA(1, 0, At, B0); G8_MMA(1, 1, At, B1); G8_BAR; G8_SCHED;
        }
        if constexpr (FP8) asm volatile("s_nop 15\n\ts_nop 15\n\ts_nop 15" ::: "memory");
        if (wr == 0) G8_BAR;
        E(acc, cur, wr, wc, fr, fq);
        if (!has_next) break;
#pragma unroll
        for (int a = 0; a < 2; ++a)
#pragma unroll
            for (int b = 0; b < 2; ++b)
#pragma unroll
                for (int m = 0; m < 4; ++m)
#pragma unroll
                    for (int n = 0; n < 2; ++n) acc[a][b][m][n] = (f32x4){0.f, 0.f, 0.f, 0.f};
        cur = nxt; cA = nA; cB = nB; ++ui;
        if (wr == 1) G8_BAR;
    }
    G8_WAIT_V(0);
    G8_BAR;
#undef G8_KA
#undef G8_SA
#undef G8_SB
#undef G8_STAGE
#undef G8_LDA
#undef G8_RDA
#undef G8_RDB
#undef G8_LDB
#undef G8_MMA
#undef G8_WAIT_V
#undef G8_WAIT_L
#undef G8_BAR
#undef G8_SCHED
}

struct GUnitM { const char* A8; const char* B8; const char* A16; const char* B16; int nt8, nt; int i0, i1, i2; };
typedef int i32x4 __attribute__((ext_vector_type(4)));
template <class Epi, class Sched>
__device__ __forceinline__ void gemm_phase_mixed(LAS unsigned char* lds, const unsigned ldb8, const unsigned ldb16, const Sched& S, const Epi& E, const int scale_b8, const int scale_a8) {
    const int wid = __builtin_amdgcn_readfirstlane(S.wave);
    int tid = wid * 64 + lane_id(); asm volatile("" : "+v"(tid));
    const int lane = tid & 63, wr = wid >> 2, wc = wid & 3, fr = lane & 15, fq = lane >> 4;
    unsigned voffA8[2], rowB[2];
#pragma unroll
    for (int i = 0; i < 2; ++i) { int R, C; stage_rc(tid * 16 + i * 8192, R, C); const int Rb = Epi::PERM ? ((R & ~31) + perm32(R & 31)) : R;
        voffA8[i] = (unsigned)R * 256u + (unsigned)C * 2u; rowB[i] = (unsigned)Rb; }
#define GM_VA(is8, i) ((is8) ? voffA8[i] : voffA8[i] + (voffA8[i] & ~255u))
#define GM_VB(is8, i) (rowB[i] * ((is8) ? ldb8 : ldb16) + (voffA8[i] & 255u))
    const unsigned ldsw = (unsigned)wid * 1024u;
    const int aoff = lds_byte(wr * 64 + fr, fq * 8), boff = lds_byte(wc * 32 + fr, fq * 8);
#define GM_SA(b, h) (((b) * 2 + (h)) * HTB)
#define GM_SB(b, h) ((4 + (b) * 2 + (h)) * HTB)
#define GM_PA(u, kt) ((kt) < (u).nt8 ? (u).A8 + (size_t)((kt) >> 1) * 65536u + (size_t)((kt) & 1) * 128u : (u).A16 + (size_t)(((kt) - (u).nt8) >> 2) * 131072u + (size_t)(((kt) - (u).nt8) & 3) * 128u)
#define GM_PB(u, kt) ((kt) < (u).nt8 ? (u).B8 + (size_t)(kt) * 128u : (u).B16 + (size_t)((kt) - (u).nt8) * 128u)
#define GM_STAGE_A(bufoff, gbase, is8, half) do { const char* _g = (gbase) + ((half) ? ((is8) ? 32768u : 65536u) : 0u); _Pragma("unroll") for (int _i = 0; _i < 2; ++_i) \
        __builtin_amdgcn_global_load_lds((const unsigned*)(_g + GM_VA(is8, _i)), (LAS unsigned*)(lds + (bufoff) + ldsw + _i * 8192), 16, 0, 0); } while (0)
#define GM_STAGE_B(bufoff, gbase, is8, half) do { const char* _g = (gbase) + ((half) ? (size_t)HALF * ((is8) ? ldb8 : ldb16) : (size_t)0); _Pragma("unroll") for (int _i = 0; _i < 2; ++_i) \
        __builtin_amdgcn_global_load_lds((const unsigned*)(_g + GM_VB(is8, _i)), (LAS unsigned*)(lds + (bufoff) + ldsw + _i * 8192), 16, 0, 0); } while (0)
#define GM_RDA(b, h, m, k) (*(const LAS bf16x8*)(lds + GM_SA(b, h) + aoff + (m) * 2048 + (k) * 1024))
#define GM_RDB(b, h, n, k) (*(const LAS bf16x8*)(lds + GM_SB(b, h) + boff + (n) * 2048 + (k) * 1024))
#define GM_LDA8(b, h) do { _Pragma("unroll") for (int m = 0; m < 4; ++m) At8[m] = cat8(GM_RDA(b, h, m, 0), GM_RDA(b, h, m, 1)); } while (0)
#define GM_LDB8(dst, b, h) do { _Pragma("unroll") for (int n = 0; n < 2; ++n) dst##8[n] = cat8(GM_RDB(b, h, n, 0), GM_RDB(b, h, n, 1)); } while (0)
#define GM_LDA16(b, h) do { _Pragma("unroll") for (int m = 0; m < 4; ++m) { At[m][0] = GM_RDA(b, h, m, 0); At[m][1] = GM_RDA(b, h, m, 1); } } while (0)
#define GM_LDB16(dst, b, h) do { _Pragma("unroll") for (int n = 0; n < 2; ++n) { dst[n][0] = GM_RDB(b, h, n, 0); dst[n][1] = GM_RDB(b, h, n, 1); } } while (0)
#define GM_MMA8(ai, bj, Bt) do { __builtin_amdgcn_s_setprio(1); _Pragma("unroll") for (int m = 0; m < 4; ++m) _Pragma("unroll") for (int n = 0; n < 2; ++n) \
        asm volatile("v_mfma_scale_f32_16x16x128_f8f6f4 %0, %1, %2, %0, %3, %4 op_sel_hi:[0,0,0]" : "+v"(acc[ai][bj][m][n]) : "v"(Bt##8[n]), "v"(At8[m]), "v"(sb8_v), "v"(sa8_v)); \
        __builtin_amdgcn_s_setprio(0); } while (0)
#define GM_MMA16(ai, bj, Bt) do { __builtin_amdgcn_s_setprio(1); _Pragma("unroll") for (int m = 0; m < 4; ++m) _Pragma("unroll") for (int n = 0; n < 2; ++n) _Pragma("unroll") for (int k = 0; k < 2; ++k) \
        acc[ai][bj][m][n] = __builtin_amdgcn_mfma_f32_16x16x32_bf16(Bt[n][k], At[m][k], acc[ai][bj][m][n], 0, 0, 0); __builtin_amdgcn_s_setprio(0); } while (0)
#define GM_TRIP(LDA_, LDB_, MMA_, c8_) do { \
            const bool last = (t == nt - 2); \
            const char* a1 = GM_PA(cur, t) + 128; \
            bool n8; const char* a2; const char* b2; \
            if (!last) { n8 = (t + 2) < cur.nt8; a2 = GM_PA(cur, t + 2); b2 = GM_PB(cur, t + 2); } \
            else if (has_next) { n8 = 0 < nxt.nt8; a2 = GM_PA(nxt, 0); b2 = GM_PB(nxt, 0); } \
            else { n8 = 0 < cur.nt8; a2 = GM_PA(cur, 0); b2 = GM_PB(cur, 0); } \
            const char* a3 = a2 + 128; const char* b3 = b2 + 128; \
            LDB_(B0, 0, 0); LDB_(B1, 0, 1); GM_SCHED; LDA_(0, 0); GM_STAGE_A(GM_SA(1, 1), a1, c8_, 1); \
            GM_WAIT_V(8); GM_WAIT_L(0); GM_BAR; MMA_(0, 0, B0); MMA_(0, 1, B1); GM_BAR; GM_SCHED; \
            LDA_(0, 1); GM_STAGE_B(GM_SB(0, 0), b2, n8, 0); GM_STAGE_B(GM_SB(0, 1), b2, n8, 1); GM_STAGE_A(GM_SA(0, 0), a2, n8, 0); \
            GM_WAIT_V(8); GM_WAIT_L(0); GM_BAR; MMA_(1, 0, B0); MMA_(1, 1, B1); GM_BAR; GM_SCHED; \
            LDB_(B0, 1, 0); LDB_(B1, 1, 1); GM_SCHED; LDA_(1, 0); GM_STAGE_A(GM_SA(0, 1), a2, n8, 1); \
            GM_WAIT_V(8); GM_WAIT_L(0); GM_BAR; MMA_(0, 0, B0); MMA_(0, 1, B1); GM_BAR; GM_SCHED; \
            LDA_(1, 1); GM_STAGE_B(GM_SB(1, 0), b3, n8, 0); GM_STAGE_B(GM_SB(1, 1), b3, n8, 1); GM_STAGE_A(GM_SA(1, 0), a3, n8, 0); \
            GM_WAIT_V(8); GM_WAIT_L(0); GM_BAR; MMA_(1, 0, B0); MMA_(1, 1, B1); GM_BAR; GM_SCHED; } while (0)
#define GM_WAIT_V(n) asm volatile("s_waitcnt vmcnt(" #n ")" ::: "memory")
#define GM_WAIT_L(n) asm volatile("s_waitcnt lgkmcnt(" #n ")" ::: "memory")
#define GM_BAR __builtin_amdgcn_s_barrier()
#define GM_SCHED __builtin_amdgcn_sched_barrier(0)
    GUnitM cur, nxt; int ui = 0;
    if (!S.next(0, cur)) return;
    f32x4 acc[2][2][4][2];
#pragma unroll
    for (int a = 0; a < 2; ++a)
#pragma unroll
        for (int b = 0; b < 2; ++b)
#pragma unroll
            for (int m = 0; m < 4; ++m)
#pragma unroll
                for (int n = 0; n < 2; ++n) acc[a][b][m][n] = (f32x4){0.f, 0.f, 0.f, 0.f};
    const int sb8_v = scale_b8, sa8_v = scale_a8;
    i32x8 At8[4], B08[2], B18[2]; bf16x8 At[4][2], B0[2][2], B1[2][2];
    { const bool p8 = 0 < cur.nt8; const char* a0 = GM_PA(cur, 0); const char* b0 = GM_PB(cur, 0);
      GM_STAGE_B(GM_SB(0, 0), b0, p8, 0); GM_STAGE_B(GM_SB(0, 1), b0, p8, 1); GM_STAGE_A(GM_SA(0, 0), a0, p8, 0); GM_STAGE_A(GM_SA(0, 1), a0, p8, 1);
      if (wr == 1) GM_BAR;
      GM_WAIT_V(2); GM_BAR;
      GM_STAGE_B(GM_SB(1, 0), b0 + 128, p8, 0); GM_STAGE_A(GM_SA(1, 0), a0 + 128, p8, 0); GM_STAGE_B(GM_SB(1, 1), b0 + 128, p8, 1);
      GM_WAIT_V(6); GM_BAR; }
    for (;;) {
        const bool has_next = S.next(ui + 1, nxt);
        const int nt = cur.nt, nt8 = cur.nt8;
        for (int t = 0; t < nt8; t += 2) GM_TRIP(GM_LDA8, GM_LDB8, GM_MMA8, true);
        for (int t = nt8; t < nt; t += 2) GM_TRIP(GM_LDA16, GM_LDB16, GM_MMA16, false);
        asm volatile("s_nop 15\n\ts_nop 15\n\ts_nop 15" ::: "memory");
        if (wr == 0) GM_BAR;
        { int tz = lane_id(); asm volatile("" : "+v"(tz));
          const int ln = tz & 63; E(acc, cur, wr, wc, ln & 15, ln >> 4); }
        if (!has_next) break;
#pragma unroll
        for (int a = 0; a < 2; ++a)
#pragma unroll
            for (int b = 0; b < 2; ++b)
#pragma unroll
                for (int m = 0; m < 4; ++m)
#pragma unroll
                    for (int n = 0; n < 2; ++n) acc[a][b][m][n] = (f32x4){0.f, 0.f, 0.f, 0.f};
        cur = nxt; ++ui;
        if (wr == 1) GM_BAR;
    }
    GM_WAIT_V(0);
    GM_BAR;
#undef GM_VA
#undef GM_VB
#undef GM_SA
#undef GM_SB
#undef GM_PA
#undef GM_PB
#undef GM_STAGE_A
#undef GM_STAGE_B
#undef GM_RDA
#undef GM_RDB
#undef GM_LDA8
#undef GM_LDB8
#undef GM_LDA16
#undef GM_LDB16
#undef GM_MMA8
#undef GM_MMA16
#undef GM_TRIP
#undef GM_WAIT_V
#undef GM_WAIT_L
#undef GM_BAR
#undef GM_SCHED
}
}
using g8::GUnit;
using g8::GUnitM;
using g8::HALF;

struct Params {
    const float *x_prompt, *x_sample, *st_C, *st_n, *st_m, *st_mconv, *st_cconv;
    const float *w_up, *w_mconv, *b_mconv, *w_q, *w_k, *w_v, *w_gate, *b_gate, *mh_gain, *skip, *w_down;
    const float *w_cin, *b_cin, *w_dw, *b_dw, *cln_g, *cln_b, *w_cout, *b_cout, *pln_g, *pln_b;
    float* out; unsigned char* ws; int ph_lo, ph_hi;
};
struct Frame { LAS unsigned char* lds; int tid, lane, wave, G, bx, vcu, dry; };

struct EpiUp {
    static constexpr bool PERM = true;
    bf16_t* base; int act; float sc;
    DI void operator()(const f32x4 (&acc)[2][2][4][2], const GUnit& u, int wr, int wc, int fr, int fq) const {
        const int row0 = u.i1 * 256 + wr * 64 + fr, col0 = u.i2 * 256 + wc * 32 + 8 * fq;
#pragma unroll
        for (int ai = 0; ai < 2; ++ai)
#pragma unroll
            for (int m = 0; m < 4; ++m) { bf16_t* rowp = base + (size_t)(row0 + ai * HALF + m * 16) * INNER + col0;
#pragma unroll
                for (int bj = 0; bj < 2; ++bj) { f32x4 v0 = acc[ai][bj][m][0], v1 = acc[ai][bj][m][1];
                    if (act) {
#pragma unroll
                        for (int j = 0; j < 4; ++j) { v0[j] = fsilu(v0[j] * sc); v1[j] = fsilu(v1[j] * sc); } }
                    u32x4 w; w.x = pk_bf16(v0[0], v0[1]); w.y = pk_bf16(v0[2], v0[3]); w.z = pk_bf16(v1[0], v1[1]); w.w = pk_bf16(v1[2], v1[3]);
                    *(u32x4*)(rowp + bj * HALF) = w; } }
    }
};
struct EpiS {
    static constexpr bool PERM = true;
    bf16_t* Sb; const float* cs; const float* mx; float* den; int dry; float sc; int far;
    DI void operator()(const f32x4 (&acc)[2][2][4][2], const GUnit& u, int wr, int wc, int fr, int fq) const {
        const int bh = u.i0, pm = u.i1, pn = u.i2;
        bf16_t* tile = (bf16_t*)((unsigned char*)Sb + WS_S16 - WS_S + (size_t)bh * S16_BH + (size_t)(pm + pn) * 131072);
        unsigned char* tile8 = (unsigned char*)Sb + (size_t)bh * S8_BH + (size_t)((pm - 2) * (pm - 1) / 2 + pn) * 65536;
        const float* csb = cs + bh * 4096 + pn * 256; const float* mxb = mx + bh * 4096 + pm * 256; float* denb = den + bh * 4096 + pm * 256;
        const bool diag = (pm == pn);
        f32x4 cv[2][2];
#pragma unroll
        for (int bj = 0; bj < 2; ++bj)
#pragma unroll
            for (int n = 0; n < 2; ++n) cv[bj][n] = *(const f32x4*)(csb + bj * HALF + wc * 32 + 8 * fq + 4 * n);
#pragma unroll
        for (int ai = 0; ai < 2; ++ai)
#pragma unroll
            for (int m = 0; m < 4; ++m) { const int rloc = ai * HALF + wr * 64 + m * 16 + fr; const float mxt = mxb[rloc]; float rs = 0.f;
                const int rowlim = diag ? rloc - (wc * 32 + 8 * fq) : 0x10000;
#pragma unroll
                for (int bj = 0; bj < 2; ++bj) { f32x4 v[2];
#pragma unroll
                    for (int n = 0; n < 2; ++n) { v[n] = acc[ai][bj][m][n];
#pragma unroll
                        for (int j = 0; j < 4; ++j) { const bool masked = (bj * HALF + 4 * n + j) > rowlim;
                            const float d = masked ? 0.f : fexp(cv[bj][n][j] - mxt) * sc; v[n][j] *= d; rs += v[n][j]; } }
                    if (far) { u32x2 w8; w8.x = pk_fp8x4(v[0][0] * FP8_SA_S, v[0][1] * FP8_SA_S, v[0][2] * FP8_SA_S, v[0][3] * FP8_SA_S); w8.y = pk_fp8x4(v[1][0] * FP8_SA_S, v[1][1] * FP8_SA_S, v[1][2] * FP8_SA_S, v[1][3] * FP8_SA_S);
                        *(u32x2*)(tile8 + (size_t)rloc * 256 + bj * HALF + wc * 32 + 8 * fq) = w8; }
                    else { u32x4 w; w.x = pk_bf16(v[0][0], v[0][1]); w.y = pk_bf16(v[0][2], v[0][3]); w.z = pk_bf16(v[1][0], v[1][1]); w.w = pk_bf16(v[1][2], v[1][3]);
                        *(u32x4*)(tile + (size_t)rloc * 256 + bj * HALF + wc * 32 + 8 * fq) = w; } }
                rs += __shfl_xor(rs, 16); rs += __shfl_xor(rs, 32);
                if (fq == 0 && !dry) atomicAdd(denb + rloc, rs); }
    }
};
struct EpiState {
    static constexpr bool PERM = false;
    float* C;
    DI void operator()(const f32x4 (&acc)[2][2][4][2], const GUnit& u, int wr, int wc, int fr, int fq) const {
        float* base = C + ((size_t)u.i0 << 20);
        const int row0 = u.i1 * 256 + wr * 64 + fr, col0 = u.i2 * 256 + wc * 32 + 4 * fq;
#pragma unroll
        for (int ai = 0; ai < 2; ++ai)
#pragma unroll
            for (int m = 0; m < 4; ++m) { float* rowp = base + (size_t)(row0 + ai * HALF + m * 16) * 1024 + col0;
#pragma unroll
                for (int bj = 0; bj < 2; ++bj)
#pragma unroll
                    for (int n = 0; n < 2; ++n) st_nt((f32x4*)(rowp + bj * HALF + n * 16), acc[ai][bj][m][n]); }
    }
};
struct EpiSV {
    static constexpr bool PERM = true;
    bf16_t* hb; const float* den; const float* em;
    template <class U> DI void operator()(const f32x4 (&acc)[2][2][4][2], const U& u, int wr, int wc, int fr, int fq) const {
        const int bh = u.i0, pm = u.i1, pn = u.i2, b = bh >> 3, h = bh & 7;
        const float* denb = den + bh * 4096 + pm * 256; const float* emb = em + bh * 4096 + pm * 256;
        bf16_t* base = hb + (size_t)(b * 4096 + pm * 256) * INNER + h * 1024 + pn * 256 + wc * 32 + 8 * fq;
        float dn[2][4], ee[2][4];
#pragma unroll
        for (int ai = 0; ai < 2; ++ai)
#pragma unroll
            for (int m = 0; m < 4; ++m) { const int rloc = ai * HALF + wr * 64 + m * 16 + fr; dn[ai][m] = denb[rloc]; ee[ai][m] = emb[rloc]; }
        __builtin_amdgcn_sched_barrier(0);
#pragma unroll
        for (int ai = 0; ai < 2; ++ai)
#pragma unroll
            for (int m = 0; m < 4; ++m) { const int rloc = ai * HALF + wr * 64 + m * 16 + fr; const float g = 1.0f / fmaxf(fabsf(dn[ai][m]), ee[ai][m]);
#pragma unroll
                for (int bj = 0; bj < 2; ++bj) { const f32x4 v0 = acc[ai][bj][m][0] * g, v1 = acc[ai][bj][m][1] * g;
                    u32x4 w; w.x = pk_bf16(v0[0], v0[1]); w.y = pk_bf16(v0[2], v0[3]); w.z = pk_bf16(v1[0], v1[1]); w.w = pk_bf16(v1[2], v1[3]);
                    *(u32x4*)(base + (size_t)rloc * INNER + bj * HALF) = w; } }
    }
};
struct EpiRes {
    static constexpr bool PERM = true;
    const float* resA; const float* resB; const float* bias; bf16_t* r; float* part; float sc;
    float* rstat;
    const bf16_t* resLn; const float* lnst; const float* lng; const float* lnb;
    DI void operator()(const f32x4 (&acc)[2][2][4][2], const GUnit& u, int wr, int wc, int fr, int fq) const {
        const int pm = u.i1, row0 = pm * 256 + wr * 64 + fr, col0 = u.i2 * 256 + wc * 32 + 8 * fq;
        f32x4 bv[2][2];
#pragma unroll
        for (int bj = 0; bj < 2; ++bj)
#pragma unroll
            for (int n = 0; n < 2; ++n) bv[bj][n] = bias ? *(const f32x4*)(bias + col0 + bj * HALF + n * 4) : (f32x4){0.f, 0.f, 0.f, 0.f};
        if (u.i0 == 0) {
            f32x4 lg[2][2], lb[2][2];
            if (resLn) {
#pragma unroll
                for (int bj = 0; bj < 2; ++bj)
#pragma unroll
                    for (int n = 0; n < 2; ++n) { lg[bj][n] = *(const f32x4*)(lng + col0 + bj * HALF + n * 4); lb[bj][n] = *(const f32x4*)(lnb + col0 + bj * HALF + n * 4); }
                __builtin_amdgcn_sched_barrier(0);
#pragma unroll
                for (int bj = 0; bj < 2; ++bj)
#pragma unroll
                    for (int n = 0; n < 2; ++n) { lg[bj][n] = lg[bj][n] * ALPHA; lb[bj][n] = lb[bj][n] * ALPHA + bv[bj][n]; } }
#define ER_FINISH(xr_) do { f32x4 v[2]; \
                    _Pragma("unroll") for (int n = 0; n < 2; ++n) { v[n] = (xr_)[n] + acc[ai][bj][m][n] * sc; \
                        s1 += (v[n][0] + v[n][1]) + (v[n][2] + v[n][3]); s2 += (v[n][0] * v[n][0] + v[n][1] * v[n][1]) + (v[n][2] * v[n][2] + v[n][3] * v[n][3]); } \
                    u32x4 w; w.x = pk_bf16(v[0][0], v[0][1]); w.y = pk_bf16(v[0][2], v[0][3]); w.z = pk_bf16(v[1][0], v[1][1]); w.w = pk_bf16(v[1][2], v[1][3]); \
                    *(u32x4*)(r + ro + bj * HALF) = w; } while (0)
#define ER_STATS() do { s1 += __shfl_xor(s1, 16); s1 += __shfl_xor(s1, 32); s2 += __shfl_xor(s2, 16); s2 += __shfl_xor(s2, 32); \
                    if (fq == 0) { atomicAdd(rstat + (size_t)row * 2, s1); atomicAdd(rstat + (size_t)row * 2 + 1, s2); } } while (0)
#pragma unroll
        for (int ai = 0; ai < 2; ++ai) {
            if (resLn) {
                u32x4 rw[4][2]; float mn[4], rs[4];
#pragma unroll
                for (int m = 0; m < 4; ++m) { const int row = row0 + ai * HALF + m * 16; const size_t ro = (size_t)row * DM + col0;
                    mn[m] = lnst[(size_t)row * 2]; rs[m] = lnst[(size_t)row * 2 + 1];
#pragma unroll
                    for (int bj = 0; bj < 2; ++bj) rw[m][bj] = ld_nt((const u32x4*)(resLn + ro + bj * HALF)); }
                __builtin_amdgcn_sched_barrier(0);
#pragma unroll
                for (int m = 0; m < 4; ++m) { const int row = row0 + ai * HALF + m * 16; const size_t ro = (size_t)row * DM + col0; const float mean = mn[m], rstd = rs[m];
                    float s1 = 0.f, s2 = 0.f;
#pragma unroll
                    for (int bj = 0; bj < 2; ++bj) { const u32x4 q = rw[m][bj]; f32x4 xr[2];
                        xr[0] = ((f32x4){bf_lo(q.x), bf_hi(q.x), bf_lo(q.y), bf_hi(q.y)} - mean) * rstd * lg[bj][0] + lb[bj][0]; xr[1] = ((f32x4){bf_lo(q.z), bf_hi(q.z), bf_lo(q.w), bf_hi(q.w)} - mean) * rstd * lg[bj][1] + lb[bj][1];
                        ER_FINISH(xr); }
                    ER_STATS(); }
            } else {
#pragma unroll
              for (int mh = 0; mh < 4; mh += 2) {
                f32x4 xq[2][2][2];
#pragma unroll
                for (int m = mh; m < mh + 2; ++m) { const size_t ro = (size_t)(row0 + ai * HALF + m * 16) * DM + col0;
#pragma unroll
                    for (int bj = 0; bj < 2; ++bj) { xq[m - mh][bj][0] = ld_nt((const f32x4*)(resA + ro + bj * HALF)); xq[m - mh][bj][1] = ld_nt((const f32x4*)(resA + ro + bj * HALF + 4)); } }
                __builtin_amdgcn_sched_barrier(0);
#pragma unroll
                for (int m = mh; m < mh + 2; ++m) { const int row = row0 + ai * HALF + m * 16; const size_t ro = (size_t)row * DM + col0;
                    float s1 = 0.f, s2 = 0.f;
#pragma unroll
                    for (int bj = 0; bj < 2; ++bj) { f32x4 xr[2]; xr[0] = xq[m - mh][bj][0] * ALPHA + bv[bj][0]; xr[1] = xq[m - mh][bj][1] * ALPHA + bv[bj][1]; ER_FINISH(xr); }
                    ER_STATS(); }
              }
            }
        }
#undef ER_FINISH
#undef ER_STATS
        } else {
            const bool first = (u.i0 == 1); float* pr = part + (size_t)(u.i0 - 1) * TS * DM - (size_t)TP * DM; const float* res = resB + (size_t)(row0 - TP) * DM;
#pragma unroll
        for (int ai = 0; ai < 2; ++ai)
#pragma unroll
          for (int mh = 0; mh < 4; mh += 2) { f32x4 xq[2][2][2];
            if (first) {
#pragma unroll
                for (int m = mh; m < mh + 2; ++m) { const size_t ro = (size_t)(ai * HALF + m * 16) * DM + col0;
#pragma unroll
                    for (int bj = 0; bj < 2; ++bj)
#pragma unroll
                        for (int n = 0; n < 2; ++n) xq[m - mh][bj][n] = *(const f32x4*)(res + ro + bj * HALF + n * 4); }
                __builtin_amdgcn_sched_barrier(0); }
#pragma unroll
            for (int m = mh; m < mh + 2; ++m) { const size_t ro = (size_t)(ai * HALF + m * 16) * DM + col0; float* rowp = pr + (size_t)row0 * DM + ro;
#pragma unroll
                for (int bj = 0; bj < 2; ++bj)
#pragma unroll
                    for (int n = 0; n < 2; ++n) { f32x4 v = acc[ai][bj][m][n] * sc;
                        if (first) v += xq[m - mh][bj][n] * ALPHA + bv[bj][n];
                        *(f32x4*)(rowp + bj * HALF + n * 4) = v; } } }
        }
    }
};
struct EpiCin {
    static constexpr bool PERM = true;
    bf16_t* ub; bf16_t* szg; const float* bias; float sc;
    DI void operator()(const f32x4 (&acc)[2][2][4][2], const GUnit& u, int wr, int wc, int fr, int fq) const {
        const int pm = u.i1, pn = u.i2, row0 = pm * 256 + wr * 64 + fr;
        if (pn < 32) {
            const int ch0 = pn * 128 + wc * 32 + 8 * fq;
            f32x4 ba[2], bg[2];
#pragma unroll
            for (int n = 0; n < 2; ++n) { ba[n] = *(const f32x4*)(bias + ch0 + 4 * n); bg[n] = *(const f32x4*)(bias + 4096 + ch0 + 4 * n); }
#pragma unroll
            for (int ai = 0; ai < 2; ++ai)
#pragma unroll
                for (int m = 0; m < 4; ++m) { f32x4 o[2];
#pragma unroll
                    for (int n = 0; n < 2; ++n) { const f32x4 a = acc[ai][0][m][n] * sc + ba[n], g = acc[ai][1][m][n] * sc + bg[n];
#pragma unroll
                        for (int j = 0; j < 4; ++j) o[n][j] = a[j] * fsigm(g[j]); }
                    u32x4 w; w.x = pk_bf16(o[0][0], o[0][1]); w.y = pk_bf16(o[0][2], o[0][3]); w.z = pk_bf16(o[1][0], o[1][1]); w.w = pk_bf16(o[1][2], o[1][3]);
                    *(u32x4*)(ub + (size_t)(row0 + ai * HALF + m * 16) * DM + ch0) = w; }
        } else {
            const int ch0 = (pn - 32) * 256 + wc * 32 + 8 * fq;
            f32x4 bzz[2][2];
#pragma unroll
            for (int bj = 0; bj < 2; ++bj)
#pragma unroll
                for (int n = 0; n < 2; ++n) bzz[bj][n] = *(const f32x4*)(bias + 8192 + ch0 + bj * HALF + 4 * n);
            __builtin_amdgcn_sched_barrier(0);
#pragma unroll
            for (int bj = 0; bj < 2; ++bj) {
#pragma unroll
                for (int ai = 0; ai < 2; ++ai)
#pragma unroll
                    for (int m = 0; m < 4; ++m) { f32x4 o[2];
#pragma unroll
                        for (int n = 0; n < 2; ++n) { const f32x4 z = acc[ai][bj][m][n] * sc + bzz[bj][n];
#pragma unroll
                            for (int j = 0; j < 4; ++j) o[n][j] = fsilu(z[j]); }
                        u32x4 w; w.x = pk_bf16(o[0][0], o[0][1]); w.y = pk_bf16(o[0][2], o[0][3]); w.z = pk_bf16(o[1][0], o[1][1]); w.w = pk_bf16(o[1][2], o[1][3]);
                        *(u32x4*)(szg + (size_t)(row0 + ai * HALF + m * 16) * DM + ch0 + bj * HALF) = w; } }
        }
    }
};

struct SchedS {
    const char* qp; const char* xa; int G, c, far, wave;
    DI bool next(int i, GUnit& u) const {
        const int per = far ? 105 : 31, L = i * G + c; if (L >= 32 * per) return false;
        const int bh = L / per, rr = L - bh * per; int pm, pn;
        if (far) { int q = 0; while ((q + 1) * (q + 2) / 2 <= rr) ++q; pn = rr - q * (q + 1) / 2; pm = q + 2; }
        else if (rr < 16) { pm = rr; pn = rr; } else { pm = rr - 15; pn = rr - 16; }
        const int b = bh >> 3, h = bh & 7; const size_t es = far ? 1 : 2;
        u.A = qp + ((size_t)(b * 4096 + pm * 256) * INNER + h * 1024) * es; u.B = xa + ((size_t)(b * 4096 + pn * 256) * INNER + h * 1024) * es;
        u.nt = far ? 8 : 16; u.i0 = bh; u.i1 = pm; u.i2 = pn; return true;
    }
};
struct SchedState {
    const char* kwT; const char* vT; int G, c, wave;
    DI bool next(int i, GUnit& u) const {
        const int L = i * G + c; if (L >= 512) return false;
        const int bh = L >> 4, pm = (L >> 2) & 3, pn = L & 3, b = bh >> 3, h = bh & 7;
        u.A = kwT + ((size_t)(h * 1024 + pm * 256) * TPP + b * 4096) * 2; u.B = vT + ((size_t)(h * 1024 + pn * 256) * TPP + b * 4096) * 2;
        u.nt = 64; u.i0 = bh; u.i1 = pm; u.i2 = pn; return true;
    }
};
struct SchedSV {
    const char* S8; const char* S16; const char* vT8; const char* vT; int G, c, wave;
    DI bool next(int i, GUnitM& u) const {
        const int slot = c + G * (i >> 3); if (slot >= 256) return false;
        const int sub = i & 7, bh = slot >> 3, j = slot & 7, pn = j & 3, set = j >> 2, p = 4 * set + (sub >> 1), pm = (sub & 1) ? 15 - p : p, b = bh >> 3, h = bh & 7;
        const int pn0 = pm >= 1 ? pm - 1 : 0;
        u.nt8 = pm >= 2 ? 2 * (pm - 1) : 0; u.nt = u.nt8 + (pm >= 1 ? 8 : 4);
        u.A8 = S8 + (size_t)bh * S8_BH + (size_t)((pm - 2) * (pm - 1) / 2) * 65536; u.A16 = S16 + (size_t)bh * S16_BH + (size_t)(pm + pn0) * 131072;
        u.B8 = vT8 + (size_t)(h * 1024 + pn * 256) * P8 + b * 4096; u.B16 = vT + ((size_t)(h * 1024 + pn * 256) * TPP + b * 4096 + pn0 * 256) * 2;
        u.i0 = bh; u.i1 = pm; u.i2 = pn; return true;
    }
};

template <bool ALSO_FP8>
DI void transpose_item(const float* W, int K, int N, bf16_t* WT, int k0, int n0, int orow0, LAS float* scr, int lane, unsigned char* WQ = nullptr, float qscale = 1.f) {
#pragma unroll 8
    for (int i = 0; i < 32; ++i) { const int kk = 2 * i + (lane >> 5); scr[kk * 33 + (lane & 31)] = ld_nt(W + (size_t)(k0 + kk) * N + n0 + (lane & 31)); }
    asm volatile("s_waitcnt lgkmcnt(0)" ::: "memory");
    const int c = lane & 7;
#pragma unroll
    for (int j = 0; j < 4; ++j) { const int n = (lane >> 3) + 8 * j; const LAS float* s = scr + (8 * c) * 33 + n;
        u32x4 o; o.x = pk_bf16(s[0 * 33], s[1 * 33]); o.y = pk_bf16(s[2 * 33], s[3 * 33]); o.z = pk_bf16(s[4 * 33], s[5 * 33]); o.w = pk_bf16(s[6 * 33], s[7 * 33]);
        *(u32x4*)(WT + (size_t)(orow0 + n) * K + k0 + 8 * c) = o;
        if constexpr (ALSO_FP8) { u32x2 q; q.x = pk_fp8x4(s[0 * 33] * qscale, s[1 * 33] * qscale, s[2 * 33] * qscale, s[3 * 33] * qscale); q.y = pk_fp8x4(s[4 * 33] * qscale, s[5 * 33] * qscale, s[6 * 33] * qscale, s[7 * 33] * qscale);
            *(u32x2*)(WQ + (size_t)(orow0 + n) * K + k0 + 8 * c) = q; } }
    asm volatile("s_waitcnt lgkmcnt(0)" ::: "memory");
}
DI void transpose_item_fp8(const float* W, int K, int N, unsigned char* WT, int k0, int n0, float scale, LAS float* scr, int lane) {
#pragma unroll 8
    for (int i = 0; i < 32; ++i) { const int kk = 2 * i + (lane >> 5); scr[kk * 33 + (lane & 31)] = ld_nt(W + (size_t)(k0 + kk) * N + n0 + (lane & 31)); }
    asm volatile("s_waitcnt lgkmcnt(0)" ::: "memory");
    const int c = lane & 7;
#pragma unroll
    for (int j = 0; j < 4; ++j) { const int n = (lane >> 3) + 8 * j; const LAS float* s = scr + (8 * c) * 33 + n;
        u32x2 o; o.x = pk_fp8x4(s[0 * 33] * scale, s[1 * 33] * scale, s[2 * 33] * scale, s[3 * 33] * scale); o.y = pk_fp8x4(s[4 * 33] * scale, s[5 * 33] * scale, s[6 * 33] * scale, s[7 * 33] * scale);
        *(u32x2*)(WT + (size_t)(n0 + n) * K + k0 + 8 * c) = o; }
    asm volatile("s_waitcnt lgkmcnt(0)" ::: "memory");
}
DI void transpose_weight_fp8(const Frame& F, const float* W, int K, int N, unsigned char* WT, float scale) {
    LAS float* scr = (LAS float*)(F.lds + F.wave * 16384);
    const int gw = F.vcu * NWAVES + F.wave, NGW = F.G * NWAVES, nblk = N / 32, nitems = (K / 64) * nblk;
    for (int it = gw; it < nitems; it += NGW) { const int kb = it / nblk, nb = it - kb * nblk; transpose_item_fp8(W, K, N, WT, 64 * kb, 32 * nb, scale, scr, F.lane); }
}
DI void transpose_weight(const Frame& F, const float* W, int K, int N, bf16_t* WT, bool cin_map, unsigned char* WQ = nullptr, float qscale = 1.f) {
    LAS float* scr = (LAS float*)(F.lds + F.wave * 16384);
    const int gw = F.vcu * NWAVES + F.wave, NGW = F.G * NWAVES, nblk = N / 32, nitems = (K / 64) * nblk;
    for (int it = gw; it < nitems; it += NGW) { const int kb = it / nblk, nb = it - kb * nblk, n0 = 32 * nb; int orow0 = n0;
        if (cin_map) { if (n0 < 4096) orow0 = 256 * (n0 >> 7) + (n0 & 127); else if (n0 < 8192) orow0 = 256 * ((n0 - 4096) >> 7) + 128 + (n0 & 127); }
        if (cin_map) transpose_item<true>(W, K, N, WT, 64 * kb, n0, orow0, scr, F.lane, WQ, qscale); else transpose_item<false>(W, K, N, WT, 64 * kb, n0, orow0, scr, F.lane); }
}

DI void phase_prologue(const Frame& F, const Params& p) {
    unsigned char* ws = p.ws;
    { LAS float* scr = (LAS float*)(F.lds + F.wave * 16384);
      const int gw = F.vcu * NWAVES + F.wave, NGW = F.G * NWAVES, nblk = 2 * INNER / 32, nitems = (DM / 64) * nblk;
      for (int it = gw; it < nitems; it += NGW) { const int kb = it / nblk, nb = it - kb * nblk, n0 = 32 * nb;
          if (n0 < INNER) transpose_item<false>(p.w_up, DM, 2 * INNER, (bf16_t*)(ws + WS_WUP), 64 * kb, n0, n0, scr, F.lane);
          else transpose_item_fp8(p.w_up, DM, 2 * INNER, ws + WS_WZQ - (size_t)INNER * DM, 64 * kb, n0, FP8_SB_WZ, scr, F.lane); } }
    const size_t gt = (size_t)F.vcu * NTHR + F.tid, NT = (size_t)F.G * NTHR;
    bf16_t* xb = (bf16_t*)(ws + WS_XB);
    for (size_t i0 = gt; i0 < (size_t)TT * (DM / 8); i0 += 4 * NT) {
        f32x4 a[4], b[4];
#pragma unroll
        for (int u = 0; u < 4; ++u) { const size_t i = i0 + (size_t)u * NT; if (i < (size_t)TT * (DM / 8)) { const size_t tok = i >> 9; const int c8 = (int)(i & 511) * 8;
            const float* src = tok < TP ? p.x_prompt + tok * DM + c8 : p.x_sample + (tok - TP) * DM + c8; a[u] = ld_nt((const f32x4*)src); b[u] = ld_nt((const f32x4*)(src + 4)); } }
#pragma unroll
        for (int u = 0; u < 4; ++u) { const size_t i = i0 + (size_t)u * NT; if (i < (size_t)TT * (DM / 8)) { const size_t tok = i >> 9; const int c8 = (int)(i & 511) * 8;
            u32x4 w; w.x = pk_bf16(a[u][0], a[u][1]); w.y = pk_bf16(a[u][2], a[u][3]); w.z = pk_bf16(b[u][0], b[u][1]); w.w = pk_bf16(b[u][2], b[u][3]);
            *(u32x4*)(xb + tok * DM + c8) = w;
            u32x2 q8; q8.x = pk_fp8x4(a[u][0] * FP8_SA_X, a[u][1] * FP8_SA_X, a[u][2] * FP8_SA_X, a[u][3] * FP8_SA_X); q8.y = pk_fp8x4(b[u][0] * FP8_SA_X, b[u][1] * FP8_SA_X, b[u][2] * FP8_SA_X, b[u][3] * FP8_SA_X);
            *(u32x2*)(ws + WS_XQ + tok * DM + c8) = q8; } }
    }
    for (size_t i = gt; i < (WS_ZERO_BYTES - WS_GATES) / 16; i += NT) *(u32x4*)(ws + WS_GATES + 16 * i) = (u32x4){0u, 0u, 0u, 0u};
    for (size_t i = gt; i < (size_t)32 * 1024 / 4; i += NT) *(f32x4*)(p.out + O_PN + 4 * i) = (f32x4){0.f, 0.f, 0.f, 0.f};
    bf16_t* GT = (bf16_t*)(ws + WS_GT);
    for (size_t i = gt; i < (size_t)2 * 16 * INNER; i += NT) { const int c = (int)(i & 8191), g = (int)(i >> 13) & 15, which = (int)(i >> 17);
        const int n = c >> 2, d = c & 3; float s = 0.f;
        if (which == 0) {
#pragma unroll
            for (int e = 0; e < 4; ++e) s += p.w_q[n * 16 + d * 4 + e] * p.w_gate[(size_t)(0 * INNER + 4 * n + e) * 16 + g] + p.w_k[n * 16 + d * 4 + e] * p.w_gate[(size_t)(1 * INNER + 4 * n + e) * 16 + g];
        } else {
#pragma unroll
            for (int e = 0; e < 4; ++e) s += p.w_v[n * 16 + d * 4 + e] * p.w_gate[(size_t)(2 * INNER + 4 * n + e) * 16 + g];
        }
        GT[i] = f2bf(s); }
}

template <bool SAMP>
DI void passA_item(const Frame& F, const Params& p, int tg, int cg, int step0 = 0, int nstep = 4) {
    unsigned char* ws = p.ws;
    const bf16_t* __restrict__ xm = (const bf16_t*)(ws + WS_XM); bf16_t* __restrict__ xa = (bf16_t*)(ws + WS_XA); const bf16_t* __restrict__ GT = (const bf16_t*)(ws + WS_GT); float* gates = (float*)(ws + WS_GATES);
    LAS f32x4* red = (LAS f32x4*)F.lds;
    LAS unsigned short* tVw = (LAS unsigned short*)(F.lds + 32768 + F.wave * 4096);
    const int fr = F.lane & 15, fq = F.lane >> 4;
    f32x4 accg[4];
#pragma unroll
    for (int j = 0; j < 4; ++j) accg[j] = (f32x4){0.f, 0.f, 0.f, 0.f};
    const int tokb = tg * 64 + fr;
    for (int step = step0; step < step0 + nstep; ++step) {
        const int c = cg * 1024 + F.wave * 128 + 32 * step + 8 * fq;
        f32x4 wv[5][2];
#pragma unroll
        for (int j = 0; j < 4; ++j) { wv[j][0] = *(const f32x4*)(p.w_mconv + (size_t)j * INNER + c); wv[j][1] = *(const f32x4*)(p.w_mconv + (size_t)j * INNER + c + 4); }
        wv[4][0] = *(const f32x4*)(p.b_mconv + c); wv[4][1] = *(const f32x4*)(p.b_mconv + c + 4);
        const bf16x8 ga = *(const bf16x8*)(GT + (size_t)(0 * 16 + fr) * INNER + c), gm = *(const bf16x8*)(GT + (size_t)(1 * 16 + fr) * INNER + c);
        f32x4 wvv[2][4];
        if (!SAMP) {
#pragma unroll
            for (int bb = 0; bb < 2; ++bb)
#pragma unroll
                for (int d = 0; d < 4; ++d) wvv[bb][d] = *(const f32x4*)(p.w_v + (size_t)((c >> 2) + bb) * 16 + 4 * d); }
#pragma unroll
      for (int th = 0; th < 2; ++th) {
        u32x4 raw[4][4];
#pragma unroll
        for (int tl = 2 * th; tl < 2 * th + 2; ++tl) { const int tok = tokb + 16 * tl; const int t = SAMP ? ((tok - TP) & 31) : (tok & 4095);
#pragma unroll
            for (int j = 0; j < 4; ++j) { const int back = (3 - j) < t ? (3 - j) : t;
                raw[tl][j] = *(const u32x4*)(xm + (size_t)(tok - back) * INNER + c); } }
#pragma unroll
        for (int tl = 2 * th; tl < 2 * th + 2; ++tl) { const int tok = tokb + 16 * tl; const int t = SAMP ? ((tok - TP) & 31) : (tok & 4095);
            float xc[8];
#pragma unroll
            for (int i = 0; i < 8; ++i) xc[i] = wv[4][i >> 2][i & 3];
#pragma unroll
            for (int j = 0; j < 4; ++j) { const int tj = t + j - 3; float xin[8]; unpack8(raw[tl][j], xin);
                if (tj < 0) {
                    if (SAMP) { const int bsm = (tok - TP) >> 5; const float* hp = p.st_mconv + (size_t)(bsm * 3 + tj + 3) * INNER + c; const f32x4 h0 = *(const f32x4*)hp, h1 = *(const f32x4*)(hp + 4);
                        xin[0] = h0[0]; xin[1] = h0[1]; xin[2] = h0[2]; xin[3] = h0[3]; xin[4] = h1[0]; xin[5] = h1[1]; xin[6] = h1[2]; xin[7] = h1[3]; }
                    else {
#pragma unroll
                        for (int i = 0; i < 8; ++i) xin[i] = 0.f; } }
#pragma unroll
                for (int i = 0; i < 8; ++i) xc[i] += wv[j][i >> 2][i & 3] * xin[i]; }
#pragma unroll
            for (int i = 0; i < 8; ++i) xc[i] = fsilu(xc[i]);
            const u32x4 xa4 = pack8(xc);
            *(u32x4*)(xa + (size_t)tok * INNER + c) = xa4;
            if (!SAMP) { u32x2 x8v; x8v.x = pk_fp8x4(xc[0] * FP8_SA_XA, xc[1] * FP8_SA_XA, xc[2] * FP8_SA_XA, xc[3] * FP8_SA_XA); x8v.y = pk_fp8x4(xc[4] * FP8_SA_XA, xc[5] * FP8_SA_XA, xc[6] * FP8_SA_XA, xc[7] * FP8_SA_XA);
                *(u32x2*)((unsigned char*)p.out + O8_XA8 + (size_t)tok * INNER + c) = x8v; }
            accg[tl] = __builtin_amdgcn_mfma_f32_16x16x32_bf16(__builtin_bit_cast(bf16x8, xa4), ga, accg[tl], 0, 0, 0);
            accg[tl] = __builtin_amdgcn_mfma_f32_16x16x32_bf16(__builtin_bit_cast(bf16x8, raw[tl][3]), gm, accg[tl], 0, 0, 0);
            if (!SAMP) {
                float xv[8]; unpack8(raw[tl][3], xv);
                const int col = 16 * tl + fr, dw = ((col >> 1) ^ (8 * fq)) << 1;
#pragma unroll
                for (int bb = 0; bb < 2; ++bb)
#pragma unroll
                    for (int e = 0; e < 4; ++e) { const float v = xv[4 * bb] * wvv[bb][0][e] + xv[4 * bb + 1] * wvv[bb][1][e] + xv[4 * bb + 2] * wvv[bb][2][e] + xv[4 * bb + 3] * wvv[bb][3][e];
                        tVw[(8 * fq + 4 * bb + e) * 64 + dw + (col & 1)] = f2bf(v); } }
        }
      }
        if (!SAMP) {
            asm volatile("s_waitcnt lgkmcnt(0)" ::: "memory");
#pragma unroll
            for (int k = 0; k < 4; ++k) { const int q = F.lane + 64 * k, row = q >> 3, ch = q & 7;
                const u32x4 vrow = *(const LAS u32x4*)(tVw + row * 64 + ((((4 * ch) ^ (8 * (row >> 3)))) << 1));
                const size_t chan = (size_t)(cg * 1024 + F.wave * 128 + 32 * step + row);
                *(u32x4*)((bf16_t*)(ws + WS_VT) + chan * TPP + tg * 64 + 8 * ch) = vrow;
                float vf[8]; unpack8(vrow, vf); u32x2 v8; v8.x = pk_fp8x4(vf[0] * FP8_SA_V, vf[1] * FP8_SA_V, vf[2] * FP8_SA_V, vf[3] * FP8_SA_V); v8.y = pk_fp8x4(vf[4] * FP8_SA_V, vf[5] * FP8_SA_V, vf[6] * FP8_SA_V, vf[7] * FP8_SA_V);
                *(u32x2*)(ws + WS_VT8 + chan * P8 + tg * 64 + 8 * ch) = v8; }
            asm volatile("s_waitcnt lgkmcnt(0)" ::: "memory"); }
    }
    __syncthreads();
#pragma unroll
    for (int tl = 0; tl < 4; ++tl) red[(F.wave * 4 + tl) * 64 + F.lane] = accg[tl];
    __syncthreads();
    if (F.tid < 256 && !F.dry) { const int tl = F.tid >> 6, ln = F.tid & 63; f32x4 sacc = (f32x4){0.f, 0.f, 0.f, 0.f};
#pragma unroll
        for (int w = 0; w < NWAVES; ++w) sacc += red[(w * 4 + tl) * 64 + ln];
#pragma unroll
        for (int j = 0; j < 4; ++j) atomicAdd(gates + (size_t)(tg * 64 + 16 * tl + 4 * (ln >> 4) + j) * 16 + (ln & 15), sacc[j]); }
}
DI void phase_passA(const Frame& F, const Params& p) {
    unsigned char* ws = p.ws;
    const bf16_t* xm = (const bf16_t*)(ws + WS_XM);
    for (int it = F.vcu; it < (TP / 64) * 8 + (TS / 64) * 8 * 4; it += F.G) { const int item = (TP / 64) * 8 + (TS / 64) * 8 * 4 - 1 - it;
        if (item < (TP / 64) * 8) passA_item<false>(F, p, item >> 3, item & 7);
        else { const int si = item - (TP / 64) * 8; passA_item<true>(F, p, TP / 64 + (si >> 5), (si >> 2) & 7, si & 3, 1); } }
    const size_t gt = (size_t)F.vcu * NTHR + F.tid, NT = (size_t)F.G * NTHR;
    for (size_t i = gt; i < (size_t)(4 + 16) * 3 * (INNER / 8); i += NT) { const int c8 = (int)(i & 1023) * 8, ri = (int)(i >> 10), sq = ri / 3, k = ri - sq * 3;
        size_t tok; float* dst;
        if (sq < 4) { tok = (size_t)sq * 4096 + 4093 + k; dst = p.out + O_PMC + (size_t)(sq * 3 + k) * INNER + c8; }
        else { const int b = sq - 4; tok = (size_t)TP + b * 32 + 29 + k; dst = p.out + O_SMC + (size_t)(b * 3 + k) * INNER + c8; }
        float f[8]; unpack8(*(const u32x4*)(xm + tok * INNER + c8), f);
        *(f32x4*)dst = (f32x4){f[0], f[1], f[2], f[3]}; *(f32x4*)(dst + 4) = (f32x4){f[4], f[5], f[6], f[7]}; }
}

DI void headwise8(const float (&x)[8], const float* W, int n0, float scale, float (&y)[8]) {
#pragma unroll
    for (int bb = 0; bb < 2; ++bb) { const float* w = W + (size_t)(n0 + bb) * 16; const f32x4 w0 = *(const f32x4*)w, w1 = *(const f32x4*)(w + 4), w2 = *(const f32x4*)(w + 8), w3 = *(const f32x4*)(w + 12);
#pragma unroll
        for (int e = 0; e < 4; ++e) y[4 * bb + e] = (x[4 * bb] * w0[e] + x[4 * bb + 1] * w1[e] + x[4 * bb + 2] * w2[e] + x[4 * bb + 3] * w3[e]) * scale; }
}

DI float block_excl_add(float v, LAS float* sm, int lane, int wave) {
    float incl = v;
#pragma unroll
    for (int o = 1; o < 64; o <<= 1) { const float t = __shfl_up(incl, o); if (lane >= o) incl += t; }
    __syncthreads();
    if (lane == 63) sm[wave] = incl;
    __syncthreads();
    float woff = 0.f;
#pragma unroll
    for (int w = 0; w < NWAVES; ++w) { const float t = sm[w]; if (w < wave) woff += t; }
    return woff + incl - v;
}
DI float block_excl_max(float v, LAS float* sm, int lane, int wave) {
    float incl = v;
#pragma unroll
    for (int o = 1; o < 64; o <<= 1) { const float t = __shfl_up(incl, o); if (lane >= o) incl = fmaxf(incl, t); }
    float excl = __shfl_up(incl, 1); if (lane == 0) excl = -3.0e38f;
    __syncthreads();
    if (lane == 63) sm[wave] = incl;
    __syncthreads();
    float woff = -3.0e38f;
#pragma unroll
    for (int w = 0; w < NWAVES; ++w) { const float t = sm[w]; if (w < wave) woff = fmaxf(woff, t); }
    return fmaxf(woff, excl);
}
DI void scan_prompt(const Frame& F, const Params& p, int bh) {
    unsigned char* ws = p.ws;
    const float* gates = (const float*)(ws + WS_GATES); float* cs = (float*)(ws + WS_CS); float* mx = (float*)(ws + WS_MX); float* em = (float*)(ws + WS_EM); float* mxl = (float*)(ws + WS_MXL);
    LAS float* sm = (LAS float*)(F.lds + 1024);
    const int b = bh >> 3, h = bh & 7; const float bi = p.b_gate[h], bf = p.b_gate[8 + h];
    const float* gp = gates + (size_t)(b * 4096 + 8 * F.tid) * 16;
    float ig[8], lf[8];
#pragma unroll
    for (int k = 0; k < 8; ++k) { ig[k] = gp[k * 16 + h]; lf[k] = gp[k * 16 + 8 + h]; }
    float s = 0.f;
#pragma unroll
    for (int k = 0; k < 8; ++k) { ig[k] += bi; lf[k] = logsig(lf[k] + bf); s += lf[k]; }
    float run = block_excl_add(s, sm, F.lane, F.wave);
    float c[8], B[8], mloc = -3.0e38f;
#pragma unroll
    for (int k = 0; k < 8; ++k) { run += lf[k]; B[k] = run; c[k] = ig[k] - run; mloc = fmaxf(mloc, c[k]); }
    float rm = fmaxf(0.f, block_excl_max(mloc, sm, F.lane, F.wave));
    f32x4 oc[2], om[2], oe[2];
#pragma unroll
    for (int k = 0; k < 8; ++k) { rm = fmaxf(rm, c[k]); oc[k >> 2][k & 3] = c[k]; om[k >> 2][k & 3] = rm; oe[k >> 2][k & 3] = expf(-(B[k] + rm)); }
    const size_t o = (size_t)bh * 4096 + 8 * F.tid;
    *(f32x4*)(cs + o) = oc[0]; *(f32x4*)(cs + o + 4) = oc[1]; *(f32x4*)(mx + o) = om[0]; *(f32x4*)(mx + o + 4) = om[1]; *(f32x4*)(em + o) = oe[0]; *(f32x4*)(em + o + 4) = oe[1];
    if (F.tid == NTHR - 1) { p.out[O_PM + bh] = B[7] + rm; mxl[bh] = rm; }
}

DI void sample_prep(const Frame& F, const Params& p, int bh) {
    unsigned char* ws = p.ws;
    const float* gates = (const float*)(ws + WS_GATES); const bf16_t* __restrict__ xa = (const bf16_t*)(ws + WS_XA); const bf16_t* __restrict__ xm = (const bf16_t*)(ws + WS_XM);
    bf16_t* __restrict__ Sp = (bf16_t*)(ws + WS_SSP); bf16_t* __restrict__ qt = (bf16_t*)(ws + WS_SQT); bf16_t* __restrict__ wkT = (bf16_t*)(ws + WS_SWK); bf16_t* __restrict__ vTs = (bf16_t*)(ws + WS_SVT); float* scb = (float*)(ws + WS_MXL + 1024);
    LAS float* red = (LAS float*)(F.lds + 4096);
    LAS float* scr = (LAS float*)(F.lds + F.wave * 512);
    const int lane = F.lane, b = bh >> 3, h = bh & 7, r = lane & 31, hf = lane >> 5, tok0 = TP + 32 * b;
    const float ig = gates[(size_t)(tok0 + r) * 16 + h] + p.b_gate[h], lf = logsig(gates[(size_t)(tok0 + r) * 16 + 8 + h] + p.b_gate[8 + h]);
    float bc = lf;
#pragma unroll
    for (int o = 1; o < 32; o <<= 1) { const float v = __shfl_up(bc, o, 32); if (r >= o) bc += v; }
    const float m0 = p.st_m[bh], c = ig - bc;
    float pmx = c;
#pragma unroll
    for (int o = 1; o < 32; o <<= 1) { const float v = __shfl_up(pmx, o, 32); if (r >= o) pmx = fmaxf(pmx, v); }
    const float mxt = fmaxf(m0, pmx), m_t = bc + mxt, inter = expf(m0 - mxt), emt = expf(-m_t);
    const float mx31 = __shfl(mxt, 31), b31 = __shfl(bc, 31);
    const float w_s = expf(c - mx31), scv = expf(m0 - mx31);
    const int dkw = 128 * F.wave;
    const bf16_t* xar = xa + (size_t)(tok0 + r) * INNER + h * 1024 + dkw + 8 * hf; const bf16_t* xmr = xm + (size_t)(tok0 + r) * INNER + h * 1024 + dkw + 8 * hf;
    const float* n0v = p.st_n + (size_t)bh * 1024 + dkw + 8 * hf;
    f32x16 accS;
#pragma unroll
    for (int i = 0; i < 16; ++i) accS[i] = 0.f;
    float qn = 0.f;
#pragma unroll 4
    for (int kk = 0; kk < 8; ++kk) {
        float x[8], q[8], k[8]; unpack8(*(const u32x4*)(xar + 16 * kk), x);
        const int n0 = (h * 1024 + dkw + 16 * kk + 8 * hf) >> 2;
        headwise8(x, p.w_q, n0, 1.0f, q); headwise8(x, p.w_k, n0, 0.03125f, k);
        const f32x4 na = *(const f32x4*)(n0v + 16 * kk), nb = *(const f32x4*)(n0v + 16 * kk + 4);
        qn += q[0] * na[0] + q[1] * na[1] + q[2] * na[2] + q[3] * na[3] + q[4] * nb[0] + q[5] * nb[1] + q[6] * nb[2] + q[7] * nb[3];
        accS = __builtin_amdgcn_mfma_f32_32x32x16_bf16(__builtin_bit_cast(bf16x8, pack8(q)), __builtin_bit_cast(bf16x8, pack8(k)), accS, 0, 0, 0);
    }
    __syncthreads();
#pragma unroll
    for (int i = 0; i < 16; ++i) red[(F.wave * 17 + i) * 64 + lane] = accS[i];
    red[(F.wave * 17 + 16) * 64 + lane] = qn;
    __syncthreads();
    qn = 0.f;
#pragma unroll
    for (int i = 0; i < 16; ++i) accS[i] = 0.f;
#pragma unroll
    for (int w = 0; w < NWAVES; ++w) {
#pragma unroll
        for (int i = 0; i < 16; ++i) accS[i] += red[(w * 17 + i) * 64 + lane];
        qn += red[(w * 17 + 16) * 64 + lane]; }
    qn += __shfl_xor(qn, 32);
    float sv[16];
#pragma unroll
    for (int i = 0; i < 16; ++i) { const int t = (i & 3) + 8 * (i >> 2) + 4 * hf; const float mxq = __shfl(mxt, t);
        const float d = (r <= t) ? expf(c - mxq) : 0.f; sv[i] = accS[i] * d;
        float rs = sv[i];
#pragma unroll
        for (int o = 1; o < 32; o <<= 1) rs += __shfl_xor(rs, o);
        if (r == 0) scr[t] = rs; }
    asm volatile("s_waitcnt lgkmcnt(0)" ::: "memory");
    const float den = scr[r] + inter * qn, g = 1.0f / fmaxf(fabsf(den), emt), f = inter * g;
    asm volatile("s_waitcnt lgkmcnt(0)" ::: "memory");
    if (hf == 0) scr[32 + r] = g;
    asm volatile("s_waitcnt lgkmcnt(0)" ::: "memory");
    if (F.wave == 0) {
#pragma unroll
        for (int i = 0; i < 16; ++i) { const int t = (i & 3) + 8 * (i >> 2) + 4 * hf; Sp[(size_t)(bh * 32 + t) * 32 + r] = f2bf(sv[i] * scr[32 + t]); } }
    asm volatile("s_waitcnt lgkmcnt(0)" ::: "memory");
#pragma unroll 2
    for (int kk = 0; kk < 8; ++kk) {
        float x[8], xv[8], q[8], k[8], v[8]; unpack8(*(const u32x4*)(xar + 16 * kk), x); unpack8(*(const u32x4*)(xmr + 16 * kk), xv);
        const int dk0 = dkw + 16 * kk + 8 * hf, n0 = (h * 1024 + dk0) >> 2;
        const float n0s[8] = {p.st_n[(size_t)bh * 1024 + dk0], p.st_n[(size_t)bh * 1024 + dk0 + 1], p.st_n[(size_t)bh * 1024 + dk0 + 2], p.st_n[(size_t)bh * 1024 + dk0 + 3],
                              p.st_n[(size_t)bh * 1024 + dk0 + 4], p.st_n[(size_t)bh * 1024 + dk0 + 5], p.st_n[(size_t)bh * 1024 + dk0 + 6], p.st_n[(size_t)bh * 1024 + dk0 + 7]};
        headwise8(x, p.w_q, n0, 1.0f, q); headwise8(x, p.w_k, n0, 0.03125f, k); headwise8(xv, p.w_v, n0, 1.0f, v);
#pragma unroll
        for (int i = 0; i < 8; ++i) q[i] *= f;
        *(u32x4*)(qt + (size_t)(bh * 32 + r) * 1024 + dk0) = pack8(q);
#pragma unroll
        for (int i = 0; i < 8; ++i) { const float wk = k[i] * w_s; wkT[(size_t)(bh * 1024 + dk0 + i) * 32 + r] = f2bf(wk); vTs[(size_t)(bh * 1024 + dk0 + i) * 32 + r] = f2bf(v[i]);
            float ns = wk;
#pragma unroll
            for (int o = 1; o < 32; o <<= 1) ns += __shfl_xor(ns, o);
            if (r == 0) p.out[O_SN + (size_t)bh * 1024 + dk0 + i] = scv * n0s[i] + ns; }
    }
    if (F.tid == 0) { p.out[O_SM + bh] = b31 + mx31; scb[bh] = scv; }
    __syncthreads();
}

DI void phase_passB(const Frame& F, const Params& p) {
    unsigned char* ws = p.ws;
    const bf16_t* __restrict__ xa = (const bf16_t*)(ws + WS_XA); const bf16_t* __restrict__ xm = (const bf16_t*)(ws + WS_XM); bf16_t* __restrict__ qp = (bf16_t*)(ws + WS_QP); bf16_t* __restrict__ kwT = (bf16_t*)(ws + WS_KWT); bf16_t* __restrict__ vT = (bf16_t*)(ws + WS_VT);
    const float* cs = (const float*)(ws + WS_CS); const float* mxl = (const float*)(ws + WS_MXL);
    unsigned char* __restrict__ q8 = (unsigned char*)p.out + O8_Q8; unsigned char* __restrict__ xa8 = (unsigned char*)p.out + O8_XA8;
    LAS bf16_t* tK = (LAS bf16_t*)F.lds;
    const int g = F.tid & 7, tl = F.tid >> 3;
    for (int item = F.vcu; item < 2048; item += F.G) {
        const int cb = item & 127, tb = item >> 7, b = tb >> 2, h = cb >> 4, bh = b * 8 + h, c = cb * 64 + 8 * g, n0 = c >> 2;
        float wqk[2][4][4], wkk[2][4][4], wvv[2][4][4];
#pragma unroll
        for (int bb = 0; bb < 2; ++bb) { float wq[4][4];
#pragma unroll
            for (int d = 0; d < 4; ++d) { const f32x4 a = *(const f32x4*)(p.w_q + (size_t)(n0 + bb) * 16 + 4 * d), k4 = *(const f32x4*)(p.w_k + (size_t)(n0 + bb) * 16 + 4 * d), v4 = *(const f32x4*)(p.w_v + (size_t)(n0 + bb) * 16 + 4 * d);
#pragma unroll
                for (int e = 0; e < 4; ++e) { wq[d][e] = a[e]; wkk[bb][d][e] = k4[e] * 0.03125f; wvv[bb][d][e] = v4[e]; } }
#pragma unroll
            for (int d = 0; d < 4; ++d)
#pragma unroll
                for (int d2 = 0; d2 < 4; ++d2) wqk[bb][d][d2] = wq[d][0] * wkk[bb][d2][0] + wq[d][1] * wkk[bb][d2][1] + wq[d][2] * wkk[bb][d2][2] + wq[d][3] * wkk[bb][d2][3]; }
        const float mxlast = mxl[bh];
        float nacc[8];
#pragma unroll
        for (int i = 0; i < 8; ++i) nacc[i] = 0.f;
        const int tokb = tb * 1024 + tl;
#pragma unroll 1
        for (int sub4 = 0; sub4 < 16; sub4 += 2) {
          u32x4 rxa[2];
#pragma unroll
          for (int u = 0; u < 2; ++u) { const int tk = tokb + (sub4 + u) * 64; rxa[u] = *(const u32x4*)(xa + (size_t)tk * INNER + c); }
          const float rcs0 = cs[bh * 4096 + ((tokb + sub4 * 64) & 4095)], rcs1 = cs[bh * 4096 + ((tokb + sub4 * 64 + 64) & 4095)];
#pragma unroll
          for (int u = 0; u < 2; ++u) {
            const int sub = sub4 + u, tok = tokb + sub * 64;
            const u32x4 cxa = rxa[u]; const float ccs = u ? rcs1 : rcs0;
            float x[8], q[8], kw[8]; unpack8(cxa, x);
            const float w = fexp(ccs - mxlast);
#pragma unroll
            for (int bb = 0; bb < 2; ++bb)
#pragma unroll
                for (int e = 0; e < 4; ++e) {
                    q[4 * bb + e] = x[4 * bb] * wqk[bb][0][e] + x[4 * bb + 1] * wqk[bb][1][e] + x[4 * bb + 2] * wqk[bb][2][e] + x[4 * bb + 3] * wqk[bb][3][e];
                    kw[4 * bb + e] = (x[4 * bb] * wkk[bb][0][e] + x[4 * bb + 1] * wkk[bb][1][e] + x[4 * bb + 2] * wkk[bb][2][e] + x[4 * bb + 3] * wkk[bb][3][e]) * w; }
            *(u32x4*)(qp + (size_t)tok * INNER + c) = pack8(q);
            { u32x2 q8v, x8v; q8v.x = pk_fp8x4(q[0] * FP8_SA_Q, q[1] * FP8_SA_Q, q[2] * FP8_SA_Q, q[3] * FP8_SA_Q); q8v.y = pk_fp8x4(q[4] * FP8_SA_Q, q[5] * FP8_SA_Q, q[6] * FP8_SA_Q, q[7] * FP8_SA_Q);
              *(u32x2*)(q8 + (size_t)tok * INNER + c) = q8v; (void)x8v; }
            LAS bf16_t* bK = tK + (sub & 1) * (64 * 72);
#pragma unroll
            for (int i = 0; i < 8; ++i) { nacc[i] += kw[i]; bK[(8 * i + g) * 72 + tl] = f2bf(kw[i]); }
            LDS_BARRIER();
            { const int row = F.tid >> 3, ch = F.tid & 7, chan = 8 * (row & 7) + (row >> 3); const size_t o = (size_t)(cb * 64 + chan) * TPP + tb * 1024 + sub * 64 + 8 * ch;
              *(u32x4*)(kwT + o) = *(const LAS u32x4*)(bK + row * 72 + 8 * ch); }
          }
        }
        LDS_BARRIER();
#pragma unroll
        for (int i = 0; i < 8; ++i) { float v = nacc[i]; v += __shfl_xor(v, 8); v += __shfl_xor(v, 16); v += __shfl_xor(v, 32);
            if (F.lane < 8 && !F.dry) atomicAdd(p.out + O_PN + (size_t)bh * 1024 + (c & 1023) + i, v); }
    }
}

DI void phase_sample_cell(const Frame& F, const Params& p) {
    unsigned char* ws = p.ws;
    const bf16_t* __restrict__ Sp = (const bf16_t*)(ws + WS_SSP); const bf16_t* __restrict__ qt = (const bf16_t*)(ws + WS_SQT); const bf16_t* __restrict__ wkT = (const bf16_t*)(ws + WS_SWK); const bf16_t* __restrict__ vTs = (const bf16_t*)(ws + WS_SVT);
    const float* scb = (const float*)(ws + WS_MXL + 1024); bf16_t* __restrict__ hs = (bf16_t*)(ws + WS_HS);
    const int r = F.lane & 31, hf = F.lane >> 5, gw = F.vcu * NWAVES + F.wave, NGW = F.G * NWAVES;
    for (int item = gw; item < 128 * 16; item += NGW) {
        const int bh = item >> 4, dvp = item & 15, b = bh >> 3, h = bh & 7;
        const __amdgpu_buffer_rsrc_t rC0 = __builtin_amdgcn_make_buffer_rsrc((void*)(p.st_C + ((size_t)bh << 20)), 0, 1 << 22, 0x00020000);
        const __amdgpu_buffer_rsrc_t rCn = __builtin_amdgcn_make_buffer_rsrc((void*)(p.out + O_SC + ((size_t)bh << 20)), 0, 1 << 22, 0x00020000);
        const unsigned voff = (unsigned)((4 * hf) * 1024 + r) * 4u; const int sbase = dvp * 256;
#define SC_OFF(dkt_, i_, d_) (sbase + ((dkt_) * 32 + ((i_) & 3) + 8 * ((i_) >> 2)) * 4096 + (d_) * 128)
        const float sc = scb[bh];
        bf16x8 vf[2][2], sf[2];
#pragma unroll
        for (int s2 = 0; s2 < 2; ++s2) { sf[s2] = *(const bf16x8*)(Sp + (size_t)(bh * 32 + r) * 32 + 16 * s2 + 8 * hf);
#pragma unroll
            for (int d = 0; d < 2; ++d) vf[d][s2] = *(const bf16x8*)(vTs + (size_t)(bh * 1024 + dvp * 64 + 32 * d + r) * 32 + 16 * s2 + 8 * hf); }
        f32x16 acch[2];
#pragma unroll
        for (int d = 0; d < 2; ++d) {
#pragma unroll
            for (int i = 0; i < 16; ++i) acch[d][i] = 0.f;
            acch[d] = __builtin_amdgcn_mfma_f32_32x32x16_bf16(sf[0], vf[d][0], acch[d], 0, 0, 0); acch[d] = __builtin_amdgcn_mfma_f32_32x32x16_bf16(sf[1], vf[d][1], acch[d], 0, 0, 0); }
        const bf16_t* qrow = qt + (size_t)(bh * 32 + r) * 1024 + 4 * hf; const bf16_t* wkrow = wkT + (size_t)(bh * 1024 + r) * 32 + 8 * hf;
        f32x16 cn[2];
#pragma unroll
        for (int d = 0; d < 2; ++d)
#pragma unroll
            for (int i = 0; i < 16; ++i) cn[d][i] = __uint_as_float(__builtin_amdgcn_raw_buffer_load_b32(rC0, voff, SC_OFF(0, i, d), 2));
        for (int dkt = 0; dkt < 32; ++dkt) {
            f32x16 c[2] = {cn[0], cn[1]};
            if (dkt < 31) {
#pragma unroll
                for (int d = 0; d < 2; ++d)
#pragma unroll
                    for (int i = 0; i < 16; ++i) cn[d][i] = __uint_as_float(__builtin_amdgcn_raw_buffer_load_b32(rC0, voff, SC_OFF(dkt + 1, i, d), 2)); }
            bf16x8 pa[2], wa[2];
#pragma unroll
            for (int s = 0; s < 2; ++s) { const u32x2 lo = *(const u32x2*)(qrow + dkt * 32 + 16 * s), hi = *(const u32x2*)(qrow + dkt * 32 + 16 * s + 8);
                u32x4 t4; t4.x = lo.x; t4.y = lo.y; t4.z = hi.x; t4.w = hi.y; pa[s] = __builtin_bit_cast(bf16x8, t4);
                wa[s] = *(const bf16x8*)(wkrow + (size_t)dkt * 32 * 32 + 16 * s); }
#pragma unroll
            for (int d = 0; d < 2; ++d) {
#pragma unroll
                for (int s = 0; s < 2; ++s) { u32x4 xs; xs.x = pk_bf16(c[d][8 * s], c[d][8 * s + 1]); xs.y = pk_bf16(c[d][8 * s + 2], c[d][8 * s + 3]); xs.z = pk_bf16(c[d][8 * s + 4], c[d][8 * s + 5]); xs.w = pk_bf16(c[d][8 * s + 6], c[d][8 * s + 7]);
                    acch[d] = __builtin_amdgcn_mfma_f32_32x32x16_bf16(pa[s], __builtin_bit_cast(bf16x8, xs), acch[d], 0, 0, 0); }
#pragma unroll
                for (int i = 0; i < 16; ++i) c[d][i] *= sc;
                c[d] = __builtin_amdgcn_mfma_f32_32x32x16_bf16(wa[0], vf[d][0], c[d], 0, 0, 0); c[d] = __builtin_amdgcn_mfma_f32_32x32x16_bf16(wa[1], vf[d][1], c[d], 0, 0, 0);
#pragma unroll
                for (int i = 0; i < 16; ++i) __builtin_amdgcn_raw_buffer_store_b32(__float_as_uint(c[d][i]), rCn, voff, SC_OFF(dkt, i, d), 2); }
        }
#pragma unroll
        for (int d = 0; d < 2; ++d)
#pragma unroll
            for (int i = 0; i < 16; ++i) { const int t = (i & 3) + 8 * (i >> 2) + 4 * hf; hs[(size_t)(b * 32 + t) * INNER + h * 1024 + dvp * 64 + 32 * d + r] = f2bf(acch[d][i]); }
#undef SC_OFF
    }
}

DI void phase_predown(const Frame& F, const Params& p) {
    unsigned char* ws = p.ws;
    const bf16_t* __restrict__ hb = (const bf16_t*)(ws + WS_H); const bf16_t* __restrict__ hs = (const bf16_t*)(ws + WS_HS); const bf16_t* __restrict__ xa = (const bf16_t*)(ws + WS_XA); const bf16_t* __restrict__ sz = (const bf16_t*)(ws + WS_SZ);
    unsigned char* __restrict__ pre = ws + WS_PRE;
    const int gw = F.vcu * NWAVES + F.wave, NGW = F.G * NWAVES;
    if ((NGW & 7) != 0) return;
    const int h = gw & 7, cc0 = h * 1024 + 8 * F.lane;
    f32x4 gk[2][4];
#pragma unroll
    for (int j = 0; j < 2; ++j) { gk[j][0] = *(const f32x4*)(p.mh_gain + cc0 + 512 * j); gk[j][1] = *(const f32x4*)(p.mh_gain + cc0 + 512 * j + 4); gk[j][2] = *(const f32x4*)(p.skip + cc0 + 512 * j); gk[j][3] = *(const f32x4*)(p.skip + cc0 + 512 * j + 4); }
    u32x4 nh[2], na[2], nz[2];
#define PD_LOAD(item_) do { const int tok_ = (item_) >> 3; const bf16_t* hrow_ = tok_ < TP ? hb + (size_t)tok_ * INNER + cc0 : hs + (size_t)(tok_ - TP) * INNER + cc0; \
        _Pragma("unroll") for (int j = 0; j < 2; ++j) { nh[j] = ld_nt((const u32x4*)(hrow_ + 512 * j)); na[j] = ld_nt((const u32x4*)(xa + (size_t)tok_ * INNER + cc0 + 512 * j)); nz[j] = ld_nt((const u32x4*)(sz + (size_t)tok_ * INNER + cc0 + 512 * j)); } } while (0)
    if (gw < TT * NH) PD_LOAD(gw);
    for (int item = gw; item < TT * NH; item += NGW) {
        const int tok = item >> 3;
        u32x4 ch[2] = {nh[0], nh[1]}, ca[2] = {na[0], na[1]}, cz[2] = {nz[0], nz[1]};
        if (item + NGW < TT * NH) PD_LOAD(item + NGW);
        float v[2][8]; float s = 0.f;
#pragma unroll
        for (int j = 0; j < 2; ++j) { unpack8(ch[j], v[j]);
#pragma unroll
            for (int i = 0; i < 8; ++i) s += v[j][i]; }
        const float mean = wave_sum(s) * (1.0f / 1024.0f); float s2 = 0.f;
#pragma unroll
        for (int j = 0; j < 2; ++j)
#pragma unroll
            for (int i = 0; i < 8; ++i) { v[j][i] -= mean; s2 += v[j][i] * v[j][i]; }
        const float rstd = 1.0f / sqrtf(wave_sum(s2) * (1.0f / 1024.0f) + LN_EPS);
#pragma unroll
        for (int j = 0; j < 2; ++j) { float a[8], z[8], o[8]; unpack8(ca[j], a); unpack8(cz[j], z);
#pragma unroll
            for (int i = 0; i < 4; ++i) { o[i] = (v[j][i] * rstd * gk[j][0][i] + gk[j][2][i] * a[i]) * z[i]; o[4 + i] = (v[j][4 + i] * rstd * gk[j][1][i] + gk[j][3][i] * a[4 + i]) * z[4 + i]; }
            u32x2 w8; w8.x = pk_fp8x4(o[0] * FP8_SA_PRE, o[1] * FP8_SA_PRE, o[2] * FP8_SA_PRE, o[3] * FP8_SA_PRE); w8.y = pk_fp8x4(o[4] * FP8_SA_PRE, o[5] * FP8_SA_PRE, o[6] * FP8_SA_PRE, o[7] * FP8_SA_PRE);
            *(u32x2*)(pre + (size_t)tok * INNER + cc0 + 512 * j) = w8; }
    }
#undef PD_LOAD
}

DI void ln_rows(const Frame& F, const bf16_t* src, const float* rstat, const float* part, const float* g, const float* bta, float* dstA, float* dstB, bf16_t* dstb, unsigned char* dstq, float* lnst) {
    const int gw = F.vcu * NWAVES + F.wave, NGW = F.G * NWAVES;
    LAS f32x4* gl = (LAS f32x4*)F.lds; LAS f32x4* bl = gl + DM / 4;
    __syncthreads();
    for (int i = F.tid; i < DM / 4; i += NTHR) { gl[i] = *(const f32x4*)(g + 4 * i); bl[i] = *(const f32x4*)(bta + 4 * i); }
    __syncthreads();
    constexpr int TV = TP + 4 * TS;
    for (int vr = gw + ((TV - 1 - gw) / NGW) * NGW; vr >= 0; vr -= NGW) {
        int row = vr;
        if (vr >= TP) { if ((vr - TP) & 3) continue; row = TP + ((vr - TP) >> 2); }
        f32x4 v[16]; float mean, rstd;
        if (row < TP) { const u32x2* xr = (const u32x2*)(src + (size_t)row * DM) + F.lane;
#pragma unroll
            for (int j = 0; j < 16; ++j) { const u32x2 w = xr[64 * j]; v[j] = (f32x4){bf_lo(w.x), bf_hi(w.x), bf_lo(w.y), bf_hi(w.y)}; }
            mean = rstat[(size_t)row * 2] * (1.0f / DM); rstd = 1.0f / sqrtf(fmaxf(rstat[(size_t)row * 2 + 1] * (1.0f / DM) - mean * mean, 0.f) + LN_EPS);
#pragma unroll
            for (int j = 0; j < 16; ++j) v[j] = v[j] - mean;
        } else {
#pragma unroll
            for (int j = 0; j < 16; ++j) v[j] = (f32x4){0.f, 0.f, 0.f, 0.f};
#pragma unroll 1
            for (int sp = 0; sp < 8; ++sp) { const f32x4* xr = (const f32x4*)(part + ((size_t)sp * TS + (row - TP)) * DM) + F.lane; f32x4 t[16];
#pragma unroll
                for (int j = 0; j < 16; ++j) t[j] = xr[64 * j];
                __builtin_amdgcn_sched_barrier(0);
#pragma unroll
                for (int j = 0; j < 16; ++j) v[j] += t[j]; }
            float s = 0.f;
#pragma unroll
            for (int j = 0; j < 16; ++j) s += (v[j][0] + v[j][1]) + (v[j][2] + v[j][3]);
            mean = wave_sum(s) * (1.0f / DM); float s2 = 0.f;
#pragma unroll
            for (int j = 0; j < 16; ++j) { v[j] = v[j] - mean; s2 += (v[j][0] * v[j][0] + v[j][1] * v[j][1]) + (v[j][2] * v[j][2] + v[j][3] * v[j][3]); }
            rstd = 1.0f / sqrtf(wave_sum(s2) * (1.0f / DM) + LN_EPS); }
        float* drow = row < TP ? (dstA ? dstA + (size_t)row * DM : nullptr) : dstB + (size_t)(row - TP) * DM;
        if (lnst && row < TP && F.lane == 0) { lnst[(size_t)row * 2] = mean; lnst[(size_t)row * 2 + 1] = rstd; }
        const bool wb = dstb && (row >= TP || ((row >> 8) & 15) == 15);
#pragma unroll
        for (int j = 0; j < 16; ++j) { const int cc = 4 * F.lane + 256 * j; const f32x4 gg = gl[F.lane + 64 * j], bb = bl[F.lane + 64 * j]; const f32x4 o = v[j] * rstd * gg + bb;
            if (drow) { if (dstq) *(f32x4*)(drow + cc) = o; else st_nt((f32x4*)(drow + cc), o); }
            if (wb) { u32x2 w; w.x = pk_bf16(o[0], o[1]); w.y = pk_bf16(o[2], o[3]); *(u32x2*)(dstb + (size_t)row * DM + cc) = w; }
            if (dstq) {
                *(unsigned*)(dstq + (size_t)row * DM + cc) = pk_fp8x4(o[0] * FP8_SA_X1, o[1] * FP8_SA_X1, o[2] * FP8_SA_X1, o[3] * FP8_SA_X1); } }
    }
}

DI void phase_conv31(const Frame& F, const Params& p) {
    unsigned char* ws = p.ws;
    const bf16_t* ub = (const bf16_t*)(ws + WS_U); bf16_t* cb = (bf16_t*)(ws + WS_C); float* stats = (float*)(ws + WS_STATS);
    LAS bf16_t* T = (LAS bf16_t*)F.lds;
    float w[31][2]; float2 bv = make_float2(0.f, 0.f); bool wloaded = false; int wcq = -1;
    for (int it = F.vcu; it < (TT / 32) * 4; it += F.G) { const int item = (TT / 32) * 4 - 1 - it;
        const int tt = item >> 2, cq = item & 3, cbase = cq * 1024, ch = cbase + 2 * F.tid, tok0 = tt * 32;
        const bool samp = tok0 >= TP; const int t0 = samp ? 0 : (tok0 & 4095), bsm = samp ? ((tok0 - TP) >> 5) : 0;
        __syncthreads();
        for (int i = F.tid; i < 62 * 128; i += NTHR) { const int row = i >> 7, c8 = (i & 127) * 8; u32x4 v = (u32x4){0u, 0u, 0u, 0u};
            if (row >= 30 || t0 > 0) v = *(const u32x4*)(ub + (size_t)(tok0 - 30 + row) * DM + cbase + c8);
            else if (samp) { const float* hp = p.st_cconv + (size_t)(bsm * 30 + row) * DM + cbase + c8; const f32x4 h0 = *(const f32x4*)hp, h1 = *(const f32x4*)(hp + 4);
                v.x = pk_bf16(h0[0], h0[1]); v.y = pk_bf16(h0[2], h0[3]); v.z = pk_bf16(h1[0], h1[1]); v.w = pk_bf16(h1[2], h1[3]); }
            *(LAS u32x4*)(T + row * 1024 + c8) = v; }
        __syncthreads();
        if (!wloaded || cq != wcq) { wloaded = true; wcq = cq;
#pragma unroll
            for (int j = 0; j < 31; ++j) { const float2 wv = *(const float2*)(p.w_dw + (size_t)j * DM + ch); w[j][0] = wv.x; w[j][1] = wv.y; }
            bv = *(const float2*)(p.b_dw + ch); }
        float sv[64];
#pragma unroll
        for (int tq = 0; tq < 4; ++tq) {
            float x[38][2];
#pragma unroll
            for (int i = 0; i < 38; ++i) { const unsigned raw = *(const LAS unsigned*)(T + (8 * tq + i) * 1024 + 2 * F.tid); x[i][0] = bf_lo(raw); x[i][1] = bf_hi(raw); }
#pragma unroll
            for (int o = 0; o < 8; ++o) { float a0 = bv.x, a1 = bv.y;
#pragma unroll
                for (int j = 0; j < 31; ++j) { a0 += w[j][0] * x[o + j][0]; a1 += w[j][1] * x[o + j][1]; }
                const int tok = tok0 + 8 * tq + o;
                *(unsigned*)(cb + (size_t)tok * DM + ch) = pk_bf16(a0, a1);
                sv[8 * tq + o] = a0 + a1; sv[32 + 8 * tq + o] = a0 * a0 + a1 * a1; }
        }
#pragma unroll
        for (int st = 0; st < 6; ++st) { const int off = 32 >> st, n2 = 32 >> st; const bool up = (F.lane & off) != 0;
#pragma unroll
            for (int i = 0; i < n2; ++i) { const float keep = up ? sv[i + n2] : sv[i], send = up ? sv[i] : sv[i + n2]; sv[i] = keep + __shfl_xor(send, off); } }
        if (!F.dry) atomicAdd(stats + (size_t)(tok0 + (F.lane & 31)) * 2 + (F.lane >> 5), sv[0]);
    }
    __syncthreads();
    const size_t gt = (size_t)F.vcu * NTHR + F.tid, NT = (size_t)F.G * NTHR;
    for (size_t i = gt; i < (size_t)(4 + 16) * 30 * (DM / 8); i += NT) { const int c8 = (int)(i & 511) * 8, ri = (int)(i >> 9), sq = ri / 30, k = ri - sq * 30;
        size_t tok; float* dst;
        if (sq < 4) { tok = (size_t)sq * 4096 + 4066 + k; dst = p.out + O_PCC + (size_t)(sq * 30 + k) * DM + c8; }
        else { const int b = sq - 4; tok = (size_t)TP + b * 32 + 2 + k; dst = p.out + O_SCC + (size_t)(b * 30 + k) * DM + c8; }
        float f[8]; unpack8(*(const u32x4*)(ub + tok * DM + c8), f);
        *(f32x4*)dst = (f32x4){f[0], f[1], f[2], f[3]}; *(f32x4*)(dst + 4) = (f32x4){f[4], f[5], f[6], f[7]}; }
}

DI void phase_norm2(const Frame& F, const Params& p) {
    unsigned char* ws = p.ws;
    const bf16_t* __restrict__ cb = (const bf16_t*)(ws + WS_C); const bf16_t* __restrict__ szg = (const bf16_t*)(ws + WS_SZG); const float* __restrict__ stats = (const float*)(ws + WS_STATS);
    unsigned char* __restrict__ pre2 = ws + WS_PRE2;
    const size_t gt = (size_t)F.vcu * NTHR + F.tid, NT = (size_t)F.G * NTHR, NI = (size_t)TT * (DM / 8);
    if ((NT & 511) != 0) return;
    const int c8 = (int)(gt & 511) * 8;
    const f32x4 g0 = *(const f32x4*)(p.cln_g + c8), g1 = *(const f32x4*)(p.cln_g + c8 + 4), b0 = *(const f32x4*)(p.cln_b + c8), b1 = *(const f32x4*)(p.cln_b + c8 + 4);
    for (size_t i0 = gt; i0 < NI; i0 += 4 * NT) {
        u32x4 cc[4], cz[4]; float s1[4], s2[4];
#pragma unroll
        for (int u = 0; u < 4; ++u) { const size_t i = i0 + (size_t)u * NT; if (i < NI) { const size_t tok_ = i >> 9; cc[u] = *(const u32x4*)(cb + tok_ * DM + c8); cz[u] = *(const u32x4*)(szg + tok_ * DM + c8); s1[u] = stats[tok_ * 2]; s2[u] = stats[tok_ * 2 + 1]; } }
#pragma unroll
        for (int u = 0; u < 4; ++u) { const size_t i = i0 + (size_t)u * NT; if (i < NI) { const size_t tok = i >> 9;
            const float mean = s1[u] * (1.0f / DM), var = fmaxf(s2[u] * (1.0f / DM) - mean * mean, 0.f), rstd = 1.0f / sqrtf(var + LN_EPS);
            float c[8], z[8], o[8]; unpack8(cc[u], c); unpack8(cz[u], z);
#pragma unroll
            for (int k = 0; k < 4; ++k) { o[k] = fsilu((c[k] - mean) * rstd * g0[k] + b0[k]) * z[k]; o[4 + k] = fsilu((c[4 + k] - mean) * rstd * g1[k] + b1[k]) * z[4 + k]; }
            u32x2 w8; w8.x = pk_fp8x4(o[0] * FP8_SA_PRE2, o[1] * FP8_SA_PRE2, o[2] * FP8_SA_PRE2, o[3] * FP8_SA_PRE2); w8.y = pk_fp8x4(o[4] * FP8_SA_PRE2, o[5] * FP8_SA_PRE2, o[6] * FP8_SA_PRE2, o[7] * FP8_SA_PRE2);
            *(u32x2*)(pre2 + tok * DM + c8) = w8; } }
    }
}

constexpr int N_PHASES = 16;
constexpr int LDS_BYTES = 147456;
constexpr int MISC_OFF = 131072;

__global__ void __launch_bounds__(NTHR, 2) mlstm_conformer_fwd(Params p) {
    extern __shared__ __attribute__((aligned(16))) unsigned char lds_raw[];
    Frame F; F.lds = (LAS unsigned char*)lds_raw; F.wave = __builtin_amdgcn_readfirstlane((int)threadIdx.x >> 6); F.lane = lane_id(); F.tid = F.wave * 64 + F.lane;
    F.G = gridDim.x; F.bx = blockIdx.x; F.vcu = (F.G % 8 == 0) ? (F.bx % 8) * (F.G / 8) + F.bx / 8 : F.bx;
    volatile LAS unsigned* MISC = (volatile LAS unsigned*)(F.lds + MISC_OFF);
    if (F.tid < 64) MISC[F.tid] = 0u;
    __syncthreads();
    unsigned char* ws = p.ws;
#if MK_LAUNCHES == 1
    XcdBarrier bar = xcd_barrier_post((unsigned*)(ws + WS_BAR), MISC + 8, F.wave);
#define GRID_BAR() xcd_barrier(bar)
#else
#define GRID_BAR() do { } while (0)
#endif
    const int lo = p.ph_lo, hi = p.ph_hi;
#ifndef PHMASK
#define PHMASK 0xFFFF
#endif
#define IN(k) (((PHMASK >> (k)) & 1) && lo <= (k) && (k) < hi)
#define SEAM(k) do { if (IN(k) && IN((k) + 1)) GRID_BAR(); } while (0)
    LAS unsigned char* ring = F.lds;

#ifndef P5PARTS
#define P5PARTS 7
#endif
#ifndef REPMASK
#define REPMASK 0
#endif
#define NREP(k) ((((REPMASK) >> (k)) & 1) + 1)
#define RUN(k, ...) do { if (IN(k)) { _Pragma("unroll") for (int rep = 0; rep < NREP(k); ++rep) { F.dry = rep; { int t_ = F.wave * 64 + lane_id(); asm volatile("" : "+v"(t_)); F.tid = t_; F.lane = t_ & 63; } __VA_ARGS__; if (rep + 1 < NREP(k)) GRID_BAR(); } } SEAM(k); } while (0)
    F.dry = 0;
    RUN(0, phase_prologue(F, p));
    RUN(1, {
        const bool side_first = ((F.bx & 7) & 1) != 0;
        if (side_first) { transpose_weight_fp8(F, p.w_down, INNER, DM, ws + WS_WDOWN, FP8_SB_W); __syncthreads(); }
        { g8::DenseSched S; S.init(ws + WS_XQ, ws + WS_WZQ, TT, INNER, DM, F.G, (F.G == 256) ? ((F.bx + 192) & 255) : F.bx); S.wave = F.wave;
          if (F.G == 256) { S.rag_r0 = 7; S.rag_w1 = 192; S.rag_w2 = 128; }
          EpiUp E{(bf16_t*)(ws + WS_SZ), 1, 1.0f / (FP8_SA_X * FP8_SB_WZ)};
          g8::gemm_phase<EpiUp, g8::DenseSched, false, true>(ring, DM, DM, S, E); }
        { g8::DenseSched S; S.init(ws + WS_XB, ws + WS_WUP, TT, INNER, DM * 2, F.G, F.bx); S.wave = F.wave;
          EpiUp E{(bf16_t*)(ws + WS_XM), 0, 1.0f};
          g8::gemm_phase<EpiUp, g8::DenseSched, false, false>(ring, DM * 2, DM * 2, S, E); }
        if (!side_first) transpose_weight_fp8(F, p.w_down, INNER, DM, ws + WS_WDOWN, FP8_SB_W); });
    RUN(2, phase_passA(F, p));
    RUN(3, { for (int it = F.vcu; it < 32; it += F.G) scan_prompt(F, p, it); });
    RUN(4, { for (int it = F.G - 1 - F.vcu; it < 128; it += F.G) sample_prep(F, p, it);
             phase_passB(F, p); });
    RUN(5, {
        const bool cell_first = ((F.bx & 7) & 1) != 0;
        if ((P5PARTS & 4) && cell_first) _Pragma("unroll") for (int r2 = 0; r2 < NREP(18); ++r2) phase_sample_cell(F, p);
        if (P5PARTS & 1) _Pragma("unroll") for (int r2 = 0; r2 < NREP(16); ++r2) {
          { SchedS S{(const char*)(ws + WS_QP), (const char*)(ws + WS_XA), F.G, F.vcu, 0, F.wave};
            EpiS E{(bf16_t*)(ws + WS_S), (const float*)(ws + WS_CS), (const float*)(ws + WS_MX), (float*)(ws + WS_DEN), F.dry | r2, 1.0f, 0};
            g8::gemm_phase<EpiS, SchedS, false, false>(ring, INNER * 2, INNER * 2, S, E); }
          { SchedS S{(const char*)p.out + O8_Q8, (const char*)p.out + O8_XA8, F.G, (F.G == 256) ? ((F.vcu + 32) & 255) : F.vcu, 1, F.wave};
            EpiS E{(bf16_t*)(ws + WS_S), (const float*)(ws + WS_CS), (const float*)(ws + WS_MX), (float*)(ws + WS_DEN), F.dry | r2, 1.0f, 1};
            g8::gemm_phase<EpiS, SchedS, false, true>(ring, INNER, INNER, S, E, 0x75757575  , 0x7b7b7b7b  ); } }
        if (P5PARTS & 2) _Pragma("unroll") for (int r2 = 0; r2 < NREP(17); ++r2) { SchedState S{(const char*)(ws + WS_KWT), (const char*)(ws + WS_VT), F.G, F.vcu, F.wave};
          EpiState E{p.out + O_PC};
          g8::gemm_phase<EpiState, SchedState, false>(ring, TPP * 2, TPP * 2, S, E); }
        if ((P5PARTS & 4) && !cell_first) _Pragma("unroll") for (int r2 = 0; r2 < NREP(18); ++r2) phase_sample_cell(F, p); });
    RUN(6, {
        SchedSV S{(const char*)(ws + WS_S8), (const char*)(ws + WS_S16), (const char*)(ws + WS_VT8), (const char*)(ws + WS_VT), F.G, F.vcu, F.wave};
        EpiSV E{(bf16_t*)(ws + WS_H), (const float*)(ws + WS_DEN), (const float*)(ws + WS_EM)};
        g8::gemm_phase_mixed<EpiSV, SchedSV>(ring, P8, TPP * 2, S, E, 0x7b7b7b7b  , 0x79797979  ); });
    RUN(7, phase_predown(F, p));
    RUN(8, {
        const bool side_first = ((F.bx & 7) & 1) != 0;
        if (side_first) { transpose_weight(F, p.w_cin, DM, 3 * DM, (bf16_t*)(ws + WS_WCIN), true, ws + WS_WCINQ, FP8_SB_WCIN); transpose_weight_fp8(F, p.w_cout, DM, DM, ws + WS_WCOUT, FP8_SB_W); __syncthreads(); }
        g8::DenseSched S; S.init(ws + WS_PRE, ws + WS_WDOWN, TT, DM, INNER, F.G, F.bx, TP / 256, 8); S.wave = F.wave;
        EpiRes E{p.x_prompt, p.x_sample, nullptr, (bf16_t*)(ws + WS_R), (float*)(ws + WS_PART), 1.0f / (FP8_SA_PRE * FP8_SB_W), (float*)(ws + WS_RST0), nullptr, nullptr, nullptr, nullptr};
        g8::gemm_phase<EpiRes, g8::DenseSched, false, true>(ring, INNER, INNER, S, E);
        if (!side_first) { transpose_weight(F, p.w_cin, DM, 3 * DM, (bf16_t*)(ws + WS_WCIN), true, ws + WS_WCINQ, FP8_SB_WCIN); transpose_weight_fp8(F, p.w_cout, DM, DM, ws + WS_WCOUT, FP8_SB_W); } });
    RUN(9, {
        ln_rows(F, (const bf16_t*)(ws + WS_R), (const float*)(ws + WS_RST0), (const float*)(ws + WS_PART), p.pln_g, p.pln_b, nullptr, (float*)(ws + WS_X1F), (bf16_t*)(ws + WS_X1B), ws + WS_X1Q, (float*)(ws + WS_LNST));
        });
    RUN(10, {
        { g8::DenseSched S; if (F.G == 256) S.init(ws + WS_X1B, ws + WS_WCIN, 6 * 256, 3 * DM, DM * 2, 144, F.bx < 144 ? F.bx : 100000); else S.init(ws + WS_X1B, ws + WS_WCIN, 6 * 256, 3 * DM, DM * 2, F.G, F.bx);
          S.wave = F.wave; S.pmode = 2;
          EpiCin E{(bf16_t*)(ws + WS_U), (bf16_t*)(ws + WS_SZG), p.b_cin, 1.0f};
          g8::gemm_phase<EpiCin, g8::DenseSched, false, false>(ring, DM * 2, DM * 2, S, E); }
        { g8::DenseSched S; S.init(ws + WS_X1Q, ws + WS_WCINQ, 60 * 256, 3 * DM, DM, F.G, (F.G == 256) ? ((F.bx + 112) & 255) : F.bx); S.wave = F.wave; S.pmode = 1;
          if (F.G == 256) { S.rag_r0 = 10; S.rag_w1 = 112; S.rag_w2 = 112; S.rag_w3 = 96; }
          EpiCin E{(bf16_t*)(ws + WS_U), (bf16_t*)(ws + WS_SZG), p.b_cin, 1.0f / (FP8_SA_X1 * FP8_SB_WCIN)};
          g8::gemm_phase<EpiCin, g8::DenseSched, false, true>(ring, DM, DM, S, E); } });
    RUN(11, phase_conv31(F, p));
    RUN(12, phase_norm2(F, p));
    RUN(13, {
        g8::DenseSched S; S.init(ws + WS_PRE2, ws + WS_WCOUT, TT, DM, DM, F.G, F.bx, TP / 256, 8); S.wave = F.wave;
        EpiRes E{nullptr, (const float*)(ws + WS_X1F), p.b_cout, (bf16_t*)(ws + WS_R2), (float*)(ws + WS_PART), 1.0f / (FP8_SA_PRE2 * FP8_SB_W), (float*)(ws + WS_RST1), (const bf16_t*)(ws + WS_R), (const float*)(ws + WS_LNST), p.pln_g, p.pln_b};
        g8::gemm_phase<EpiRes, g8::DenseSched, false, true>(ring, DM, DM, S, E); });
    RUN(14, ln_rows(F, (const bf16_t*)(ws + WS_R2), (const float*)(ws + WS_RST1), (const float*)(ws + WS_PART), p.pln_g + DM, p.pln_b + DM, p.out + O_YP, p.out + O_YS, nullptr, nullptr, nullptr));
#undef RUN
#undef NREP
#undef IN
#undef SEAM
}

extern "C" void kernel_launch(void* const* d_in, const int* in_sizes, int n_in, void* d_out, int out_size, void* d_ws, size_t ws_size, hipStream_t stream) {
    static int grid = 0;
    if (grid == 0) {
        if (n_in != 28 || (size_t)out_size != O_END || ws_size < WS_END) { fprintf(stderr, "kernel_launch: unexpected shapes (n_in %d, out %d, ws %zu); nothing launched\n", n_in, out_size, ws_size); grid = -1; return; }
        int dev = 0, cus = 0;
        if (hipGetDevice(&dev) != hipSuccess || hipDeviceGetAttribute(&cus, hipDeviceAttributeMultiprocessorCount, dev) != hipSuccess) { grid = -1; return; }
        if (hipFuncSetAttribute((const void*)mlstm_conformer_fwd, hipFuncAttributeMaxDynamicSharedMemorySize, LDS_BYTES) != hipSuccess) { fprintf(stderr, "kernel_launch: hipFuncSetAttribute failed\n"); grid = -1; return; }
        int per_cu = 0;
        if (hipOccupancyMaxActiveBlocksPerMultiprocessor(&per_cu, (const void*)mlstm_conformer_fwd, NTHR, LDS_BYTES) != hipSuccess || per_cu < 1) { fprintf(stderr, "kernel_launch: occupancy query says %d\n", per_cu); }
        (void)hipGetLastError();
        grid = cus;
    }
    if (grid < 0) return;
    (void)hipMemsetAsync((char*)d_ws, 0, WS_GATES, stream);
    Params p{};
    const float** pf = (const float**)&p;
    for (int i = 0; i < 28; ++i) pf[i] = (const float*)d_in[i];
    p.out = (float*)d_out; p.ws = (unsigned char*)d_ws;
#if MK_LAUNCHES == 1
    p.ph_lo = 0; p.ph_hi = N_PHASES;
    hipLaunchKernelGGL(mlstm_conformer_fwd, dim3(grid), dim3(NTHR), LDS_BYTES, stream, p);
#else
    for (int k = 0; k < 15; ++k) { p.ph_lo = k; p.ph_hi = k + 1; hipLaunchKernelGGL(mlstm_conformer_fwd, dim3(grid), dim3(NTHR), LDS_BYTES, stream, p); }
#endif
}
```

```cpp
#include <hip/hip_runtime.h>
#include <cstdio>
#include <cstdint>

#ifndef MK_LAUNCHES
#define MK_LAUNCHES 1
#endif

#define LAS __attribute__((address_space(3)))
typedef unsigned short bf16_t;
typedef short bf16x8 __attribute__((ext_vector_type(8)));
typedef float f32x4 __attribute__((ext_vector_type(4)));
typedef float f32x16 __attribute__((ext_vector_type(16)));
typedef unsigned u32x4 __attribute__((ext_vector_type(4)));
typedef unsigned u32x2 __attribute__((ext_vector_type(2)));
#define DI __device__ __forceinline__

constexpr int DM = 4096, INNER = 8192, NH = 8, DKV = 1024;
constexpr int TPP = 16384 + 64;
constexpr int TP = 16384, TS = 512, TT = TP + TS;
constexpr float ALPHA = 1.41421356237309515f, LN_EPS = 1e-5f;
constexpr int NWAVES = 8, NTHR = 512;

constexpr size_t O_YP = 0, O_YS = 67108864, O_PC = 69206016, O_PN = 102760448, O_PM = 102793216, O_PMC = 102793248, O_PCC = 102891552,
                 O_SC = 103383072, O_SN = 237600800, O_SM = 237731872, O_SMC = 237732000, O_SCC = 238125216, O_END = 240091296;

constexpr size_t MiB = 1u << 20;
constexpr size_t O8_Q8 = 0, O8_XA8 = (size_t)TP * INNER;
constexpr size_t WS_BAR = 0;
constexpr size_t WS_GATES = 64 * 1024;
constexpr size_t WS_DEN = WS_GATES + (size_t)TT * 16 * 4;
constexpr size_t WS_STATS = WS_DEN + (size_t)TP * 8 * 4;
constexpr size_t WS_RST0 = WS_STATS + (size_t)TT * 2 * 4, WS_RST1 = WS_RST0 + (size_t)TP * 2 * 4;
constexpr size_t WS_ZERO_BYTES = 3 * MiB;
static_assert(WS_RST1 + (size_t)TP * 2 * 4 <= WS_ZERO_BYTES, "zero region");
constexpr size_t WS_CS = 3 * MiB, WS_MX = WS_CS + 512 * 1024, WS_EM = WS_MX + 512 * 1024;
constexpr size_t WS_MXL = WS_EM + 512 * 1024;
constexpr size_t WS_GT = 5 * MiB;
constexpr size_t WS_WDOWN = 8 * MiB;
constexpr size_t WS_SZ = 72 * MiB;
constexpr size_t WS_XA = 336 * MiB;
constexpr size_t WS_QP = 600 * MiB;
constexpr size_t WS_KWT = 856 * MiB;
constexpr size_t WS_VT = 1113 * MiB;
constexpr size_t WS_XM = 1370 * MiB;
constexpr size_t WS_XB = 600 * MiB, WS_WUP = 732 * MiB, WS_H = 600 * MiB, WS_PRE = 864 * MiB, WS_S = 1370 * MiB, WS_R = 1392 * MiB;
constexpr size_t WS_WCIN = 1656 * MiB, WS_WCOUT = 1752 * MiB, WS_X1F = 72 * MiB, WS_X1B = 336 * MiB, WS_U = 468 * MiB, WS_SZG = 600 * MiB, WS_C = 732 * MiB,
                 WS_PRE2 = 864 * MiB, WS_R2 = 1128 * MiB;
constexpr size_t WS_XQ = 864 * MiB, WS_WZQ = 930 * MiB;
constexpr size_t WS_X1Q = 996 * MiB, WS_WCINQ = 1062 * MiB;
constexpr size_t WS_LNST = 88 * MiB;
constexpr size_t WS_PART = 1784 * MiB;
constexpr size_t WS_S8 = 1370 * MiB, WS_S16 = 1580 * MiB, WS_VT8 = 1704 * MiB;
constexpr size_t S8_BH = (size_t)105 * 65536, S16_BH = (size_t)31 * 131072;
constexpr int P8 = 16384 + 128;
constexpr size_t WS_SMALL = 1914 * MiB;
constexpr size_t WS_SSP = WS_SMALL;
constexpr size_t WS_SQT = WS_SMALL + 1 * MiB;
constexpr size_t WS_SWK = WS_SMALL + 9 * MiB;
constexpr size_t WS_SVT = WS_SMALL + 17 * MiB;
constexpr size_t WS_HS = WS_SMALL + 25 * MiB;
constexpr size_t WS_END = WS_SMALL + 33 * MiB;
static_assert(WS_S + 544 * MiB <= WS_SMALL && WS_END <= 2048 * MiB, "ws map");

typedef __bf16 bf16v2_t __attribute__((ext_vector_type(2)));
typedef float f32v2_t __attribute__((ext_vector_type(2)));
DI unsigned pk_bf16(float lo, float hi) { const f32v2_t f = {lo, hi}; const bf16v2_t t = __builtin_convertvector(f, bf16v2_t); return __builtin_bit_cast(unsigned, t); }
DI float bf_lo(unsigned u) { return __uint_as_float(u << 16); }
DI float bf_hi(unsigned u) { return __uint_as_float(u & 0xffff0000u); }
DI float bf1(bf16_t b) { return __uint_as_float((unsigned)b << 16); }
DI bf16_t f2bf(float f) { return (bf16_t)(pk_bf16(f, 0.f) & 0xffffu); }
DI void unpack8(const u32x4 v, float (&f)[8]) { f[0] = bf_lo(v.x); f[1] = bf_hi(v.x); f[2] = bf_lo(v.y); f[3] = bf_hi(v.y); f[4] = bf_lo(v.z); f[5] = bf_hi(v.z); f[6] = bf_lo(v.w); f[7] = bf_hi(v.w); }
DI u32x4 pack8(const float (&f)[8]) { u32x4 v; v.x = pk_bf16(f[0], f[1]); v.y = pk_bf16(f[2], f[3]); v.z = pk_bf16(f[4], f[5]); v.w = pk_bf16(f[6], f[7]); return v; }
constexpr float FP8_SA_PRE = 8.0f, FP8_SA_PRE2 = 16.0f, FP8_SB_W = 4096.0f, FP8_SA_X1 = 16.0f, FP8_SB_WCIN = 1024.0f, FP8_SA_X = 16.0f, FP8_SB_WZ = 1024.0f, FP8_SA_Q = 1024.0f, FP8_SA_XA = 16.0f, FP8_SA_S = 64.0f, FP8_SA_V = 16.0f;
DI unsigned pk_fp8x4(float a, float b, float c, float d) {
    a = fminf(fmaxf(a, -448.f), 448.f); b = fminf(fmaxf(b, -448.f), 448.f); c = fminf(fmaxf(c, -448.f), 448.f); d = fminf(fmaxf(d, -448.f), 448.f);
    int r = 0; r = __builtin_amdgcn_cvt_pk_fp8_f32(a, b, r, false); r = __builtin_amdgcn_cvt_pk_fp8_f32(c, d, r, true); return (unsigned)r; }
DI float fexp(float x) { return __builtin_amdgcn_exp2f(x * 1.44269504088896341f); }
DI float frcp(float x) { return __builtin_amdgcn_rcpf(x); }
DI float fsilu(float x) { return x * frcp(1.0f + fexp(-x)); }
DI float fsigm(float x) { return frcp(1.0f + fexp(-x)); }
DI float logsig(float x) { return fminf(x, 0.f) - log1pf(expf(-fabsf(x))); }
#define LDS_BARRIER() do { asm volatile("s_waitcnt lgkmcnt(0)" ::: "memory"); __builtin_amdgcn_s_barrier(); asm volatile("" ::: "memory"); } while (0)
DI int lane_id() { int l; asm volatile("v_mbcnt_lo_u32_b32 %0, -1, 0\n\tv_mbcnt_hi_u32_b32 %0, -1, %0" : "=v"(l)); return l; }
template <class T> DI T ld_nt(const T* p) { return __builtin_nontemporal_load(p); }
template <class T> DI void st_nt(T* p, const T v) { __builtin_nontemporal_store(v, p); }
DI float wave_sum(float v) {
#pragma unroll
    for (int o = 1; o < 64; o <<= 1) v += __shfl_xor(v, o);
    return v;
}

#define XB_TMO      128
#define XB_XCNT(j)  (256  + 64 * (j))
#define XB_XSUB(j)  (1280 + 64 * (j))
#define XB_XGEN(j)  (2304 + 64 * (j))
#define XB_TOP      3328
#define XB_TOPGEN   3392
#define XCD_BAR_WORDS 3456
#define XB_SPIN_CAP (1u << 22)
__device__ __forceinline__ unsigned xb_ld(unsigned* p)              { return __hip_atomic_load(p, __ATOMIC_RELAXED, __HIP_MEMORY_SCOPE_AGENT); }
__device__ __forceinline__ unsigned xb_add(unsigned* p, unsigned v) { return __hip_atomic_fetch_add(p, v, __ATOMIC_RELAXED, __HIP_MEMORY_SCOPE_AGENT); }
__device__ __forceinline__ unsigned xb_xcc_id() { return (unsigned)__builtin_amdgcn_s_getreg((3 << 11) | 20) & 0xFu; }
#define XB_SPIN(cond, bar) do { unsigned _sp = 0; while (cond) { __builtin_amdgcn_s_sleep(1); \
    if ((++_sp & 255u) == 0u) { if (xb_ld(&(bar)[XB_TMO])) break; if (_sp > XB_SPIN_CAP) { atomicAdd(&(bar)[XB_TMO], 1u); break; } } } } while (0)
struct XcdBarrier { unsigned* bar; unsigned x; volatile LAS unsigned* st; int wave; };
__device__ __forceinline__ XcdBarrier xcd_barrier_post(unsigned* bar, volatile LAS unsigned* st, int wave) {
    XcdBarrier b; b.bar = bar; b.x = xb_xcc_id(); b.st = st; b.wave = wave;
    if (wave == 0 && lane_id() == 0) (void)xb_add(&bar[XB_XCNT(b.x)], 1u);
    return b;
}
__device__ __forceinline__ void xcd_barrier_complete(unsigned* bar, unsigned x, unsigned& nloc, unsigned& nx) {
    const unsigned G = gridDim.x * gridDim.y * gridDim.z;
    unsigned sum, cnt, mine, sp = 0u;
    for (;;) {
        sum = 0u; cnt = 0u; mine = 0u;
#pragma unroll
        for (unsigned j = 0; j < 16; ++j) { const unsigned c = xb_ld(&bar[XB_XCNT(j)]); sum += c; cnt += (c > 0u) ? 1u : 0u; mine = (j == x) ? c : mine; }
        if (sum == G) break;
        __builtin_amdgcn_s_sleep(1);
        if ((++sp & 255u) == 0u) { if (xb_ld(&bar[XB_TMO])) break; if (sp > XB_SPIN_CAP) { atomicAdd(&bar[XB_TMO], 1u); break; } }
    }
    nloc = mine > 0u ? mine : 1u; nx = cnt > 0u ? cnt : 1u;
}
__device__ __forceinline__ void xcd_barrier(const XcdBarrier& b) {
    asm volatile("s_waitcnt vmcnt(0)" ::: "memory");
    __syncthreads();
    if (b.wave == 0 && lane_id() == 0) {
        unsigned* bar = b.bar;
        __builtin_amdgcn_s_waitcnt(0);
        unsigned nloc = b.st[0], nx = b.st[1];
        if (nloc == 0u) { xcd_barrier_complete(bar, b.x, nloc, nx); b.st[0] = nloc; b.st[1] = nx; }
        const unsigned old = xb_add(&bar[XB_XSUB(b.x)], 1u);
        const unsigned gen = old / nloc;
        if (old + 1u == (gen + 1u) * nloc) {
            __builtin_amdgcn_fence(__ATOMIC_RELEASE, "agent");
            asm volatile("s_waitcnt vmcnt(0)" ::: "memory");
            const unsigned og = xb_add(&bar[XB_TOP], 1u);
            const unsigned tg = og / nx;
            if (og + 1u == (tg + 1u) * nx) xb_add(&bar[XB_TOPGEN], 1u);
            else XB_SPIN(xb_ld(&bar[XB_TOPGEN]) == tg, bar);
            __builtin_amdgcn_fence(__ATOMIC_ACQUIRE, "agent");
            xb_add(&bar[XB_XGEN(b.x)], 1u);
            asm volatile("s_waitcnt vmcnt(0)" ::: "memory");
        } else {
            XB_SPIN(xb_ld(&bar[XB_XGEN(b.x)]) == gen, bar);
            __builtin_amdgcn_fence(__ATOMIC_ACQUIRE, "agent");
            asm volatile("s_waitcnt vmcnt(0)" ::: "memory");
        }
    }
    __syncthreads();
}

namespace g8 {
constexpr int BM = 256, BK = 64, HALF = 128, HTB = HALF * BK * 2, STAGE_BYTES = 8 * HTB, NXCD = 8, WGM = 8;
__host__ __device__ __forceinline__ int lds_byte(int r, int c) { const int st = (r >> 4) * 2 + (c >> 5), rr = r & 15, cc = c & 31, ob = rr * 64 + cc * 2; return st * 1024 + (ob ^ (((ob >> 9) & 1) << 5)); }
__host__ __device__ __forceinline__ void stage_rc(int b, int& R, int& C) { const int st = b / 1024, sb = b % 1024, swz = sb ^ (((sb >> 9) & 1) << 5); R = (st >> 1) * 16 + swz / 64; C = (st & 1) * 32 + (swz % 64) / 2; }
__host__ __device__ __forceinline__ int perm32(int rho) { const int n = rho >> 4, i = rho & 15; return 8 * (i >> 2) + 4 * n + (i & 3); }

typedef int i32x8 __attribute__((ext_vector_type(8)));
DI i32x8 cat8(const bf16x8 lo, const bf16x8 hi) { const u32x4 a = __builtin_bit_cast(u32x4, lo), b = __builtin_bit_cast(u32x4, hi); i32x8 r; r[0] = (int)a.x; r[1] = (int)a.y; r[2] = (int)a.z; r[3] = (int)a.w; r[4] = (int)b.x; r[5] = (int)b.y; r[6] = (int)b.z; r[7] = (int)b.w; return r; }
struct GUnit { const char* A; const char* B; int nt; int i0, i1, i2; };

struct DenseSched {
    int wave;
    const char* A; const char* B; size_t tstepA, tstepB; int nM, nN, nMf, ksp, G, c, nt, pmode;
    DI void init(const void* A_, const void* B_, int M, int N, int Kbytes, int G_, int c_, int nMfull = -1, int ksp_ = 0) { A = (const char*)A_; B = (const char*)B_; tstepA = (size_t)BM * Kbytes; tstepB = (size_t)BM * Kbytes; nM = M / BM; nN = N / BM;
        nMf = nMfull < 0 ? nM : nMfull; ksp = ksp_; G = G_; c = c_; nt = Kbytes / 128; pmode = 0; }
    int rag_r0 = -1, rag_w1 = 0, rag_w2 = 0, rag_w3 = 0;
    DI bool next(int i, GUnit& u) const {
        long L = (long)i * G + c; const int nwg = nMf * nN;
        if (rag_r0 >= 0 && i >= rag_r0) { if (i == rag_r0) { if (c >= rag_w1) return false; } else if (i == rag_r0 + 1) { if (c >= rag_w2) return false; L = (long)rag_r0 * G + rag_w1 + c; }
            else if (i == rag_r0 + 2) { if (c >= rag_w3) return false; L = (long)rag_r0 * G + rag_w1 + rag_w2 + c; } else return false; }
        if (L >= nwg) {
            if (!ksp) return false;
            const int L2 = (int)(L - nwg); if (L2 >= (nM - nMf) * nN * ksp) return false;
            const int sp = L2 % ksp, uu = L2 / ksp, pm = nMf + uu / nN, pn = uu % nN, ntu = nt / ksp;
            u.A = A + (size_t)pm * tstepA + (size_t)sp * ntu * 128; u.B = B + (size_t)pn * tstepB + (size_t)sp * ntu * 128; u.nt = ntu; u.i0 = 1 + sp; u.i1 = pm; u.i2 = pn; return true; }
        int wgid = (int)L; { const int q = nwg / NXCD, r = nwg % NXCD, xcd = wgid % NXCD, off = wgid / NXCD; wgid = (xcd < r ? xcd * (q + 1) : r * (q + 1) + (xcd - r) * q) + off; }
        const int nig = WGM * nN, gid = wgid / nig, fm = gid * WGM, gsz = (nMf - fm) < WGM ? (nMf - fm) : WGM;
        int pm = fm + ((wgid % nig) % gsz); const int pn = (wgid % nig) / gsz;
        if (pmode == 1) pm += pm / 15; else if (pmode == 2) pm = pm < 4 ? 16 * pm + 15 : 60 + pm;
        u.A = A + (size_t)pm * tstepA; u.B = B + (size_t)pn * tstepB; u.nt = nt; u.i0 = 0; u.i1 = pm; u.i2 = pn; return true;
    }
};

template <class Epi, class Sched, bool ATILED, bool FP8 = false>
__device__ __forceinline__ void gemm_phase(LAS unsigned char* lds, const unsigned ldaB, const unsigned ldbB, const Sched& S, const Epi& E, const int fp8_scale_a = 0x7f7f7f7f, const int fp8_scale_b = 0x7f7f7f7f) {
    const int wid = __builtin_amdgcn_readfirstlane(S.wave);
    int tid = wid * 64 + lane_id(); asm volatile("" : "+v"(tid));
    const int lane = tid & 63, wr = wid >> 2, wc = wid & 3, fr = lane & 15, fq = lane >> 4;
    unsigned voffA[2], voffB[2];
#pragma unroll
    for (int i = 0; i < 2; ++i) { int R, C; stage_rc(tid * 16 + i * 8192, R, C); const int Rb = Epi::PERM ? ((R & ~31) + perm32(R & 31)) : R;
        voffA[i] = (unsigned)R * ldaB + (unsigned)C * 2u; voffB[i] = (unsigned)Rb * ldbB + (unsigned)C * 2u; }
    const size_t kstep = (size_t)(BK * 2);
    const size_t hstepA = (size_t)HALF * ldaB, hstepB = (size_t)HALF * ldbB;
    const unsigned ldsw = (unsigned)wid * 1024u;
    const int aoff = lds_byte(wr * 64 + fr, fq * 8), boff = lds_byte(wc * 32 + fr, fq * 8);
#define G8_KA(p, kt) (ATILED ? ((p) + (size_t)((kt) >> 2) * 131072u + (size_t)((kt) & 3) * 128u) : ((p) + (size_t)(kt) * 128u))
#define G8_SA(b, h) (((b) * 2 + (h)) * HTB)
#define G8_SB(b, h) ((4 + (b) * 2 + (h)) * HTB)
#define G8_STAGE(bufoff, gbase, voff) do { _Pragma("unroll") for (int _i = 0; _i < 2; ++_i) \
        __builtin_amdgcn_global_load_lds((const unsigned*)((const char*)(gbase) + (voff)[_i]), (LAS unsigned*)(lds + (bufoff) + ldsw + _i * 8192), 16, 0, 0); } while (0)
#define G8_RDA(b, h, m, k) (*(const LAS bf16x8*)(lds + G8_SA(b, h) + aoff + (m) * 2048 + (k) * 1024))
#define G8_RDB(b, h, n, k) (*(const LAS bf16x8*)(lds + G8_SB(b, h) + boff + (n) * 2048 + (k) * 1024))
#define G8_LDA(dst, b, h) do { _Pragma("unroll") for (int m = 0; m < 4; ++m) { if constexpr (FP8) dst##8[m] = cat8(G8_RDA(b, h, m, 0), G8_RDA(b, h, m, 1)); else { dst[m][0] = G8_RDA(b, h, m, 0); dst[m][1] = G8_RDA(b, h, m, 1); } } } while (0)
#define G8_LDB(dst, b, h) do { _Pragma("unroll") for (int n = 0; n < 2; ++n) { if constexpr (FP8) dst##8[n] = cat8(G8_RDB(b, h, n, 0), G8_RDB(b, h, n, 1)); else { dst[n][0] = G8_RDB(b, h, n, 0); dst[n][1] = G8_RDB(b, h, n, 1); } } } while (0)
#define G8_MMA(ai, bj, At, Bt) do { __builtin_amdgcn_s_setprio(1); _Pragma("unroll") for (int m = 0; m < 4; ++m) _Pragma("unroll") for (int n = 0; n < 2; ++n) { \
        if constexpr (FP8) { asm volatile("v_mfma_scale_f32_16x16x128_f8f6f4 %0, %1, %2, %0, %3, %4 op_sel_hi:[0,0,0]" : "+v"(acc[ai][bj][m][n]) : "v"(Bt##8[n]), "v"(At##8[m]), "v"(fp8_sb_v), "v"(fp8_sa_v)); } \
        else { _Pragma("unroll") for (int k = 0; k < 2; ++k) acc[ai][bj][m][n] = __builtin_amdgcn_mfma_f32_16x16x32_bf16(Bt[n][k], At[m][k], acc[ai][bj][m][n], 0, 0, 0); } } \
        __builtin_amdgcn_s_setprio(0); } while (0)
#define G8_WAIT_V(n) asm volatile("s_waitcnt vmcnt(" #n ")" ::: "memory")
#define G8_WAIT_L(n) asm volatile("s_waitcnt lgkmcnt(" #n ")" ::: "memory")
#define G8_BAR __builtin_amdgcn_s_barrier()
#define G8_SCHED __builtin_amdgcn_sched_barrier(0)
    GUnit cur, nxt; int ui = 0;
    if (!S.next(0, cur)) return;
    f32x4 acc[2][2][4][2];
#pragma unroll
    for (int a = 0; a < 2; ++a)
#pragma unroll
        for (int b = 0; b < 2; ++b)
#pragma unroll
            for (int m = 0; m < 4; ++m)
#pragma unroll
                for (int n = 0; n < 2; ++n) acc[a][b][m][n] = (f32x4){0.f, 0.f, 0.f, 0.f};
    const int fp8_sb_v = fp8_scale_b, fp8_sa_v = fp8_scale_a;
    bf16x8 At[4][2], B0[2][2], B1[2][2]; i32x8 At8[4], B08[2], B18[2];
    const char* cA = cur.A; const char* cB = cur.B;
    G8_STAGE(G8_SB(0, 0), cB, voffB); G8_STAGE(G8_SB(0, 1), cB + hstepB, voffB); G8_STAGE(G8_SA(0, 0), cA, voffA); G8_STAGE(G8_SA(0, 1), cA + hstepA, voffA);
    if (wr == 1) G8_BAR;
    G8_WAIT_V(2); G8_BAR;
    G8_STAGE(G8_SB(1, 0), cB + kstep, voffB); G8_STAGE(G8_SA(1, 0), G8_KA(cA, 1), voffA); G8_STAGE(G8_SB(1, 1), cB + hstepB + kstep, voffB);
    G8_WAIT_V(6); G8_BAR;
    for (;;) {
        const bool has_next = S.next(ui + 1, nxt);
        const char* nA = has_next ? nxt.A : cA; const char* nB = has_next ? nxt.B : cB;
        const int nt = cur.nt;
        for (int t = 0; t < nt; t += 2) {
            const bool last = (t == nt - 2);
            const char* a1 = G8_KA(cA, t + 1);
            const char* a2 = last ? nA : G8_KA(cA, t + 2); const char* b2 = last ? nB : cB + (size_t)(t + 2) * kstep;
            const char* a3 = a2 + kstep; const char* b3 = b2 + kstep;
            G8_LDB(B0, 0, 0); G8_LDB(B1, 0, 1); G8_SCHED; G8_LDA(At, 0, 0); G8_STAGE(G8_SA(1, 1), a1 + hstepA, voffA);
            G8_WAIT_V(8); G8_WAIT_L(0); G8_BAR; G8_MMA(0, 0, At, B0); G8_MMA(0, 1, At, B1); G8_BAR; G8_SCHED;
            G8_LDA(At, 0, 1); G8_STAGE(G8_SB(0, 0), b2, voffB); G8_STAGE(G8_SB(0, 1), b2 + hstepB, voffB); G8_STAGE(G8_SA(0, 0), a2, voffA);
            G8_WAIT_V(8); G8_WAIT_L(0); G8_BAR; G8_MMA(1, 0, At, B0); G8_MMA(1, 1, At, B1); G8_BAR; G8_SCHED;
            G8_LDB(B0, 1, 0); G8_LDB(B1, 1, 1); G8_SCHED; G8_LDA(At, 1, 0); G8_STAGE(G8_SA(0, 1), a2 + hstepA, voffA);
            G8_WAIT_V(8); G8_WAIT_L(0); G8_BAR; G8_MMA(0, 0, At, B0); G8_MMA(0, 1, At, B1); G8_BAR; G8_SCHED;
            G8_LDA(At, 1, 1); G8_STAGE(G8_SB(1, 0), b3, voffB); G8_STAGE(G8_SB(1, 1), b3 + hstepB, voffB); G8_STAGE(G8_SA(1, 0), a3, voffA);
            G8_WAIT_V(8); G8_WAIT_L(0); G8_BAR; G8_MMA(1, 0, At, B0); G8_MMA(1, 1, At, B1); G8_BAR; G8_SCHED;
        }
        if constexpr (FP8) asm volatile("s_nop 15\n\ts_nop 15\n\ts_nop 15" ::: "memory");
        if (wr == 0) G8_BAR;
        E(acc, cur, wr, wc, fr, fq);
        if (!has_next) break;
#pragma unroll
        for (int a = 0; a < 2; ++a)
#pragma unroll
            for (int b = 0; b < 2; ++b)
#pragma unroll
                for (int m = 0; m < 4; ++m)
#pragma unroll
                    for (int n = 0; n < 2; ++n) acc[a][b][m][n] = (f32x4){0.f, 0.f, 0.f, 0.f};
        cur = nxt; cA = nA; cB = nB; ++ui;
        if (wr == 1) G8_BAR;
    }
    G8_WAIT_V(0);
    G8_BAR;
#undef G8_KA
#undef G8_SA
#undef G8_SB
#undef G8_STAGE
#undef G8_LDA
#undef G8_RDA
#undef G8_RDB
#undef G8_LDB
#undef G8_MMA
#undef G8_WAIT_V
#undef G8_WAIT_L
#undef G8_BAR
#undef G8_SCHED
}

struct GUnitM { const char* A8; const char* B8; const char* A16; const char* B16; int nt8, nt; int i0, i1, i2; };
typedef int i32x4 __attribute__((ext_vector_type(4)));
template <class Epi, class Sched>
__device__ __forceinline__ void gemm_phase_mixed(LAS unsigned char* lds, const unsigned ldb8, const unsigned ldb16, const Sched& S, const Epi& E, const int scale_b8, const int scale_a8) {
    const int wid = __builtin_amdgcn_readfirstlane(S.wave);
    int tid = wid * 64 + lane_id(); asm volatile("" : "+v"(tid));
    const int lane = tid & 63, wr = wid >> 2, wc = wid & 3, fr = lane & 15, fq = lane >> 4;
    unsigned voffA8[2], rowB[2];
#pragma unroll
    for (int i = 0; i < 2; ++i) { int R, C; stage_rc(tid * 16 + i * 8192, R, C); const int Rb = Epi::PERM ? ((R & ~31) + perm32(R & 31)) : R;
        voffA8[i] = (unsigned)R * 256u + (unsigned)C * 2u; rowB[i] = (unsigned)Rb; }
#define GM_VA(is8, i) ((is8) ? voffA8[i] : voffA8[i] + (voffA8[i] & ~255u))
#define GM_VB(is8, i) (rowB[i] * ((is8) ? ldb8 : ldb16) + (voffA8[i] & 255u))
    const unsigned ldsw = (unsigned)wid * 1024u;
    const int aoff = lds_byte(wr * 64 + fr, fq * 8), boff = lds_byte(wc * 32 + fr, fq * 8);
#define GM_SA(b, h) (((b) * 2 + (h)) * HTB)
#define GM_SB(b, h) ((4 + (b) * 2 + (h)) * HTB)
#define GM_PA(u, kt) ((kt) < (u).nt8 ? (u).A8 + (size_t)((kt) >> 1) * 65536u + (size_t)((kt) & 1) * 128u : (u).A16 + (size_t)(((kt) - (u).nt8) >> 2) * 131072u + (size_t)(((kt) - (u).nt8) & 3) * 128u)
#define GM_PB(u, kt) ((kt) < (u).nt8 ? (u).B8 + (size_t)(kt) * 128u : (u).B16 + (size_t)((kt) - (u).nt8) * 128u)
#define GM_STAGE_A(bufoff, gbase, is8, half) do { const char* _g = (gbase) + ((half) ? ((is8) ? 32768u : 65536u) : 0u); _Pragma("unroll") for (int _i = 0; _i < 2; ++_i) \
        __builtin_amdgcn_global_load_lds((const unsigned*)(_g + GM_VA(is8, _i)), (LAS unsigned*)(lds + (bufoff) + ldsw + _i * 8192), 16, 0, 0); } while (0)
#define GM_STAGE_B(bufoff, gbase, is8, half) do { const char* _g = (gbase) + ((half) ? (size_t)HALF * ((is8) ? ldb8 : ldb16) : (size_t)0); _Pragma("unroll") for (int _i = 0; _i < 2; ++_i) \
        __builtin_amdgcn_global_load_lds((const unsigned*)(_g + GM_VB(is8, _i)), (LAS unsigned*)(lds + (bufoff) + ldsw + _i * 8192), 16, 0, 0); } while (0)
#define GM_RDA(b, h, m, k) (*(const LAS bf16x8*)(lds + GM_SA(b, h) + aoff + (m) * 2048 + (k) * 1024))
#define GM_RDB(b, h, n, k) (*(const LAS bf16x8*)(lds + GM_SB(b, h) + boff + (n) * 2048 + (k) * 1024))
#define GM_LDA8(b, h) do { _Pragma("unroll") for (int m = 0; m < 4; ++m) At8[m] = cat8(GM_RDA(b, h, m, 0), GM_RDA(b, h, m, 1)); } while (0)
#define GM_LDB8(dst, b, h) do { _Pragma("unroll") for (int n = 0; n < 2; ++n) dst##8[n] = cat8(GM_RDB(b, h, n, 0), GM_RDB(b, h, n, 1)); } while (0)
#define GM_LDA16(b, h) do { _Pragma("unroll") for (int m = 0; m < 4; ++m) { At[m][0] = GM_RDA(b, h, m, 0); At[m][1] = GM_RDA(b, h, m, 1); } } while (0)
#define GM_LDB16(dst, b, h) do { _Pragma("unroll") for (int n = 0; n < 2; ++n) { dst[n][0] = GM_RDB(b, h, n, 0); dst[n][1] = GM_RDB(b, h, n, 1); } } while (0)
#define GM_MMA8(ai, bj, Bt) do { __builtin_amdgcn_s_setprio(1); _Pragma("unroll") for (int m = 0; m < 4; ++m) _Pragma("unroll") for (int n = 0; n < 2; ++n) \
        asm volatile("v_mfma_scale_f32_16x16x128_f8f6f4 %0, %1, %2, %0, %3, %4 op_sel_hi:[0,0,0]" : "+v"(acc[ai][bj][m][n]) : "v"(Bt##8[n]), "v"(At8[m]), "v"(sb8_v), "v"(sa8_v)); \
        __builtin_amdgcn_s_setprio(0); } while (0)
#define GM_MMA16(ai, bj, Bt) do { __builtin_amdgcn_s_setprio(1); _Pragma("unroll") for (int m = 0; m < 4; ++m) _Pragma("unroll") for (int n = 0; n < 2; ++n) _Pragma("unroll") for (int k = 0; k < 2; ++k) \
        acc[ai][bj][m][n] = __builtin_amdgcn_mfma_f32_16x16x32_bf16(Bt[n][k], At[m][k], acc[ai][bj][m][n], 0, 0, 0); __builtin_amdgcn_s_setprio(0); } while (0)
#define GM_TRIP(LDA_, LDB_, MMA_, c8_) do { \
            const bool last = (t == nt - 2); \
            const char* a1 = GM_PA(cur, t) + 128; \
            bool n8; const char* a2; const char* b2; \
            if (!last) { n8 = (t + 2) < cur.nt8; a2 = GM_PA(cur, t + 2); b2 = GM_PB(cur, t + 2); } \
            else if (has_next) { n8 = 0 < nxt.nt8; a2 = GM_PA(nxt, 0); b2 = GM_PB(nxt, 0); } \
            else { n8 = 0 < cur.nt8; a2 = GM_PA(cur, 0); b2 = GM_PB(cur, 0); } \
            const char* a3 = a2 + 128; const char* b3 = b2 + 128; \
            LDB_(B0, 0, 0); LDB_(B1, 0, 1); GM_SCHED; LDA_(0, 0); GM_STAGE_A(GM_SA(1, 1), a1, c8_, 1); \
            GM_WAIT_V(8); GM_WAIT_L(0); GM_BAR; MMA_(0, 0, B0); MMA_(0, 1, B1); GM_BAR; GM_SCHED; \
            LDA_(0, 1); GM_STAGE_B(GM_SB(0, 0), b2, n8, 0); GM_STAGE_B(GM_SB(0, 1), b2, n8, 1); GM_STAGE_A(GM_SA(0, 0), a2, n8, 0); \
            GM_WAIT_V(8); GM_WAIT_L(0); GM_BAR; MMA_(1, 0, B0); MMA_(1, 1, B1); GM_BAR; GM_SCHED; \
            LDB_(B0, 1, 0); LDB_(B1, 1, 1); GM_SCHED; LDA_(1, 0); GM_STAGE_A(GM_SA(0, 1), a2, n8, 1); \
            GM_WAIT_V(8); GM_WAIT_L(0); GM_BAR; MMA_(0, 0, B0); MMA_(0, 1, B1); GM_BAR; GM_SCHED; \
            LDA_(1, 1); GM_STAGE_B(GM_SB(1, 0), b3, n8, 0); GM_STAGE_B(GM_SB(1, 1), b3, n8, 1); GM_STAGE_A(GM_SA(1, 0), a3, n8, 0); \
            GM_WAIT_V(8); GM_WAIT_L(0); GM_BAR; MMA_(1, 0, B0); MMA_(1, 1, B1); GM_BAR; GM_SCHED; } while (0)
#define GM_WAIT_V(n) asm volatile("s_waitcnt vmcnt(" #n ")" ::: "memory")
#define GM_WAIT_L(n) asm volatile("s_waitcnt lgkmcnt(" #n ")" ::: "memory")
#define GM_BAR __builtin_amdgcn_s_barrier()
#define GM_SCHED __builtin_amdgcn_sched_barrier(0)
    GUnitM cur, nxt; int ui = 0;
    if (!S.next(0, cur)) return;
    f32x4 acc[2][2][4][2];
#pragma unroll
    for (int a = 0; a < 2; ++a)
#pragma unroll
        for (int b = 0; b < 2; ++b)
#pragma unroll
            for (int m = 0; m < 4; ++m)
#pragma unroll
                for (int n = 0; n < 2; ++n) acc[a][b][m][n] = (f32x4){0.f, 0.f, 0.f, 0.f};
    const int sb8_v = scale_b8, sa8_v = scale_a8;
    i32x8 At8[4], B08[2], B18[2]; bf16x8 At[4][2], B0[2][2], B1[2][2];
    { const bool p8 = 0 < cur.nt8; const char* a0 = GM_PA(cur, 0); const char* b0 = GM_PB(cur, 0);
      GM_STAGE_B(GM_SB(0, 0), b0, p8, 0); GM_STAGE_B(GM_SB(0, 1), b0, p8, 1); GM_STAGE_A(GM_SA(0, 0), a0, p8, 0); GM_STAGE_A(GM_SA(0, 1), a0, p8, 1);
      if (wr == 1) GM_BAR;
      GM_WAIT_V(2); GM_BAR;
      GM_STAGE_B(GM_SB(1, 0), b0 + 128, p8, 0); GM_STAGE_A(GM_SA(1, 0), a0 + 128, p8, 0); GM_STAGE_B(GM_SB(1, 1), b0 + 128, p8, 1);
      GM_WAIT_V(6); GM_BAR; }
    for (;;) {
        const bool has_next = S.next(ui + 1, nxt);
        const int nt = cur.nt, nt8 = cur.nt8;
        for (int t = 0; t < nt8; t += 2) GM_TRIP(GM_LDA8, GM_LDB8, GM_MMA8, true);
        for (int t = nt8; t < nt; t += 2) GM_TRIP(GM_LDA16, GM_LDB16, GM_MMA16, false);
        asm volatile("s_nop 15\n\ts_nop 15\n\ts_nop 15" ::: "memory");
        if (wr == 0) GM_BAR;
        { int tz = lane_id(); asm volatile("" : "+v"(tz));
          const int ln = tz & 63; E(acc, cur, wr, wc, ln & 15, ln >> 4); }
        if (!has_next) break;
#pragma unroll
        for (int a = 0; a < 2; ++a)
#pragma unroll
            for (int b = 0; b < 2; ++b)
#pragma unroll
                for (int m = 0; m < 4; ++m)
#pragma unroll
                    for (int n = 0; n < 2; ++n) acc[a][b][m][n] = (f32x4){0.f, 0.f, 0.f, 0.f};
        cur = nxt; ++ui;
        if (wr == 1) GM_BAR;
    }
    GM_WAIT_V(0);
    GM_BAR;
#undef GM_VA
#undef GM_VB
#undef GM_SA
#undef GM_SB
#undef GM_PA
#undef GM_PB
#undef GM_STAGE_A
#undef GM_STAGE_B
#undef GM_RDA
#undef GM_RDB
#undef GM_LDA8
#undef GM_LDB8
#undef GM_LDA16
#undef GM_LDB16
#undef GM_MMA8
#undef GM_MMA16
#undef GM_TRIP
#undef GM_WAIT_V
#undef GM_WAIT_L
#undef GM_BAR
#undef GM_SCHED
}
}
using g8::GUnit;
using g8::GUnitM;
using g8::HALF;

struct Params {
    const float *x_prompt, *x_sample, *st_C, *st_n, *st_m, *st_mconv, *st_cconv;
    const float *w_up, *w_mconv, *b_mconv, *w_q, *w_k, *w_v, *w_gate, *b_gate, *mh_gain, *skip, *w_down;
    const float *w_cin, *b_cin, *w_dw, *b_dw, *cln_g, *cln_b, *w_cout, *b_cout, *pln_g, *pln_b;
    float* out; unsigned char* ws; int ph_lo, ph_hi;
};
struct Frame { LAS unsigned char* lds; int tid, lane, wave, G, bx, vcu, dry; };

struct EpiUp {
    static constexpr bool PERM = true;
    bf16_t* base; int act; float sc;
    DI void operator()(const f32x4 (&acc)[2][2][4][2], const GUnit& u, int wr, int wc, int fr, int fq) const {
        const int row0 = u.i1 * 256 + wr * 64 + fr, col0 = u.i2 * 256 + wc * 32 + 8 * fq;
#pragma unroll
        for (int ai = 0; ai < 2; ++ai)
#pragma unroll
            for (int m = 0; m < 4; ++m) { bf16_t* rowp = base + (size_t)(row0 + ai * HALF + m * 16) * INNER + col0;
#pragma unroll
                for (int bj = 0; bj < 2; ++bj) { f32x4 v0 = acc[ai][bj][m][0], v1 = acc[ai][bj][m][1];
                    if (act) {
#pragma unroll
                        for (int j = 0; j < 4; ++j) { v0[j] = fsilu(v0[j] * sc); v1[j] = fsilu(v1[j] * sc); } }
                    u32x4 w; w.x = pk_bf16(v0[0], v0[1]); w.y = pk_bf16(v0[2], v0[3]); w.z = pk_bf16(v1[0], v1[1]); w.w = pk_bf16(v1[2], v1[3]);
                    *(u32x4*)(rowp + bj * HALF) = w; } }
    }
};
struct EpiS {
    static constexpr bool PERM = true;
    bf16_t* Sb; const float* cs; const float* mx; float* den; int dry; float sc; int far;
    DI void operator()(const f32x4 (&acc)[2][2][4][2], const GUnit& u, int wr, int wc, int fr, int fq) const {
        const int bh = u.i0, pm = u.i1, pn = u.i2;
        bf16_t* tile = (bf16_t*)((unsigned char*)Sb + WS_S16 - WS_S + (size_t)bh * S16_BH + (size_t)(pm + pn) * 131072);
        unsigned char* tile8 = (unsigned char*)Sb + (size_t)bh * S8_BH + (size_t)((pm - 2) * (pm - 1) / 2 + pn) * 65536;
        const float* csb = cs + bh * 4096 + pn * 256; const float* mxb = mx + bh * 4096 + pm * 256; float* denb = den + bh * 4096 + pm * 256;
        const bool diag = (pm == pn);
        f32x4 cv[2][2];
#pragma unroll
        for (int bj = 0; bj < 2; ++bj)
#pragma unroll
            for (int n = 0; n < 2; ++n) cv[bj][n] = *(const f32x4*)(csb + bj * HALF + wc * 32 + 8 * fq + 4 * n);
#pragma unroll
        for (int ai = 0; ai < 2; ++ai)
#pragma unroll
            for (int m = 0; m < 4; ++m) { const int rloc = ai * HALF + wr * 64 + m * 16 + fr; const float mxt = mxb[rloc]; float rs = 0.f;
                const int rowlim = diag ? rloc - (wc * 32 + 8 * fq) : 0x10000;
#pragma unroll
                for (int bj = 0; bj < 2; ++bj) { f32x4 v[2];
#pragma unroll
                    for (int n = 0; n < 2; ++n) { v[n] = acc[ai][bj][m][n];
#pragma unroll
                        for (int j = 0; j < 4; ++j) { const bool masked = (bj * HALF + 4 * n + j) > rowlim;
                            const float d = masked ? 0.f : fexp(cv[bj][n][j] - mxt) * sc; v[n][j] *= d; rs += v[n][j]; } }
                    if (far) { u32x2 w8; w8.x = pk_fp8x4(v[0][0] * FP8_SA_S, v[0][1] * FP8_SA_S, v[0][2] * FP8_SA_S, v[0][3] * FP8_SA_S); w8.y = pk_fp8x4(v[1][0] * FP8_SA_S, v[1][1] * FP8_SA_S, v[1][2] * FP8_SA_S, v[1][3] * FP8_SA_S);
                        *(u32x2*)(tile8 + (size_t)rloc * 256 + bj * HALF + wc * 32 + 8 * fq) = w8; }
                    else { u32x4 w; w.x = pk_bf16(v[0][0], v[0][1]); w.y = pk_bf16(v[0][2], v[0][3]); w.z = pk_bf16(v[1][0], v[1][1]); w.w = pk_bf16(v[1][2], v[1][3]);
                        *(u32x4*)(tile + (size_t)rloc * 256 + bj * HALF + wc * 32 + 8 * fq) = w; } }
                rs += __shfl_xor(rs, 16); rs += __shfl_xor(rs, 32);
                if (fq == 0 && !dry) atomicAdd(denb + rloc, rs); }
    }
};
struct EpiState {
    static constexpr bool PERM = false;
    float* C;
    DI void operator()(const f32x4 (&acc)[2][2][4][2], const GUnit& u, int wr, int wc, int fr, int fq) const {
        float* base = C + ((size_t)u.i0 << 20);
        const int row0 = u.i1 * 256 + wr * 64 + fr, col0 = u.i2 * 256 + wc * 32 + 4 * fq;
#pragma unroll
        for (int ai = 0; ai < 2; ++ai)
#pragma unroll
            for (int m = 0; m < 4; ++m) { float* rowp = base + (size_t)(row0 + ai * HALF + m * 16) * 1024 + col0;
#pragma unroll
                for (int bj = 0; bj < 2; ++bj)
#pragma unroll
                    for (int n = 0; n < 2; ++n) st_nt((f32x4*)(rowp + bj * HALF + n * 16), acc[ai][bj][m][n]); }
    }
};
struct EpiSV {
    static constexpr bool PERM = true;
    bf16_t* hb; const float* den; const float* em;
    template <class U> DI void operator()(const f32x4 (&acc)[2][2][4][2], const U& u, int wr, int wc, int fr, int fq) const {
        const int bh = u.i0, pm = u.i1, pn = u.i2, b = bh >> 3, h = bh & 7;
        const float* denb = den + bh * 4096 + pm * 256; const float* emb = em + bh * 4096 + pm * 256;
        bf16_t* base = hb + (size_t)(b * 4096 + pm * 256) * INNER + h * 1024 + pn * 256 + wc * 32 + 8 * fq;
        float dn[2][4], ee[2][4];
#pragma unroll
        for (int ai = 0; ai < 2; ++ai)
#pragma unroll
            for (int m = 0; m < 4; ++m) { const int rloc = ai * HALF + wr * 64 + m * 16 + fr; dn[ai][m] = denb[rloc]; ee[ai][m] = emb[rloc]; }
        __builtin_amdgcn_sched_barrier(0);
#pragma unroll
        for (int ai = 0; ai < 2; ++ai)
#pragma unroll
            for (int m = 0; m < 4; ++m) { const int rloc = ai * HALF + wr * 64 + m * 16 + fr; const float g = 1.0f / fmaxf(fabsf(dn[ai][m]), ee[ai][m]);
#pragma unroll
                for (int bj = 0; bj < 2; ++bj) { const f32x4 v0 = acc[ai][bj][m][0] * g, v1 = acc[ai][bj][m][1] * g;
                    u32x4 w; w.x = pk_bf16(v0[0], v0[1]); w.y = pk_bf16(v0[2], v0[3]); w.z = pk_bf16(v1[0], v1[1]); w.w = pk_bf16(v1[2], v1[3]);
                    *(u32x4*)(base + (size_t)rloc * INNER + bj * HALF) = w; } }
    }
};
struct EpiRes {
    static constexpr bool PERM = true;
    const float* resA; const float* resB; const float* bias; bf16_t* r; float* part; float sc;
    float* rstat;
    const bf16_t* resLn; const float* lnst; const float* lng; const float* lnb;
    DI void operator()(const f32x4 (&acc)[2][2][4][2], const GUnit& u, int wr, int wc, int fr, int fq) const {
        const int pm = u.i1, row0 = pm * 256 + wr * 64 + fr, col0 = u.i2 * 256 + wc * 32 + 8 * fq;
        f32x4 bv[2][2];
#pragma unroll
        for (int bj = 0; bj < 2; ++bj)
#pragma unroll
            for (int n = 0; n < 2; ++n) bv[bj][n] = bias ? *(const f32x4*)(bias + col0 + bj * HALF + n * 4) : (f32x4){0.f, 0.f, 0.f, 0.f};
        if (u.i0 == 0) {
            f32x4 lg[2][2], lb[2][2];
            if (resLn) {
#pragma unroll
                for (int bj = 0; bj < 2; ++bj)
#pragma unroll
                    for (int n = 0; n < 2; ++n) { lg[bj][n] = *(const f32x4*)(lng + col0 + bj * HALF + n * 4); lb[bj][n] = *(const f32x4*)(lnb + col0 + bj * HALF + n * 4); }
                __builtin_amdgcn_sched_barrier(0);
#pragma unroll
                for (int bj = 0; bj < 2; ++bj)
#pragma unroll
                    for (int n = 0; n < 2; ++n) { lg[bj][n] = lg[bj][n] * ALPHA; lb[bj][n] = lb[bj][n] * ALPHA + bv[bj][n]; } }
#define ER_FINISH(xr_) do { f32x4 v[2]; \
                    _Pragma("unroll") for (int n = 0; n < 2; ++n) { v[n] = (xr_)[n] + acc[ai][bj][m][n] * sc; \
                        s1 += (v[n][0] + v[n][1]) + (v[n][2] + v[n][3]); s2 += (v[n][0] * v[n][0] + v[n][1] * v[n][1]) + (v[n][2] * v[n][2] + v[n][3] * v[n][3]); } \
                    u32x4 w; w.x = pk_bf16(v[0][0], v[0][1]); w.y = pk_bf16(v[0][2], v[0][3]); w.z = pk_bf16(v[1][0], v[1][1]); w.w = pk_bf16(v[1][2], v[1][3]); \
                    *(u32x4*)(r + ro + bj * HALF) = w; } while (0)
#define ER_STATS() do { s1 += __shfl_xor(s1, 16); s1 += __shfl_xor(s1, 32); s2 += __shfl_xor(s2, 16); s2 += __shfl_xor(s2, 32); \
                    if (fq == 0) { atomicAdd(rstat + (size_t)row * 2, s1); atomicAdd(rstat + (size_t)row * 2 + 1, s2); } } while (0)
#pragma unroll
        for (int ai = 0; ai < 2; ++ai) {
            if (resLn) {
                u32x4 rw[4][2]; float mn[4], rs[4];
#pragma unroll
                for (int m = 0; m < 4; ++m) { const int row = row0 + ai * HALF + m * 16; const size_t ro = (size_t)row * DM + col0;
                    mn[m] = lnst[(size_t)row * 2]; rs[m] = lnst[(size_t)row * 2 + 1];
#pragma unroll
                    for (int bj = 0; bj < 2; ++bj) rw[m][bj] = ld_nt((const u32x4*)(resLn + ro + bj * HALF)); }
                __builtin_amdgcn_sched_barrier(0);
#pragma unroll
                for (int m = 0; m < 4; ++m) { const int row = row0 + ai * HALF + m * 16; const size_t ro = (size_t)row * DM + col0; const float mean = mn[m], rstd = rs[m];
                    float s1 = 0.f, s2 = 0.f;
#pragma unroll
                    for (int bj = 0; bj < 2; ++bj) { const u32x4 q = rw[m][bj]; f32x4 xr[2];
                        xr[0] = ((f32x4){bf_lo(q.x), bf_hi(q.x), bf_lo(q.y), bf_hi(q.y)} - mean) * rstd * lg[bj][0] + lb[bj][0]; xr[1] = ((f32x4){bf_lo(q.z), bf_hi(q.z), bf_lo(q.w), bf_hi(q.w)} - mean) * rstd * lg[bj][1] + lb[bj][1];
                        ER_FINISH(xr); }
                    ER_STATS(); }
            } else {
#pragma unroll
              for (int mh = 0; mh < 4; mh += 2) {
                f32x4 xq[2][2][2];
#pragma unroll
                for (int m = mh; m < mh + 2; ++m) { const size_t ro = (size_t)(row0 + ai * HALF + m * 16) * DM + col0;
#pragma unroll
                    for (int bj = 0; bj < 2; ++bj) { xq[m - mh][bj][0] = ld_nt((const f32x4*)(resA + ro + bj * HALF)); xq[m - mh][bj][1] = ld_nt((const f32x4*)(resA + ro + bj * HALF + 4)); } }
                __builtin_amdgcn_sched_barrier(0);
#pragma unroll
                for (int m = mh; m < mh + 2; ++m) { const int row = row0 + ai * HALF + m * 16; const size_t ro = (size_t)row * DM + col0;
                    float s1 = 0.f, s2 = 0.f;
#pragma unroll
                    for (int bj = 0; bj < 2; ++bj) { f32x4 xr[2]; xr[0] = xq[m - mh][bj][0] * ALPHA + bv[bj][0]; xr[1] = xq[m - mh][bj][1] * ALPHA + bv[bj][1]; ER_FINISH(xr); }
                    ER_STATS(); }
              }
            }
        }
#undef ER_FINISH
#undef ER_STATS
        } else {
            const bool first = (u.i0 == 1); float* pr = part + (size_t)(u.i0 - 1) * TS * DM - (size_t)TP * DM; const float* res = resB + (size_t)(row0 - TP) * DM;
#pragma unroll
        for (int ai = 0; ai < 2; ++ai)
#pragma unroll
          for (int mh = 0; mh < 4; mh += 2) { f32x4 xq[2][2][2];
            if (first) {
#pragma unroll
                for (int m = mh; m < mh + 2; ++m) { const size_t ro = (size_t)(ai * HALF + m * 16) * DM + col0;
#pragma unroll
                    for (int bj = 0; bj < 2; ++bj)
#pragma unroll
                        for (int n = 0; n < 2; ++n) xq[m - mh][bj][n] = *(const f32x4*)(res + ro + bj * HALF + n * 4); }
                __builtin_amdgcn_sched_barrier(0); }
#pragma unroll
            for (int m = mh; m < mh + 2; ++m) { const size_t ro = (size_t)(ai * HALF + m * 16) * DM + col0; float* rowp = pr + (size_t)row0 * DM + ro;
#pragma unroll
                for (int bj = 0; bj < 2; ++bj)
#pragma unroll
                    for (int n = 0; n < 2; ++n) { f32x4 v = acc[ai][bj][m][n] * sc;
                        if (first) v += xq[m - mh][bj][n] * ALPHA + bv[bj][n];
                        *(f32x4*)(rowp + bj * HALF + n * 4) = v; } } }
        }
    }
};
struct EpiCin {
    static constexpr bool PERM = true;
    bf16_t* ub; bf16_t* szg; const float* bias; float sc;
    DI void operator()(const f32x4 (&acc)[2][2][4][2], const GUnit& u, int wr, int wc, int fr, int fq) const {
        const int pm = u.i1, pn = u.i2, row0 = pm * 256 + wr * 64 + fr;
        if (pn < 32) {
            const int ch0 = pn * 128 + wc * 32 + 8 * fq;
            f32x4 ba[2], bg[2];
#pragma unroll
            for (int n = 0; n < 2; ++n) { ba[n] = *(const f32x4*)(bias + ch0 + 4 * n); bg[n] = *(const f32x4*)(bias + 4096 + ch0 + 4 * n); }
#pragma unroll
            for (int ai = 0; ai < 2; ++ai)
#pragma unroll
                for (int m = 0; m < 4; ++m) { f32x4 o[2];
#pragma unroll
                    for (int n = 0; n < 2; ++n) { const f32x4 a = acc[ai][0][m][n] * sc + ba[n], g = acc[ai][1][m][n] * sc + bg[n];
#pragma unroll
                        for (int j = 0; j < 4; ++j) o[n][j] = a[j] * fsigm(g[j]); }
                    u32x4 w; w.x = pk_bf16(o[0][0], o[0][1]); w.y = pk_bf16(o[0][2], o[0][3]); w.z = pk_bf16(o[1][0], o[1][1]); w.w = pk_bf16(o[1][2], o[1][3]);
                    *(u32x4*)(ub + (size_t)(row0 + ai * HALF + m * 16) * DM + ch0) = w; }
        } else {
            const int ch0 = (pn - 32) * 256 + wc * 32 + 8 * fq;
            f32x4 bzz[2][2];
#pragma unroll
            for (int bj = 0; bj < 2; ++bj)
#pragma unroll
                for (int n = 0; n < 2; ++n) bzz[bj][n] = *(const f32x4*)(bias + 8192 + ch0 + bj * HALF + 4 * n);
            __builtin_amdgcn_sched_barrier(0);
#pragma unroll
            for (int bj = 0; bj < 2; ++bj) {
#pragma unroll
                for (int ai = 0; ai < 2; ++ai)
#pragma unroll
                    for (int m = 0; m < 4; ++m) { f32x4 o[2];
#pragma unroll
                        for (int n = 0; n < 2; ++n) { const f32x4 z = acc[ai][bj][m][n] * sc + bzz[bj][n];
#pragma unroll
                            for (int j = 0; j < 4; ++j) o[n][j] = fsilu(z[j]); }
                        u32x4 w; w.x = pk_bf16(o[0][0], o[0][1]); w.y = pk_bf16(o[0][2], o[0][3]); w.z = pk_bf16(o[1][0], o[1][1]); w.w = pk_bf16(o[1][2], o[1][3]);
                        *(u32x4*)(szg + (size_t)(row0 + ai * HALF + m * 16) * DM + ch0 + bj * HALF) = w; } }
        }
    }
};

struct SchedS {
    const char* qp; const char* xa; int G, c, far, wave;
    DI bool next(int i, GUnit& u) const {
        const int per = far ? 105 : 31, L = i * G + c; if (L >= 32 * per) return false;
        const int bh = L / per, rr = L - bh * per; int pm, pn;
        if (far) { int q = 0; while ((q + 1) * (q + 2) / 2 <= rr) ++q; pn = rr - q * (q + 1) / 2; pm = q + 2; }
        else if (rr < 16) { pm = rr; pn = rr; } else { pm = rr - 15; pn = rr - 16; }
        const int b = bh >> 3, h = bh & 7; const size_t es = far ? 1 : 2;
        u.A = qp + ((size_t)(b * 4096 + pm * 256) * INNER + h * 1024) * es; u.B = xa + ((size_t)(b * 4096 + pn * 256) * INNER + h * 1024) * es;
        u.nt = far ? 8 : 16; u.i0 = bh; u.i1 = pm; u.i2 = pn; return true;
    }
};
struct SchedState {
    const char* kwT; const char* vT; int G, c, wave;
    DI bool next(int i, GUnit& u) const {
        const int L = i * G + c; if (L >= 512) return false;
        const int bh = L >> 4, pm = (L >> 2) & 3, pn = L & 3, b = bh >> 3, h = bh & 7;
        u.A = kwT + ((size_t)(h * 1024 + pm * 256) * TPP + b * 4096) * 2; u.B = vT + ((size_t)(h * 1024 + pn * 256) * TPP + b * 4096) * 2;
        u.nt = 64; u.i0 = bh; u.i1 = pm; u.i2 = pn; return true;
    }
};
struct SchedSV {
    const char* S8; const char* S16; const char* vT8; const char* vT; int G, c, wave;
    DI bool next(int i, GUnitM& u) const {
        const int slot = c + G * (i >> 3); if (slot >= 256) return false;
        const int sub = i & 7, bh = slot >> 3, j = slot & 7, pn = j & 3, set = j >> 2, p = 4 * set + (sub >> 1), pm = (sub & 1) ? 15 - p : p, b = bh >> 3, h = bh & 7;
        const int pn0 = pm >= 1 ? pm - 1 : 0;
        u.nt8 = pm >= 2 ? 2 * (pm - 1) : 0; u.nt = u.nt8 + (pm >= 1 ? 8 : 4);
        u.A8 = S8 + (size_t)bh * S8_BH + (size_t)((pm - 2) * (pm - 1) / 2) * 65536; u.A16 = S16 + (size_t)bh * S16_BH + (size_t)(pm + pn0) * 131072;
        u.B8 = vT8 + (size_t)(h * 1024 + pn * 256) * P8 + b * 4096; u.B16 = vT + ((size_t)(h * 1024 + pn * 256) * TPP + b * 4096 + pn0 * 256) * 2;
        u.i0 = bh; u.i1 = pm; u.i2 = pn; return true;
    }
};

template <bool ALSO_FP8>
DI void transpose_item(const float* W, int K, int N, bf16_t* WT, int k0, int n0, int orow0, LAS float* scr, int lane, unsigned char* WQ = nullptr, float qscale = 1.f) {
#pragma unroll 8
    for (int i = 0; i < 32; ++i) { const int kk = 2 * i + (lane >> 5); scr[kk * 33 + (lane & 31)] = ld_nt(W + (size_t)(k0 + kk) * N + n0 + (lane & 31)); }
    asm volatile("s_waitcnt lgkmcnt(0)" ::: "memory");
    const int c = lane & 7;
#pragma unroll
    for (int j = 0; j < 4; ++j) { const int n = (lane >> 3) + 8 * j; const LAS float* s = scr + (8 * c) * 33 + n;
        u32x4 o; o.x = pk_bf16(s[0 * 33], s[1 * 33]); o.y = pk_bf16(s[2 * 33], s[3 * 33]); o.z = pk_bf16(s[4 * 33], s[5 * 33]); o.w = pk_bf16(s[6 * 33], s[7 * 33]);
        *(u32x4*)(WT + (size_t)(orow0 + n) * K + k0 + 8 * c) = o;
        if constexpr (ALSO_FP8) { u32x2 q; q.x = pk_fp8x4(s[0 * 33] * qscale, s[1 * 33] * qscale, s[2 * 33] * qscale, s[3 * 33] * qscale); q.y = pk_fp8x4(s[4 * 33] * qscale, s[5 * 33] * qscale, s[6 * 33] * qscale, s[7 * 33] * qscale);
            *(u32x2*)(WQ + (size_t)(orow0 + n) * K + k0 + 8 * c) = q; } }
    asm volatile("s_waitcnt lgkmcnt(0)" ::: "memory");
}
DI void transpose_item_fp8(const float* W, int K, int N, unsigned char* WT, int k0, int n0, float scale, LAS float* scr, int lane) {
#pragma unroll 8
    for (int i = 0; i < 32; ++i) { const int kk = 2 * i + (lane >> 5); scr[kk * 33 + (lane & 31)] = ld_nt(W + (size_t)(k0 + kk) * N + n0 + (lane & 31)); }
    asm volatile("s_waitcnt lgkmcnt(0)" ::: "memory");
    const int c = lane & 7;
#pragma unroll
    for (int j = 0; j < 4; ++j) { const int n = (lane >> 3) + 8 * j; const LAS float* s = scr + (8 * c) * 33 + n;
        u32x2 o; o.x = pk_fp8x4(s[0 * 33] * scale, s[1 * 33] * scale, s[2 * 33] * scale, s[3 * 33] * scale); o.y = pk_fp8x4(s[4 * 33] * scale, s[5 * 33] * scale, s[6 * 33] * scale, s[7 * 33] * scale);
        *(u32x2*)(WT + (size_t)(n0 + n) * K + k0 + 8 * c) = o; }
    asm volatile("s_waitcnt lgkmcnt(0)" ::: "memory");
}
DI void transpose_weight_fp8(const Frame& F, const float* W, int K, int N, unsigned char* WT, float scale) {
    LAS float* scr = (LAS float*)(F.lds + F.wave * 16384);
    const int gw = F.vcu * NWAVES + F.wave, NGW = F.G * NWAVES, nblk = N / 32, nitems = (K / 64) * nblk;
    for (int it = gw; it < nitems; it += NGW) { const int kb = it / nblk, nb = it - kb * nblk; transpose_item_fp8(W, K, N, WT, 64 * kb, 32 * nb, scale, scr, F.lane); }
}
DI void transpose_weight(const Frame& F, const float* W, int K, int N, bf16_t* WT, bool cin_map, unsigned char* WQ = nullptr, float qscale = 1.f) {
    LAS float* scr = (LAS float*)(F.lds + F.wave * 16384);
    const int gw = F.vcu * NWAVES + F.wave, NGW = F.G * NWAVES, nblk = N / 32, nitems = (K / 64) * nblk;
    for (int it = gw; it < nitems; it += NGW) { const int kb = it / nblk, nb = it - kb * nblk, n0 = 32 * nb; int orow0 = n0;
        if (cin_map) { if (n0 < 4096) orow0 = 256 * (n0 >> 7) + (n0 & 127); else if (n0 < 8192) orow0 = 256 * ((n0 - 4096) >> 7) + 128 + (n0 & 127); }
        if (cin_map) transpose_item<true>(W, K, N, WT, 64 * kb, n0, orow0, scr, F.lane, WQ, qscale); else transpose_item<false>(W, K, N, WT, 64 * kb, n0, orow0, scr, F.lane); }
}

DI void phase_prologue(const Frame& F, const Params& p) {
    unsigned char* ws = p.ws;
    { LAS float* scr = (LAS float*)(F.lds + F.wave * 16384);
      const int gw = F.vcu * NWAVES + F.wave, NGW = F.G * NWAVES, nblk = 2 * INNER / 32, nitems = (DM / 64) * nblk;
      for (int it = gw; it < nitems; it += NGW) { const int kb = it / nblk, nb = it - kb * nblk, n0 = 32 * nb;
          if (n0 < INNER) transpose_item<false>(p.w_up, DM, 2 * INNER, (bf16_t*)(ws + WS_WUP), 64 * kb, n0, n0, scr, F.lane);
          else transpose_item_fp8(p.w_up, DM, 2 * INNER, ws + WS_WZQ - (size_t)INNER * DM, 64 * kb, n0, FP8_SB_WZ, scr, F.lane); } }
    const size_t gt = (size_t)F.vcu * NTHR + F.tid, NT = (size_t)F.G * NTHR;
    bf16_t* xb = (bf16_t*)(ws + WS_XB);
    for (size_t i0 = gt; i0 < (size_t)TT * (DM / 8); i0 += 4 * NT) {
        f32x4 a[4], b[4];
#pragma unroll
        for (int u = 0; u < 4; ++u) { const size_t i = i0 + (size_t)u * NT; if (i < (size_t)TT * (DM / 8)) { const size_t tok = i >> 9; const int c8 = (int)(i & 511) * 8;
            const float* src = tok < TP ? p.x_prompt + tok * DM + c8 : p.x_sample + (tok - TP) * DM + c8; a[u] = ld_nt((const f32x4*)src); b[u] = ld_nt((const f32x4*)(src + 4)); } }
#pragma unroll
        for (int u = 0; u < 4; ++u) { const size_t i = i0 + (size_t)u * NT; if (i < (size_t)TT * (DM / 8)) { const size_t tok = i >> 9; const int c8 = (int)(i & 511) * 8;
            u32x4 w; w.x = pk_bf16(a[u][0], a[u][1]); w.y = pk_bf16(a[u][2], a[u][3]); w.z = pk_bf16(b[u][0], b[u][1]); w.w = pk_bf16(b[u][2], b[u][3]);
            *(u32x4*)(xb + tok * DM + c8) = w;
            u32x2 q8; q8.x = pk_fp8x4(a[u][0] * FP8_SA_X, a[u][1] * FP8_SA_X, a[u][2] * FP8_SA_X, a[u][3] * FP8_SA_X); q8.y = pk_fp8x4(b[u][0] * FP8_SA_X, b[u][1] * FP8_SA_X, b[u][2] * FP8_SA_X, b[u][3] * FP8_SA_X);
            *(u32x2*)(ws + WS_XQ + tok * DM + c8) = q8; } }
    }
    for (size_t i = gt; i < (WS_ZERO_BYTES - WS_GATES) / 16; i += NT) *(u32x4*)(ws + WS_GATES + 16 * i) = (u32x4){0u, 0u, 0u, 0u};
    for (size_t i = gt; i < (size_t)32 * 1024 / 4; i += NT) *(f32x4*)(p.out + O_PN + 4 * i) = (f32x4){0.f, 0.f, 0.f, 0.f};
    bf16_t* GT = (bf16_t*)(ws + WS_GT);
    for (size_t i = gt; i < (size_t)2 * 16 * INNER; i += NT) { const int c = (int)(i & 8191), g = (int)(i >> 13) & 15, which = (int)(i >> 17);
        const int n = c >> 2, d = c & 3; float s = 0.f;
        if (which == 0) {
#pragma unroll
            for (int e = 0; e < 4; ++e) s += p.w_q[n * 16 + d * 4 + e] * p.w_gate[(size_t)(0 * INNER + 4 * n + e) * 16 + g] + p.w_k[n * 16 + d * 4 + e] * p.w_gate[(size_t)(1 * INNER + 4 * n + e) * 16 + g];
        } else {
#pragma unroll
            for (int e = 0; e < 4; ++e) s += p.w_v[n * 16 + d * 4 + e] * p.w_gate[(size_t)(2 * INNER + 4 * n + e) * 16 + g];
        }
        GT[i] = f2bf(s); }
}

template <bool SAMP>
DI void passA_item(const Frame& F, const Params& p, int tg, int cg, int step0 = 0, int nstep = 4) {
    unsigned char* ws = p.ws;
    const bf16_t* __restrict__ xm = (const bf16_t*)(ws + WS_XM); bf16_t* __restrict__ xa = (bf16_t*)(ws + WS_XA); const bf16_t* __restrict__ GT = (const bf16_t*)(ws + WS_GT); float* gates = (float*)(ws + WS_GATES);
    LAS f32x4* red = (LAS f32x4*)F.lds;
    LAS unsigned short* tVw = (LAS unsigned short*)(F.lds + 32768 + F.wave * 4096);
    const int fr = F.lane & 15, fq = F.lane >> 4;
    f32x4 accg[4];
#pragma unroll
    for (int j = 0; j < 4; ++j) accg[j] = (f32x4){0.f, 0.f, 0.f, 0.f};
    const int tokb = tg * 64 + fr;
    for (int step = step0; step < step0 + nstep; ++step) {
        const int c = cg * 1024 + F.wave * 128 + 32 * step + 8 * fq;
        f32x4 wv[5][2];
#pragma unroll
        for (int j = 0; j < 4; ++j) { wv[j][0] = *(const f32x4*)(p.w_mconv + (size_t)j * INNER + c); wv[j][1] = *(const f32x4*)(p.w_mconv + (size_t)j * INNER + c + 4); }
        wv[4][0] = *(const f32x4*)(p.b_mconv + c); wv[4][1] = *(const f32x4*)(p.b_mconv + c + 4);
        const bf16x8 ga = *(const bf16x8*)(GT + (size_t)(0 * 16 + fr) * INNER + c), gm = *(const bf16x8*)(GT + (size_t)(1 * 16 + fr) * INNER + c);
        f32x4 wvv[2][4];
        if (!SAMP) {
#pragma unroll
            for (int bb = 0; bb < 2; ++bb)
#pragma unroll
                for (int d = 0; d < 4; ++d) wvv[bb][d] = *(const f32x4*)(p.w_v + (size_t)((c >> 2) + bb) * 16 + 4 * d); }
#pragma unroll
      for (int th = 0; th < 2; ++th) {
        u32x4 raw[4][4];
#pragma unroll
        for (int tl = 2 * th; tl < 2 * th + 2; ++tl) { const int tok = tokb + 16 * tl; const int t = SAMP ? ((tok - TP) & 31) : (tok & 4095);
#pragma unroll
            for (int j = 0; j < 4; ++j) { const int back = (3 - j) < t ? (3 - j) : t;
                raw[tl][j] = *(const u32x4*)(xm + (size_t)(tok - back) * INNER + c); } }
#pragma unroll
        for (int tl = 2 * th; tl < 2 * th + 2; ++tl) { const int tok = tokb + 16 * tl; const int t = SAMP ? ((tok - TP) & 31) : (tok & 4095);
            float xc[8];
#pragma unroll
            for (int i = 0; i < 8; ++i) xc[i] = wv[4][i >> 2][i & 3];
#pragma unroll
            for (int j = 0; j < 4; ++j) { const int tj = t + j - 3; float xin[8]; unpack8(raw[tl][j], xin);
                if (tj < 0) {
                    if (SAMP) { const int bsm = (tok - TP) >> 5; const float* hp = p.st_mconv + (size_t)(bsm * 3 + tj + 3) * INNER + c; const f32x4 h0 = *(const f32x4*)hp, h1 = *(const f32x4*)(hp + 4);
                        xin[0] = h0[0]; xin[1] = h0[1]; xin[2] = h0[2]; xin[3] = h0[3]; xin[4] = h1[0]; xin[5] = h1[1]; xin[6] = h1[2]; xin[7] = h1[3]; }
                    else {
#pragma unroll
                        for (int i = 0; i < 8; ++i) xin[i] = 0.f; } }
#pragma unroll
                for (int i = 0; i < 8; ++i) xc[i] += wv[j][i >> 2][i & 3] * xin[i]; }
#pragma unroll
            for (int i = 0; i < 8; ++i) xc[i] = fsilu(xc[i]);
            const u32x4 xa4 = pack8(xc);
            *(u32x4*)(xa + (size_t)tok * INNER + c) = xa4;
            if (!SAMP) { u32x2 x8v; x8v.x = pk_fp8x4(xc[0] * FP8_SA_XA, xc[1] * FP8_SA_XA, xc[2] * FP8_SA_XA, xc[3] * FP8_SA_XA); x8v.y = pk_fp8x4(xc[4] * FP8_SA_XA, xc[5] * FP8_SA_XA, xc[6] * FP8_SA_XA, xc[7] * FP8_SA_XA);
                *(u32x2*)((unsigned char*)p.out + O8_XA8 + (size_t)tok * INNER + c) = x8v; }
            accg[tl] = __builtin_amdgcn_mfma_f32_16x16x32_bf16(__builtin_bit_cast(bf16x8, xa4), ga, accg[tl], 0, 0, 0);
            accg[tl] = __builtin_amdgcn_mfma_f32_16x16x32_bf16(__builtin_bit_cast(bf16x8, raw[tl][3]), gm, accg[tl], 0, 0, 0);
            if (!SAMP) {
                float xv[8]; unpack8(raw[tl][3], xv);
                const int col = 16 * tl + fr, dw = ((col >> 1) ^ (8 * fq)) << 1;
#pragma unroll
                for (int bb = 0; bb < 2; ++bb)
#pragma unroll
                    for (int e = 0; e < 4; ++e) { const float v = xv[4 * bb] * wvv[bb][0][e] + xv[4 * bb + 1] * wvv[bb][1][e] + xv[4 * bb + 2] * wvv[bb][2][e] + xv[4 * bb + 3] * wvv[bb][3][e];
                        tVw[(8 * fq + 4 * bb + e) * 64 + dw + (col & 1)] = f2bf(v); } }
        }
      }
        if (!SAMP) {
            asm volatile("s_waitcnt lgkmcnt(0)" ::: "memory");
#pragma unroll
            for (int k = 0; k < 4; ++k) { const int q = F.lane + 64 * k, row = q >> 3, ch = q & 7;
                const u32x4 vrow = *(const LAS u32x4*)(tVw + row * 64 + ((((4 * ch) ^ (8 * (row >> 3)))) << 1));
                const size_t chan = (size_t)(cg * 1024 + F.wave * 128 + 32 * step + row);
                *(u32x4*)((bf16_t*)(ws + WS_VT) + chan * TPP + tg * 64 + 8 * ch) = vrow;
                float vf[8]; unpack8(vrow, vf); u32x2 v8; v8.x = pk_fp8x4(vf[0] * FP8_SA_V, vf[1] * FP8_SA_V, vf[2] * FP8_SA_V, vf[3] * FP8_SA_V); v8.y = pk_fp8x4(vf[4] * FP8_SA_V, vf[5] * FP8_SA_V, vf[6] * FP8_SA_V, vf[7] * FP8_SA_V);
                *(u32x2*)(ws + WS_VT8 + chan * P8 + tg * 64 + 8 * ch) = v8; }
            asm volatile("s_waitcnt lgkmcnt(0)" ::: "memory"); }
    }
    __syncthreads();
#pragma unroll
    for (int tl = 0; tl < 4; ++tl) red[(F.wave * 4 + tl) * 64 + F.lane] = accg[tl];
    __syncthreads();
    if (F.tid < 256 && !F.dry) { const int tl = F.tid >> 6, ln = F.tid & 63; f32x4 sacc = (f32x4){0.f, 0.f, 0.f, 0.f};
#pragma unroll
        for (int w = 0; w < NWAVES; ++w) sacc += red[(w * 4 + tl) * 64 + ln];
#pragma unroll
        for (int j = 0; j < 4; ++j) atomicAdd(gates + (size_t)(tg * 64 + 16 * tl + 4 * (ln >> 4) + j) * 16 + (ln & 15), sacc[j]); }
}
DI void phase_passA(const Frame& F, const Params& p) {
    unsigned char* ws = p.ws;
    const bf16_t* xm = (const bf16_t*)(ws + WS_XM);
    for (int it = F.vcu; it < (TP / 64) * 8 + (TS / 64) * 8 * 4; it += F.G) { const int item = (TP / 64) * 8 + (TS / 64) * 8 * 4 - 1 - it;
        if (item < (TP / 64) * 8) passA_item<false>(F, p, item >> 3, item & 7);
        else { const int si = item - (TP / 64) * 8; passA_item<true>(F, p, TP / 64 + (si >> 5), (si >> 2) & 7, si & 3, 1); } }
    const size_t gt = (size_t)F.vcu * NTHR + F.tid, NT = (size_t)F.G * NTHR;
    for (size_t i = gt; i < (size_t)(4 + 16) * 3 * (INNER / 8); i += NT) { const int c8 = (int)(i & 1023) * 8, ri = (int)(i >> 10), sq = ri / 3, k = ri - sq * 3;
        size_t tok; float* dst;
        if (sq < 4) { tok = (size_t)sq * 4096 + 4093 + k; dst = p.out + O_PMC + (size_t)(sq * 3 + k) * INNER + c8; }
        else { const int b = sq - 4; tok = (size_t)TP + b * 32 + 29 + k; dst = p.out + O_SMC + (size_t)(b * 3 + k) * INNER + c8; }
        float f[8]; unpack8(*(const u32x4*)(xm + tok * INNER + c8), f);
        *(f32x4*)dst = (f32x4){f[0], f[1], f[2], f[3]}; *(f32x4*)(dst + 4) = (f32x4){f[4], f[5], f[6], f[7]}; }
}

DI void headwise8(const float (&x)[8], const float* W, int n0, float scale, float (&y)[8]) {
#pragma unroll
    for (int bb = 0; bb < 2; ++bb) { const float* w = W + (size_t)(n0 + bb) * 16; const f32x4 w0 = *(const f32x4*)w, w1 = *(const f32x4*)(w + 4), w2 = *(const f32x4*)(w + 8), w3 = *(const f32x4*)(w + 12);
#pragma unroll
        for (int e = 0; e < 4; ++e) y[4 * bb + e] = (x[4 * bb] * w0[e] + x[4 * bb + 1] * w1[e] + x[4 * bb + 2] * w2[e] + x[4 * bb + 3] * w3[e]) * scale; }
}

DI float block_excl_add(float v, LAS float* sm, int lane, int wave) {
    float incl = v;
#pragma unroll
    for (int o = 1; o < 64; o <<= 1) { const float t = __shfl_up(incl, o); if (lane >= o) incl += t; }
    __syncthreads();
    if (lane == 63) sm[wave] = incl;
    __syncthreads();
    float woff = 0.f;
#pragma unroll
    for (int w = 0; w < NWAVES; ++w) { const float t = sm[w]; if (w < wave) woff += t; }
    return woff + incl - v;
}
DI float block_excl_max(float v, LAS float* sm, int lane, int wave) {
    float incl = v;
#pragma unroll
    for (int o = 1; o < 64; o <<= 1) { const float t = __shfl_up(incl, o); if (lane >= o) incl = fmaxf(incl, t); }
    float excl = __shfl_up(incl, 1); if (lane == 0) excl = -3.0e38f;
    __syncthreads();
    if (lane == 63) sm[wave] = incl;
    __syncthreads();
    float woff = -3.0e38f;
#pragma unroll
    for (int w = 0; w < NWAVES; ++w) { const float t = sm[w]; if (w < wave) woff = fmaxf(woff, t); }
    return fmaxf(woff, excl);
}
DI void scan_prompt(const Frame& F, const Params& p, int bh) {
    unsigned char* ws = p.ws;
    const float* gates = (const float*)(ws + WS_GATES); float* cs = (float*)(ws + WS_CS); float* mx = (float*)(ws + WS_MX); float* em = (float*)(ws + WS_EM); float* mxl = (float*)(ws + WS_MXL);
    LAS float* sm = (LAS float*)(F.lds + 1024);
    const int b = bh >> 3, h = bh & 7; const float bi = p.b_gate[h], bf = p.b_gate[8 + h];
    const float* gp = gates + (size_t)(b * 4096 + 8 * F.tid) * 16;
    float ig[8], lf[8];
#pragma unroll
    for (int k = 0; k < 8; ++k) { ig[k] = gp[k * 16 + h]; lf[k] = gp[k * 16 + 8 + h]; }
    float s = 0.f;
#pragma unroll
    for (int k = 0; k < 8; ++k) { ig[k] += bi; lf[k] = logsig(lf[k] + bf); s += lf[k]; }
    float run = block_excl_add(s, sm, F.lane, F.wave);
    float c[8], B[8], mloc = -3.0e38f;
#pragma unroll
    for (int k = 0; k < 8; ++k) { run += lf[k]; B[k] = run; c[k] = ig[k] - run; mloc = fmaxf(mloc, c[k]); }
    float rm = fmaxf(0.f, block_excl_max(mloc, sm, F.lane, F.wave));
    f32x4 oc[2], om[2], oe[2];
#pragma unroll
    for (int k = 0; k < 8; ++k) { rm = fmaxf(rm, c[k]); oc[k >> 2][k & 3] = c[k]; om[k >> 2][k & 3] = rm; oe[k >> 2][k & 3] = expf(-(B[k] + rm)); }
    const size_t o = (size_t)bh * 4096 + 8 * F.tid;
    *(f32x4*)(cs + o) = oc[0]; *(f32x4*)(cs + o + 4) = oc[1]; *(f32x4*)(mx + o) = om[0]; *(f32x4*)(mx + o + 4) = om[1]; *(f32x4*)(em + o) = oe[0]; *(f32x4*)(em + o + 4) = oe[1];
    if (F.tid == NTHR - 1) { p.out[O_PM + bh] = B[7] + rm; mxl[bh] = rm; }
}

DI void sample_prep(const Frame& F, const Params& p, int bh) {
    unsigned char* ws = p.ws;
    const float* gates = (const float*)(ws + WS_GATES); const bf16_t* __restrict__ xa = (const bf16_t*)(ws + WS_XA); const bf16_t* __restrict__ xm = (const bf16_t*)(ws + WS_XM);
    bf16_t* __restrict__ Sp = (bf16_t*)(ws + WS_SSP); bf16_t* __restrict__ qt = (bf16_t*)(ws + WS_SQT); bf16_t* __restrict__ wkT = (bf16_t*)(ws + WS_SWK); bf16_t* __restrict__ vTs = (bf16_t*)(ws + WS_SVT); float* scb = (float*)(ws + WS_MXL + 1024);
    LAS float* red = (LAS float*)(F.lds + 4096);
    LAS float* scr = (LAS float*)(F.lds + F.wave * 512);
    const int lane = F.lane, b = bh >> 3, h = bh & 7, r = lane & 31, hf = lane >> 5, tok0 = TP + 32 * b;
    const float ig = gates[(size_t)(tok0 + r) * 16 + h] + p.b_gate[h], lf = logsig(gates[(size_t)(tok0 + r) * 16 + 8 + h] + p.b_gate[8 + h]);
    float bc = lf;
#pragma unroll
    for (int o = 1; o < 32; o <<= 1) { const float v = __shfl_up(bc, o, 32); if (r >= o) bc += v; }
    const float m0 = p.st_m[bh], c = ig - bc;
    float pmx = c;
#pragma unroll
    for (int o = 1; o < 32; o <<= 1) { const float v = __shfl_up(pmx, o, 32); if (r >= o) pmx = fmaxf(pmx, v); }
    const float mxt = fmaxf(m0, pmx), m_t = bc + mxt, inter = expf(m0 - mxt), emt = expf(-m_t);
    const float mx31 = __shfl(mxt, 31), b31 = __shfl(bc, 31);
    const float w_s = expf(c - mx31), scv = expf(m0 - mx31);
    const int dkw = 128 * F.wave;
    const bf16_t* xar = xa + (size_t)(tok0 + r) * INNER + h * 1024 + dkw + 8 * hf; const bf16_t* xmr = xm + (size_t)(tok0 + r) * INNER + h * 1024 + dkw + 8 * hf;
    const float* n0v = p.st_n + (size_t)bh * 1024 + dkw + 8 * hf;
    f32x16 accS;
#pragma unroll
    for (int i = 0; i < 16; ++i) accS[i] = 0.f;
    float qn = 0.f;
#pragma unroll 4
    for (int kk = 0; kk < 8; ++kk) {
        float x[8], q[8], k[8]; unpack8(*(const u32x4*)(xar + 16 * kk), x);
        const int n0 = (h * 1024 + dkw + 16 * kk + 8 * hf) >> 2;
        headwise8(x, p.w_q, n0, 1.0f, q); headwise8(x, p.w_k, n0, 0.03125f, k);
        const f32x4 na = *(const f32x4*)(n0v + 16 * kk), nb = *(const f32x4*)(n0v + 16 * kk + 4);
        qn += q[0] * na[0] + q[1] * na[1] + q[2] * na[2] + q[3] * na[3] + q[4] * nb[0] + q[5] * nb[1] + q[6] * nb[2] + q[7] * nb[3];
        accS = __builtin_amdgcn_mfma_f32_32x32x16_bf16(__builtin_bit_cast(bf16x8, pack8(q)), __builtin_bit_cast(bf16x8, pack8(k)), accS, 0, 0, 0);
    }
    __syncthreads();
#pragma unroll
    for (int i = 0; i < 16; ++i) red[(F.wave * 17 + i) * 64 + lane] = accS[i];
    red[(F.wave * 17 + 16) * 64 + lane] = qn;
    __syncthreads();
    qn = 0.f;
#pragma unroll
    for (int i = 0; i < 16; ++i) accS[i] = 0.f;
#pragma unroll
    for (int w = 0; w < NWAVES; ++w) {
#pragma unroll
        for (int i = 0; i < 16; ++i) accS[i] += red[(w * 17 + i) * 64 + lane];
        qn += red[(w * 17 + 16) * 64 + lane]; }
    qn += __shfl_xor(qn, 32);
    float sv[16];
#pragma unroll
    for (int i = 0; i < 16; ++i) { const int t = (i & 3) + 8 * (i >> 2) + 4 * hf; const float mxq = __shfl(mxt, t);
        const float d = (r <= t) ? expf(c - mxq) : 0.f; sv[i] = accS[i] * d;
        float rs = sv[i];
#pragma unroll
        for (int o = 1; o < 32; o <<= 1) rs += __shfl_xor(rs, o);
        if (r == 0) scr[t] = rs; }
    asm volatile("s_waitcnt lgkmcnt(0)" ::: "memory");
    const float den = scr[r] + inter * qn, g = 1.0f / fmaxf(fabsf(den), emt), f = inter * g;
    asm volatile("s_waitcnt lgkmcnt(0)" ::: "memory");
    if (hf == 0) scr[32 + r] = g;
    asm volatile("s_waitcnt lgkmcnt(0)" ::: "memory");
    if (F.wave == 0) {
#pragma unroll
        for (int i = 0; i < 16; ++i) { const int t = (i & 3) + 8 * (i >> 2) + 4 * hf; Sp[(size_t)(bh * 32 + t) * 32 + r] = f2bf(sv[i] * scr[32 + t]); } }
    asm volatile("s_waitcnt lgkmcnt(0)" ::: "memory");
#pragma unroll 2
    for (int kk = 0; kk < 8; ++kk) {
        float x[8], xv[8], q[8], k[8], v[8]; unpack8(*(const u32x4*)(xar + 16 * kk), x); unpack8(*(const u32x4*)(xmr + 16 * kk), xv);
        const int dk0 = dkw + 16 * kk + 8 * hf, n0 = (h * 1024 + dk0) >> 2;
        const float n0s[8] = {p.st_n[(size_t)bh * 1024 + dk0], p.st_n[(size_t)bh * 1024 + dk0 + 1], p.st_n[(size_t)bh * 1024 + dk0 + 2], p.st_n[(size_t)bh * 1024 + dk0 + 3],
                              p.st_n[(size_t)bh * 1024 + dk0 + 4], p.st_n[(size_t)bh * 1024 + dk0 + 5], p.st_n[(size_t)bh * 1024 + dk0 + 6], p.st_n[(size_t)bh * 1024 + dk0 + 7]};
        headwise8(x, p.w_q, n0, 1.0f, q); headwise8(x, p.w_k, n0, 0.03125f, k); headwise8(xv, p.w_v, n0, 1.0f, v);
#pragma unroll
        for (int i = 0; i < 8; ++i) q[i] *= f;
        *(u32x4*)(qt + (size_t)(bh * 32 + r) * 1024 + dk0) = pack8(q);
#pragma unroll
        for (int i = 0; i < 8; ++i) { const float wk = k[i] * w_s; wkT[(size_t)(bh * 1024 + dk0 + i) * 32 + r] = f2bf(wk); vTs[(size_t)(bh * 1024 + dk0 + i) * 32 + r] = f2bf(v[i]);
            float ns = wk;
#pragma unroll
            for (int o = 1; o < 32; o <<= 1) ns += __shfl_xor(ns, o);
            if (r == 0) p.out[O_SN + (size_t)bh * 1024 + dk0 + i] = scv * n0s[i] + ns; }
    }
    if (F.tid == 0) { p.out[O_SM + bh] = b31 + mx31; scb[bh] = scv; }
    __syncthreads();
}

DI void phase_passB(const Frame& F, const Params& p) {
    unsigned char* ws = p.ws;
    const bf16_t* __restrict__ xa = (const bf16_t*)(ws + WS_XA); const bf16_t* __restrict__ xm = (const bf16_t*)(ws + WS_XM); bf16_t* __restrict__ qp = (bf16_t*)(ws + WS_QP); bf16_t* __restrict__ kwT = (bf16_t*)(ws + WS_KWT); bf16_t* __restrict__ vT = (bf16_t*)(ws + WS_VT);
    const float* cs = (const float*)(ws + WS_CS); const float* mxl = (const float*)(ws + WS_MXL);
    unsigned char* __restrict__ q8 = (unsigned char*)p.out + O8_Q8; unsigned char* __restrict__ xa8 = (unsigned char*)p.out + O8_XA8;
    LAS bf16_t* tK = (LAS bf16_t*)F.lds;
    const int g = F.tid & 7, tl = F.tid >> 3;
    for (int item = F.vcu; item < 2048; item += F.G) {
        const int cb = item & 127, tb = item >> 7, b = tb >> 2, h = cb >> 4, bh = b * 8 + h, c = cb * 64 + 8 * g, n0 = c >> 2;
        float wqk[2][4][4], wkk[2][4][4], wvv[2][4][4];
#pragma unroll
        for (int bb = 0; bb < 2; ++bb) { float wq[4][4];
#pragma unroll
            for (int d = 0; d < 4; ++d) { const f32x4 a = *(const f32x4*)(p.w_q + (size_t)(n0 + bb) * 16 + 4 * d), k4 = *(const f32x4*)(p.w_k + (size_t)(n0 + bb) * 16 + 4 * d), v4 = *(const f32x4*)(p.w_v + (size_t)(n0 + bb) * 16 + 4 * d);
#pragma unroll
                for (int e = 0; e < 4; ++e) { wq[d][e] = a[e]; wkk[bb][d][e] = k4[e] * 0.03125f; wvv[bb][d][e] = v4[e]; } }
#pragma unroll
            for (int d = 0; d < 4; ++d)
#pragma unroll
                for (int d2 = 0; d2 < 4; ++d2) wqk[bb][d][d2] = wq[d][0] * wkk[bb][d2][0] + wq[d][1] * wkk[bb][d2][1] + wq[d][2] * wkk[bb][d2][2] + wq[d][3] * wkk[bb][d2][3]; }
        const float mxlast = mxl[bh];
        float nacc[8];
#pragma unroll
        for (int i = 0; i < 8; ++i) nacc[i] = 0.f;
        const int tokb = tb * 1024 + tl;
#pragma unroll 1
        for (int sub4 = 0; sub4 < 16; sub4 += 2) {
          u32x4 rxa[2];
#pragma unroll
          for (int u = 0; u < 2; ++u) { const int tk = tokb + (sub4 + u) * 64; rxa[u] = *(const u32x4*)(xa + (size_t)tk * INNER + c); }
          const float rcs0 = cs[bh * 4096 + ((tokb + sub4 * 64) & 4095)], rcs1 = cs[bh * 4096 + ((tokb + sub4 * 64 + 64) & 4095)];
#pragma unroll
          for (int u = 0; u < 2; ++u) {
            const int sub = sub4 + u, tok = tokb + sub * 64;
            const u32x4 cxa = rxa[u]; const float ccs = u ? rcs1 : rcs0;
            float x[8], q[8], kw[8]; unpack8(cxa, x);
            const float w = fexp(ccs - mxlast);
#pragma unroll
            for (int bb = 0; bb < 2; ++bb)
#pragma unroll
                for (int e = 0; e < 4; ++e) {
                    q[4 * bb + e] = x[4 * bb] * wqk[bb][0][e] + x[4 * bb + 1] * wqk[bb][1][e] + x[4 * bb + 2] * wqk[bb][2][e] + x[4 * bb + 3] * wqk[bb][3][e];
                    kw[4 * bb + e] = (x[4 * bb] * wkk[bb][0][e] + x[4 * bb + 1] * wkk[bb][1][e] + x[4 * bb + 2] * wkk[bb][2][e] + x[4 * bb + 3] * wkk[bb][3][e]) * w; }
            *(u32x4*)(qp + (size_t)tok * INNER + c) = pack8(q);
            { u32x2 q8v, x8v; q8v.x = pk_fp8x4(q[0] * FP8_SA_Q, q[1] * FP8_SA_Q, q[2] * FP8_SA_Q, q[3] * FP8_SA_Q); q8v.y = pk_fp8x4(q[4] * FP8_SA_Q, q[5] * FP8_SA_Q, q[6] * FP8_SA_Q, q[7] * FP8_SA_Q);
              *(u32x2*)(q8 + (size_t)tok * INNER + c) = q8v; (void)x8v; }
            LAS bf16_t* bK = tK + (sub & 1) * (64 * 72);
#pragma unroll
            for (int i = 0; i < 8; ++i) { nacc[i] += kw[i]; bK[(8 * i + g) * 72 + tl] = f2bf(kw[i]); }
            LDS_BARRIER();
            { const int row = F.tid >> 3, ch = F.tid & 7, chan = 8 * (row & 7) + (row >> 3); const size_t o = (size_t)(cb * 64 + chan) * TPP + tb * 1024 + sub * 64 + 8 * ch;
              *(u32x4*)(kwT + o) = *(const LAS u32x4*)(bK + row * 72 + 8 * ch); }
          }
        }
        LDS_BARRIER();
#pragma unroll
        for (int i = 0; i < 8; ++i) { float v = nacc[i]; v += __shfl_xor(v, 8); v += __shfl_xor(v, 16); v += __shfl_xor(v, 32);
            if (F.lane < 8 && !F.dry) atomicAdd(p.out + O_PN + (size_t)bh * 1024 + (c & 1023) + i, v); }
    }
}

DI void phase_sample_cell(const Frame& F, const Params& p) {
    unsigned char* ws = p.ws;
    const bf16_t* __restrict__ Sp = (const bf16_t*)(ws + WS_SSP); const bf16_t* __restrict__ qt = (const bf16_t*)(ws + WS_SQT); const bf16_t* __restrict__ wkT = (const bf16_t*)(ws + WS_SWK); const bf16_t* __restrict__ vTs = (const bf16_t*)(ws + WS_SVT);
    const float* scb = (const float*)(ws + WS_MXL + 1024); bf16_t* __restrict__ hs = (bf16_t*)(ws + WS_HS);
    const int r = F.lane & 31, hf = F.lane >> 5, gw = F.vcu * NWAVES + F.wave, NGW = F.G * NWAVES;
    for (int item = gw; item < 128 * 16; item += NGW) {
        const int bh = item >> 4, dvp = item & 15, b = bh >> 3, h = bh & 7;
        const __amdgpu_buffer_rsrc_t rC0 = __builtin_amdgcn_make_buffer_rsrc((void*)(p.st_C + ((size_t)bh << 20)), 0, 1 << 22, 0x00020000);
        const __amdgpu_buffer_rsrc_t rCn = __builtin_amdgcn_make_buffer_rsrc((void*)(p.out + O_SC + ((size_t)bh << 20)), 0, 1 << 22, 0x00020000);
        const unsigned voff = (unsigned)((4 * hf) * 1024 + r) * 4u; const int sbase = dvp * 256;
#define SC_OFF(dkt_, i_, d_) (sbase + ((dkt_) * 32 + ((i_) & 3) + 8 * ((i_) >> 2)) * 4096 + (d_) * 128)
        const float sc = scb[bh];
        bf16x8 vf[2][2], sf[2];
#pragma unroll
        for (int s2 = 0; s2 < 2; ++s2) { sf[s2] = *(const bf16x8*)(Sp + (size_t)(bh * 32 + r) * 32 + 16 * s2 + 8 * hf);
#pragma unroll
            for (int d = 0; d < 2; ++d) vf[d][s2] = *(const bf16x8*)(vTs + (size_t)(bh * 1024 + dvp * 64 + 32 * d + r) * 32 + 16 * s2 + 8 * hf); }
        f32x16 acch[2];
#pragma unroll
        for (int d = 0; d < 2; ++d) {
#pragma unroll
            for (int i = 0; i < 16; ++i) acch[d][i] = 0.f;
            acch[d] = __builtin_amdgcn_mfma_f32_32x32x16_bf16(sf[0], vf[d][0], acch[d], 0, 0, 0); acch[d] = __builtin_amdgcn_mfma_f32_32x32x16_bf16(sf[1], vf[d][1], acch[d], 0, 0, 0); }
        const bf16_t* qrow = qt + (size_t)(bh * 32 + r) * 1024 + 4 * hf; const bf16_t* wkrow = wkT + (size_t)(bh * 1024 + r) * 32 + 8 * hf;
        f32x16 cn[2];
#pragma unroll
        for (int d = 0; d < 2; ++d)
#pragma unroll
            for (int i = 0; i < 16; ++i) cn[d][i] = __uint_as_float(__builtin_amdgcn_raw_buffer_load_b32(rC0, voff, SC_OFF(0, i, d), 2));
        for (int dkt = 0; dkt < 32; ++dkt) {
            f32x16 c[2] = {cn[0], cn[1]};
            if (dkt < 31) {
#pragma unroll
                for (int d = 0; d < 2; ++d)
#pragma unroll
                    for (int i = 0; i < 16; ++i) cn[d][i] = __uint_as_float(__builtin_amdgcn_raw_buffer_load_b32(rC0, voff, SC_OFF(dkt + 1, i, d), 2)); }
            bf16x8 pa[2], wa[2];
#pragma unroll
            for (int s = 0; s < 2; ++s) { const u32x2 lo = *(const u32x2*)(qrow + dkt * 32 + 16 * s), hi = *(const u32x2*)(qrow + dkt * 32 + 16 * s + 8);
                u32x4 t4; t4.x = lo.x; t4.y = lo.y; t4.z = hi.x; t4.w = hi.y; pa[s] = __builtin_bit_cast(bf16x8, t4);
                wa[s] = *(const bf16x8*)(wkrow + (size_t)dkt * 32 * 32 + 16 * s); }
#pragma unroll
            for (int d = 0; d < 2; ++d) {
#pragma unroll
                for (int s = 0; s < 2; ++s) { u32x4 xs; xs.x = pk_bf16(c[d][8 * s], c[d][8 * s + 1]); xs.y = pk_bf16(c[d][8 * s + 2], c[d][8 * s + 3]); xs.z = pk_bf16(c[d][8 * s + 4], c[d][8 * s + 5]); xs.w = pk_bf16(c[d][8 * s + 6], c[d][8 * s + 7]);
                    acch[d] = __builtin_amdgcn_mfma_f32_32x32x16_bf16(pa[s], __builtin_bit_cast(bf16x8, xs), acch[d], 0, 0, 0); }
#pragma unroll
                for (int i = 0; i < 16; ++i) c[d][i] *= sc;
                c[d] = __builtin_amdgcn_mfma_f32_32x32x16_bf16(wa[0], vf[d][0], c[d], 0, 0, 0); c[d] = __builtin_amdgcn_mfma_f32_32x32x16_bf16(wa[1], vf[d][1], c[d], 0, 0, 0);
#pragma unroll
                for (int i = 0; i < 16; ++i) __builtin_amdgcn_raw_buffer_store_b32(__float_as_uint(c[d][i]), rCn, voff, SC_OFF(dkt, i, d), 2); }
        }
#pragma unroll
        for (int d = 0; d < 2; ++d)
#pragma unroll
            for (int i = 0; i < 16; ++i) { const int t = (i & 3) + 8 * (i >> 2) + 4 * hf; hs[(size_t)(b * 32 + t) * INNER + h * 1024 + dvp * 64 + 32 * d + r] = f2bf(acch[d][i]); }
#undef SC_OFF
    }
}

DI void phase_predown(const Frame& F, const Params& p) {
    unsigned char* ws = p.ws;
    const bf16_t* __restrict__ hb = (const bf16_t*)(ws + WS_H); const bf16_t* __restrict__ hs = (const bf16_t*)(ws + WS_HS); const bf16_t* __restrict__ xa = (const bf16_t*)(ws + WS_XA); const bf16_t* __restrict__ sz = (const bf16_t*)(ws + WS_SZ);
    unsigned char* __restrict__ pre = ws + WS_PRE;
    const int gw = F.vcu * NWAVES + F.wave, NGW = F.G * NWAVES;
    if ((NGW & 7) != 0) return;
    const int h = gw & 7, cc0 = h * 1024 + 8 * F.lane;
    f32x4 gk[2][4];
#pragma unroll
    for (int j = 0; j < 2; ++j) { gk[j][0] = *(const f32x4*)(p.mh_gain + cc0 + 512 * j); gk[j][1] = *(const f32x4*)(p.mh_gain + cc0 + 512 * j + 4); gk[j][2] = *(const f32x4*)(p.skip + cc0 + 512 * j); gk[j][3] = *(const f32x4*)(p.skip + cc0 + 512 * j + 4); }
    u32x4 nh[2], na[2], nz[2];
#define PD_LOAD(item_) do { const int tok_ = (item_) >> 3; const bf16_t* hrow_ = tok_ < TP ? hb + (size_t)tok_ * INNER + cc0 : hs + (size_t)(tok_ - TP) * INNER + cc0; \
        _Pragma("unroll") for (int j = 0; j < 2; ++j) { nh[j] = ld_nt((const u32x4*)(hrow_ + 512 * j)); na[j] = ld_nt((const u32x4*)(xa + (size_t)tok_ * INNER + cc0 + 512 * j)); nz[j] = ld_nt((const u32x4*)(sz + (size_t)tok_ * INNER + cc0 + 512 * j)); } } while (0)
    if (gw < TT * NH) PD_LOAD(gw);
    for (int item = gw; item < TT * NH; item += NGW) {
        const int tok = item >> 3;
        u32x4 ch[2] = {nh[0], nh[1]}, ca[2] = {na[0], na[1]}, cz[2] = {nz[0], nz[1]};
        if (item + NGW < TT * NH) PD_LOAD(item + NGW);
        float v[2][8]; float s = 0.f;
#pragma unroll
        for (int j = 0; j < 2; ++j) { unpack8(ch[j], v[j]);
#pragma unroll
            for (int i = 0; i < 8; ++i) s += v[j][i]; }
        const float mean = wave_sum(s) * (1.0f / 1024.0f); float s2 = 0.f;
#pragma unroll
        for (int j = 0; j < 2; ++j)
#pragma unroll
            for (int i = 0; i < 8; ++i) { v[j][i] -= mean; s2 += v[j][i] * v[j][i]; }
        const float rstd = 1.0f / sqrtf(wave_sum(s2) * (1.0f / 1024.0f) + LN_EPS);
#pragma unroll
        for (int j = 0; j < 2; ++j) { float a[8], z[8], o[8]; unpack8(ca[j], a); unpack8(cz[j], z);
#pragma unroll
            for (int i = 0; i < 4; ++i) { o[i] = (v[j][i] * rstd * gk[j][0][i] + gk[j][2][i] * a[i]) * z[i]; o[4 + i] = (v[j][4 + i] * rstd * gk[j][1][i] + gk[j][3][i] * a[4 + i]) * z[4 + i]; }
            u32x2 w8; w8.x = pk_fp8x4(o[0] * FP8_SA_PRE, o[1] * FP8_SA_PRE, o[2] * FP8_SA_PRE, o[3] * FP8_SA_PRE); w8.y = pk_fp8x4(o[4] * FP8_SA_PRE, o[5] * FP8_SA_PRE, o[6] * FP8_SA_PRE, o[7] * FP8_SA_PRE);
            *(u32x2*)(pre + (size_t)tok * INNER + cc0 + 512 * j) = w8; }
    }
#undef PD_LOAD
}

DI void ln_rows(const Frame& F, const bf16_t* src, const float* rstat, const float* part, const float* g, const float* bta, float* dstA, float* dstB, bf16_t* dstb, unsigned char* dstq, float* lnst) {
    const int gw = F.vcu * NWAVES + F.wave, NGW = F.G * NWAVES;
    LAS f32x4* gl = (LAS f32x4*)F.lds; LAS f32x4* bl = gl + DM / 4;
    __syncthreads();
    for (int i = F.tid; i < DM / 4; i += NTHR) { gl[i] = *(const f32x4*)(g + 4 * i); bl[i] = *(const f32x4*)(bta + 4 * i); }
    __syncthreads();
    constexpr int TV = TP + 4 * TS;
    for (int vr = gw + ((TV - 1 - gw) / NGW) * NGW; vr >= 0; vr -= NGW) {
        int row = vr;
        if (vr >= TP) { if ((vr - TP) & 3) continue; row = TP + ((vr - TP) >> 2); }
        f32x4 v[16]; float mean, rstd;
        if (row < TP) { const u32x2* xr = (const u32x2*)(src + (size_t)row * DM) + F.lane;
#pragma unroll
            for (int j = 0; j < 16; ++j) { const u32x2 w = xr[64 * j]; v[j] = (f32x4){bf_lo(w.x), bf_hi(w.x), bf_lo(w.y), bf_hi(w.y)}; }
            mean = rstat[(size_t)row * 2] * (1.0f / DM); rstd = 1.0f / sqrtf(fmaxf(rstat[(size_t)row * 2 + 1] * (1.0f / DM) - mean * mean, 0.f) + LN_EPS);
#pragma unroll
            for (int j = 0; j < 16; ++j) v[j] = v[j] - mean;
        } else {
#pragma unroll
            for (int j = 0; j < 16; ++j) v[j] = (f32x4){0.f, 0.f, 0.f, 0.f};
#pragma unroll 1
            for (int sp = 0; sp < 8; ++sp) { const f32x4* xr = (const f32x4*)(part + ((size_t)sp * TS + (row - TP)) * DM) + F.lane; f32x4 t[16];
#pragma unroll
                for (int j = 0; j < 16; ++j) t[j] = xr[64 * j];
                __builtin_amdgcn_sched_barrier(0);
#pragma unroll
                for (int j = 0; j < 16; ++j) v[j] += t[j]; }
            float s = 0.f;
#pragma unroll
            for (int j = 0; j < 16; ++j) s += (v[j][0] + v[j][1]) + (v[j][2] + v[j][3]);
            mean = wave_sum(s) * (1.0f / DM); float s2 = 0.f;
#pragma unroll
            for (int j = 0; j < 16; ++j) { v[j] = v[j] - mean; s2 += (v[j][0] * v[j][0] + v[j][1] * v[j][1]) + (v[j][2] * v[j][2] + v[j][3] * v[j][3]); }
            rstd = 1.0f / sqrtf(wave_sum(s2) * (1.0f / DM) + LN_EPS); }
        float* drow = row < TP ? (dstA ? dstA + (size_t)row * DM : nullptr) : dstB + (size_t)(row - TP) * DM;
        if (lnst && row < TP && F.lane == 0) { lnst[(size_t)row * 2] = mean; lnst[(size_t)row * 2 + 1] = rstd; }
        const bool wb = dstb && (row >= TP || ((row >> 8) & 15) == 15);
#pragma unroll
        for (int j = 0; j < 16; ++j) { const int cc = 4 * F.lane + 256 * j; const f32x4 gg = gl[F.lane + 64 * j], bb = bl[F.lane + 64 * j]; const f32x4 o = v[j] * rstd * gg + bb;
            if (drow) { if (dstq) *(f32x4*)(drow + cc) = o; else st_nt((f32x4*)(drow + cc), o); }
            if (wb) { u32x2 w; w.x = pk_bf16(o[0], o[1]); w.y = pk_bf16(o[2], o[3]); *(u32x2*)(dstb + (size_t)row * DM + cc) = w; }
            if (dstq) {
                *(unsigned*)(dstq + (size_t)row * DM + cc) = pk_fp8x4(o[0] * FP8_SA_X1, o[1] * FP8_SA_X1, o[2] * FP8_SA_X1, o[3] * FP8_SA_X1); } }
    }
}

DI void phase_conv31(const Frame& F, const Params& p) {
    unsigned char* ws = p.ws;
    const bf16_t* ub = (const bf16_t*)(ws + WS_U); bf16_t* cb = (bf16_t*)(ws + WS_C); float* stats = (float*)(ws + WS_STATS);
    LAS bf16_t* T = (LAS bf16_t*)F.lds;
    float w[31][2]; float2 bv = make_float2(0.f, 0.f); bool wloaded = false; int wcq = -1;
    for (int it = F.vcu; it < (TT / 32) * 4; it += F.G) { const int item = (TT / 32) * 4 - 1 - it;
        const int tt = item >> 2, cq = item & 3, cbase = cq * 1024, ch = cbase + 2 * F.tid, tok0 = tt * 32;
        const bool samp = tok0 >= TP; const int t0 = samp ? 0 : (tok0 & 4095), bsm = samp ? ((tok0 - TP) >> 5) : 0;
        __syncthreads();
#pragma unroll
        for (int k0 = 0; k0 < 16; k0 += 8) { u32x4 v[8];
#pragma unroll
            for (int k = 0; k < 8; ++k) { const int i = F.tid + (k0 + k) * NTHR, row = i >> 7, c8 = (i & 127) * 8; v[k] = (u32x4){0u, 0u, 0u, 0u};
                if (row < 62 && (row >= 30 || t0 > 0)) v[k] = *(const u32x4*)(ub + (size_t)(tok0 - 30 + row) * DM + cbase + c8); }
            __builtin_amdgcn_sched_barrier(0);
#pragma unroll
            for (int k = 0; k < 8; ++k) { const int i = F.tid + (k0 + k) * NTHR, row = i >> 7, c8 = (i & 127) * 8;
                if (row < 62) *(LAS u32x4*)(T + row * 1024 + c8) = v[k]; } }
        if (samp)
            for (int i = F.tid; i < 30 * 128; i += NTHR) { const int row = i >> 7, c8 = (i & 127) * 8; u32x4 v;
                const float* hp = p.st_cconv + (size_t)(bsm * 30 + row) * DM + cbase + c8; const f32x4 h0 = *(const f32x4*)hp, h1 = *(const f32x4*)(hp + 4);
                v.x = pk_bf16(h0[0], h0[1]); v.y = pk_bf16(h0[2], h0[3]); v.z = pk_bf16(h1[0], h1[1]); v.w = pk_bf16(h1[2], h1[3]);
                *(LAS u32x4*)(T + row * 1024 + c8) = v; }
        __syncthreads();
        if (!wloaded || cq != wcq) { wloaded = true; wcq = cq;
#pragma unroll
            for (int j = 0; j < 31; ++j) { const float2 wv = *(const float2*)(p.w_dw + (size_t)j * DM + ch); w[j][0] = wv.x; w[j][1] = wv.y; }
            bv = *(const float2*)(p.b_dw + ch); }
        float sv[64];
#pragma unroll
        for (int tq = 0; tq < 4; ++tq) {
            float x[38][2];
#pragma unroll
            for (int i = 0; i < 38; ++i) { const unsigned raw = *(const LAS unsigned*)(T + (8 * tq + i) * 1024 + 2 * F.tid); x[i][0] = bf_lo(raw); x[i][1] = bf_hi(raw); }
#pragma unroll
            for (int o = 0; o < 8; ++o) { float a0 = bv.x, a1 = bv.y;
#pragma unroll
                for (int j = 0; j < 31; ++j) { a0 += w[j][0] * x[o + j][0]; a1 += w[j][1] * x[o + j][1]; }
                const int tok = tok0 + 8 * tq + o;
                *(unsigned*)(cb + (size_t)tok * DM + ch) = pk_bf16(a0, a1);
                sv[8 * tq + o] = a0 + a1; sv[32 + 8 * tq + o] = a0 * a0 + a1 * a1; }
        }
#pragma unroll
        for (int st = 0; st < 6; ++st) { const int off = 32 >> st, n2 = 32 >> st; const bool up = (F.lane & off) != 0;
#pragma unroll
            for (int i = 0; i < n2; ++i) { const float keep = up ? sv[i + n2] : sv[i], send = up ? sv[i] : sv[i + n2]; sv[i] = keep + __shfl_xor(send, off); } }
        if (!F.dry) atomicAdd(stats + (size_t)(tok0 + (F.lane & 31)) * 2 + (F.lane >> 5), sv[0]);
    }
    __syncthreads();
    const size_t gt = (size_t)F.vcu * NTHR + F.tid, NT = (size_t)F.G * NTHR;
    for (size_t i = gt; i < (size_t)(4 + 16) * 30 * (DM / 8); i += NT) { const int c8 = (int)(i & 511) * 8, ri = (int)(i >> 9), sq = ri / 30, k = ri - sq * 30;
        size_t tok; float* dst;
        if (sq < 4) { tok = (size_t)sq * 4096 + 4066 + k; dst = p.out + O_PCC + (size_t)(sq * 30 + k) * DM + c8; }
        else { const int b = sq - 4; tok = (size_t)TP + b * 32 + 2 + k; dst = p.out + O_SCC + (size_t)(b * 30 + k) * DM + c8; }
        float f[8]; unpack8(*(const u32x4*)(ub + tok * DM + c8), f);
        *(f32x4*)dst = (f32x4){f[0], f[1], f[2], f[3]}; *(f32x4*)(dst + 4) = (f32x4){f[4], f[5], f[6], f[7]}; }
}

DI void phase_norm2(const Frame& F, const Params& p) {
    unsigned char* ws = p.ws;
    const bf16_t* __restrict__ cb = (const bf16_t*)(ws + WS_C); const bf16_t* __restrict__ szg = (const bf16_t*)(ws + WS_SZG); const float* __restrict__ stats = (const float*)(ws + WS_STATS);
    unsigned char* __restrict__ pre2 = ws + WS_PRE2;
    const size_t gt = (size_t)F.vcu * NTHR + F.tid, NT = (size_t)F.G * NTHR, NI = (size_t)TT * (DM / 8);
    if ((NT & 511) != 0) return;
    const int c8 = (int)(gt & 511) * 8;
    const f32x4 g0 = *(const f32x4*)(p.cln_g + c8), g1 = *(const f32x4*)(p.cln_g + c8 + 4), b0 = *(const f32x4*)(p.cln_b + c8), b1 = *(const f32x4*)(p.cln_b + c8 + 4);
    for (size_t i0 = gt; i0 < NI; i0 += 4 * NT) {
        u32x4 cc[4], cz[4]; float s1[4], s2[4];
#pragma unroll
        for (int u = 0; u < 4; ++u) { const size_t i = i0 + (size_t)u * NT; if (i < NI) { const size_t tok_ = i >> 9; cc[u] = *(const u32x4*)(cb + tok_ * DM + c8); cz[u] = *(const u32x4*)(szg + tok_ * DM + c8); s1[u] = stats[tok_ * 2]; s2[u] = stats[tok_ * 2 + 1]; } }
#pragma unroll
        for (int u = 0; u < 4; ++u) { const size_t i = i0 + (size_t)u * NT; if (i < NI) { const size_t tok = i >> 9;
            const float mean = s1[u] * (1.0f / DM), var = fmaxf(s2[u] * (1.0f / DM) - mean * mean, 0.f), rstd = 1.0f / sqrtf(var + LN_EPS);
            float c[8], z[8], o[8]; unpack8(cc[u], c); unpack8(cz[u], z);
#pragma unroll
            for (int k = 0; k < 4; ++k) { o[k] = fsilu((c[k] - mean) * rstd * g0[k] + b0[k]) * z[k]; o[4 + k] = fsilu((c[4 + k] - mean) * rstd * g1[k] + b1[k]) * z[4 + k]; }
            u32x2 w8; w8.x = pk_fp8x4(o[0] * FP8_SA_PRE2, o[1] * FP8_SA_PRE2, o[2] * FP8_SA_PRE2, o[3] * FP8_SA_PRE2); w8.y = pk_fp8x4(o[4] * FP8_SA_PRE2, o[5] * FP8_SA_PRE2, o[6] * FP8_SA_PRE2, o[7] * FP8_SA_PRE2);
            *(u32x2*)(pre2 + tok * DM + c8) = w8; } }
    }
}

constexpr int N_PHASES = 16;
constexpr int LDS_BYTES = 147456;
constexpr int MISC_OFF = 131072;

__global__ void __launch_bounds__(NTHR, 2) mlstm_conformer_fwd(Params p) {
    extern __shared__ __attribute__((aligned(16))) unsigned char lds_raw[];
    Frame F; F.lds = (LAS unsigned char*)lds_raw; F.wave = __builtin_amdgcn_readfirstlane((int)threadIdx.x >> 6); F.lane = lane_id(); F.tid = F.wave * 64 + F.lane;
    F.G = gridDim.x; F.bx = blockIdx.x; F.vcu = (F.G % 8 == 0) ? (F.bx % 8) * (F.G / 8) + F.bx / 8 : F.bx;
    volatile LAS unsigned* MISC = (volatile LAS unsigned*)(F.lds + MISC_OFF);
    if (F.tid < 64) MISC[F.tid] = 0u;
    __syncthreads();
    unsigned char* ws = p.ws;
#if MK_LAUNCHES == 1
    XcdBarrier bar = xcd_barrier_post((unsigned*)(ws + WS_BAR), MISC + 8, F.wave);
#define GRID_BAR() xcd_barrier(bar)
#else
#define GRID_BAR() do { } while (0)
#endif
    const int lo = p.ph_lo, hi = p.ph_hi;
#ifndef PHMASK
#define PHMASK 0xFFFF
#endif
#define IN(k) (((PHMASK >> (k)) & 1) && lo <= (k) && (k) < hi)
#define SEAM(k) do { if (IN(k) && IN((k) + 1)) GRID_BAR(); } while (0)
    LAS unsigned char* ring = F.lds;

#ifndef P5PARTS
#define P5PARTS 7
#endif
#ifndef REPMASK
#define REPMASK 0
#endif
#define NREP(k) ((((REPMASK) >> (k)) & 1) + 1)
#define RUN(k, ...) do { if (IN(k)) { _Pragma("unroll") for (int rep = 0; rep < NREP(k); ++rep) { F.dry = rep; { int t_ = F.wave * 64 + lane_id(); asm volatile("" : "+v"(t_)); F.tid = t_; F.lane = t_ & 63; } __VA_ARGS__; if (rep + 1 < NREP(k)) GRID_BAR(); } } SEAM(k); } while (0)
    F.dry = 0;
    RUN(0, phase_prologue(F, p));
    RUN(1, {
        const bool side_first = ((F.bx & 7) & 1) != 0;
        if (side_first) { transpose_weight_fp8(F, p.w_down, INNER, DM, ws + WS_WDOWN, FP8_SB_W); __syncthreads(); }
        { g8::DenseSched S; S.init(ws + WS_XQ, ws + WS_WZQ, TT, INNER, DM, F.G, (F.G == 256) ? ((F.bx + 192) & 255) : F.bx); S.wave = F.wave;
          if (F.G == 256) { S.rag_r0 = 7; S.rag_w1 = 192; S.rag_w2 = 128; }
          EpiUp E{(bf16_t*)(ws + WS_SZ), 1, 1.0f / (FP8_SA_X * FP8_SB_WZ)};
          g8::gemm_phase<EpiUp, g8::DenseSched, false, true>(ring, DM, DM, S, E); }
        { g8::DenseSched S; S.init(ws + WS_XB, ws + WS_WUP, TT, INNER, DM * 2, F.G, F.bx); S.wave = F.wave;
          EpiUp E{(bf16_t*)(ws + WS_XM), 0, 1.0f};
          g8::gemm_phase<EpiUp, g8::DenseSched, false, false>(ring, DM * 2, DM * 2, S, E); }
        if (!side_first) transpose_weight_fp8(F, p.w_down, INNER, DM, ws + WS_WDOWN, FP8_SB_W); });
    RUN(2, phase_passA(F, p));
    RUN(3, { for (int it = F.vcu; it < 32; it += F.G) scan_prompt(F, p, it); });
    RUN(4, { for (int it = F.G - 1 - F.vcu; it < 128; it += F.G) sample_prep(F, p, it);
             phase_passB(F, p); });
    RUN(5, {
        const bool cell_first = ((F.bx & 7) & 1) != 0;
        if ((P5PARTS & 4) && cell_first) _Pragma("unroll") for (int r2 = 0; r2 < NREP(18); ++r2) phase_sample_cell(F, p);
        if (P5PARTS & 1) _Pragma("unroll") for (int r2 = 0; r2 < NREP(16); ++r2) {
          { SchedS S{(const char*)(ws + WS_QP), (const char*)(ws + WS_XA), F.G, F.vcu, 0, F.wave};
            EpiS E{(bf16_t*)(ws + WS_S), (const float*)(ws + WS_CS), (const float*)(ws + WS_MX), (float*)(ws + WS_DEN), F.dry | r2, 1.0f, 0};
            g8::gemm_phase<EpiS, SchedS, false, false>(ring, INNER * 2, INNER * 2, S, E); }
          { SchedS S{(const char*)p.out + O8_Q8, (const char*)p.out + O8_XA8, F.G, (F.G == 256) ? ((F.vcu + 32) & 255) : F.vcu, 1, F.wave};
            EpiS E{(bf16_t*)(ws + WS_S), (const float*)(ws + WS_CS), (const float*)(ws + WS_MX), (float*)(ws + WS_DEN), F.dry | r2, 1.0f, 1};
            g8::gemm_phase<EpiS, SchedS, false, true>(ring, INNER, INNER, S, E, 0x75757575  , 0x7b7b7b7b  ); } }
        if (P5PARTS & 2) _Pragma("unroll") for (int r2 = 0; r2 < NREP(17); ++r2) { SchedState S{(const char*)(ws + WS_KWT), (const char*)(ws + WS_VT), F.G, F.vcu, F.wave};
          EpiState E{p.out + O_PC};
          g8::gemm_phase<EpiState, SchedState, false>(ring, TPP * 2, TPP * 2, S, E); }
        if ((P5PARTS & 4) && !cell_first) _Pragma("unroll") for (int r2 = 0; r2 < NREP(18); ++r2) phase_sample_cell(F, p); });
    RUN(6, {
        SchedSV S{(const char*)(ws + WS_S8), (const char*)(ws + WS_S16), (const char*)(ws + WS_VT8), (const char*)(ws + WS_VT), F.G, F.vcu, F.wave};
        EpiSV E{(bf16_t*)(ws + WS_H), (const float*)(ws + WS_DEN), (const float*)(ws + WS_EM)};
        g8::gemm_phase_mixed<EpiSV, SchedSV>(ring, P8, TPP * 2, S, E, 0x7b7b7b7b  , 0x79797979  ); });
    RUN(7, phase_predown(F, p));
    RUN(8, {
        const bool side_first = ((F.bx & 7) & 1) != 0;
        if (side_first) { transpose_weight(F, p.w_cin, DM, 3 * DM, (bf16_t*)(ws + WS_WCIN), true, ws + WS_WCINQ, FP8_SB_WCIN); transpose_weight_fp8(F, p.w_cout, DM, DM, ws + WS_WCOUT, FP8_SB_W); __syncthreads(); }
        g8::DenseSched S; S.init(ws + WS_PRE, ws + WS_WDOWN, TT, DM, INNER, F.G, F.bx, TP / 256, 8); S.wave = F.wave;
        EpiRes E{p.x_prompt, p.x_sample, nullptr, (bf16_t*)(ws + WS_R), (float*)(ws + WS_PART), 1.0f / (FP8_SA_PRE * FP8_SB_W), (float*)(ws + WS_RST0), nullptr, nullptr, nullptr, nullptr};
        g8::gemm_phase<EpiRes, g8::DenseSched, false, true>(ring, INNER, INNER, S, E);
        if (!side_first) { transpose_weight(F, p.w_cin, DM, 3 * DM, (bf16_t*)(ws + WS_WCIN), true, ws + WS_WCINQ, FP8_SB_WCIN); transpose_weight_fp8(F, p.w_cout, DM, DM, ws + WS_WCOUT, FP8_SB_W); } });
    RUN(9, {
        ln_rows(F, (const bf16_t*)(ws + WS_R), (const float*)(ws + WS_RST0), (const float*)(ws + WS_PART), p.pln_g, p.pln_b, nullptr, (float*)(ws + WS_X1F), (bf16_t*)(ws + WS_X1B), ws + WS_X1Q, (float*)(ws + WS_LNST));
        });
    RUN(10, {
        { g8::DenseSched S; if (F.G == 256) S.init(ws + WS_X1B, ws + WS_WCIN, 6 * 256, 3 * DM, DM * 2, 144, F.bx < 144 ? F.bx : 100000); else S.init(ws + WS_X1B, ws + WS_WCIN, 6 * 256, 3 * DM, DM * 2, F.G, F.bx);
          S.wave = F.wave; S.pmode = 2;
          EpiCin E{(bf16_t*)(ws + WS_U), (bf16_t*)(ws + WS_SZG), p.b_cin, 1.0f};
          g8::gemm_phase<EpiCin, g8::DenseSched, false, false>(ring, DM * 2, DM * 2, S, E); }
        { g8::DenseSched S; S.init(ws + WS_X1Q, ws + WS_WCINQ, 60 * 256, 3 * DM, DM, F.G, (F.G == 256) ? ((F.bx + 112) & 255) : F.bx); S.wave = F.wave; S.pmode = 1;
          if (F.G == 256) { S.rag_r0 = 10; S.rag_w1 = 112; S.rag_w2 = 112; S.rag_w3 = 96; }
          EpiCin E{(bf16_t*)(ws + WS_U), (bf16_t*)(ws + WS_SZG), p.b_cin, 1.0f / (FP8_SA_X1 * FP8_SB_WCIN)};
          g8::gemm_phase<EpiCin, g8::DenseSched, false, true>(ring, DM, DM, S, E); } });
    RUN(11, phase_conv31(F, p));
    RUN(12, phase_norm2(F, p));
    RUN(13, {
        g8::DenseSched S; S.init(ws + WS_PRE2, ws + WS_WCOUT, TT, DM, DM, F.G, F.bx, TP / 256, 8); S.wave = F.wave;
        EpiRes E{nullptr, (const float*)(ws + WS_X1F), p.b_cout, (bf16_t*)(ws + WS_R2), (float*)(ws + WS_PART), 1.0f / (FP8_SA_PRE2 * FP8_SB_W), (float*)(ws + WS_RST1), (const bf16_t*)(ws + WS_R), (const float*)(ws + WS_LNST), p.pln_g, p.pln_b};
        g8::gemm_phase<EpiRes, g8::DenseSched, false, true>(ring, DM, DM, S, E); });
    RUN(14, ln_rows(F, (const bf16_t*)(ws + WS_R2), (const float*)(ws + WS_RST1), (const float*)(ws + WS_PART), p.pln_g + DM, p.pln_b + DM, p.out + O_YP, p.out + O_YS, nullptr, nullptr, nullptr));
#undef RUN
#undef NREP
#undef IN
#undef SEAM
}

extern "C" void kernel_launch(void* const* d_in, const int* in_sizes, int n_in, void* d_out, int out_size, void* d_ws, size_t ws_size, hipStream_t stream) {
    static int grid = 0;
    if (grid == 0) {
        if (n_in != 28 || (size_t)out_size != O_END || ws_size < WS_END) { fprintf(stderr, "kernel_launch: unexpected shapes (n_in %d, out %d, ws %zu); nothing launched\n", n_in, out_size, ws_size); grid = -1; return; }
        int dev = 0, cus = 0;
        if (hipGetDevice(&dev) != hipSuccess || hipDeviceGetAttribute(&cus, hipDeviceAttributeMultiprocessorCount, dev) != hipSuccess) { grid = -1; return; }
        if (hipFuncSetAttribute((const void*)mlstm_conformer_fwd, hipFuncAttributeMaxDynamicSharedMemorySize, LDS_BYTES) != hipSuccess) { fprintf(stderr, "kernel_launch: hipFuncSetAttribute failed\n"); grid = -1; return; }
        int per_cu = 0;
        if (hipOccupancyMaxActiveBlocksPerMultiprocessor(&per_cu, (const void*)mlstm_conformer_fwd, NTHR, LDS_BYTES) != hipSuccess || per_cu < 1) { fprintf(stderr, "kernel_launch: occupancy query says %d\n", per_cu); }
        (void)hipGetLastError();
        grid = cus;
    }
    if (grid < 0) return;
    (void)hipMemsetAsync((char*)d_ws, 0, WS_GATES, stream);
    Params p{};
    const float** pf = (const float**)&p;
    for (int i = 0; i < 28; ++i) pf[i] = (const float*)d_in[i];
    p.out = (float*)d_out; p.ws = (unsigned char*)d_ws;
#if MK_LAUNCHES == 1
    p.ph_lo = 0; p.ph_hi = N_PHASES;
    hipLaunchKernelGGL(mlstm_conformer_fwd, dim3(grid), dim3(NTHR), LDS_BYTES, stream, p);
#else
    for (int k = 0; k < 15; ++k) { p.ph_lo = k; p.ph_hi = k + 1; hipLaunchKernelGGL(mlstm_conformer_fwd, dim3(grid), dim3(NTHR), LDS_BYTES, stream, p); }
#endif
}
```

```cpp
#include <hip/hip_runtime.h>
#include <cstdio>
#include <cstdint>

#ifndef MK_LAUNCHES
#define MK_LAUNCHES 1
#endif

#define LAS __attribute__((address_space(3)))
typedef unsigned short bf16_t;
typedef short bf16x8 __attribute__((ext_vector_type(8)));
typedef float f32x4 __attribute__((ext_vector_type(4)));
typedef float f32x16 __attribute__((ext_vector_type(16)));
typedef unsigned u32x4 __attribute__((ext_vector_type(4)));
typedef unsigned u32x2 __attribute__((ext_vector_type(2)));
#define DI __device__ __forceinline__

constexpr int DM = 4096, INNER = 8192, NH = 8, DKV = 1024;
constexpr int TPP = 16384 + 64;
constexpr int TP = 16384, TS = 512, TT = TP + TS;
constexpr float ALPHA = 1.41421356237309515f, LN_EPS = 1e-5f;
constexpr int NWAVES = 8, NTHR = 512;

constexpr size_t O_YP = 0, O_YS = 67108864, O_PC = 69206016, O_PN = 102760448, O_PM = 102793216, O_PMC = 102793248, O_PCC = 102891552,
                 O_SC = 103383072, O_SN = 237600800, O_SM = 237731872, O_SMC = 237732000, O_SCC = 238125216, O_END = 240091296;

constexpr size_t MiB = 1u << 20;
constexpr size_t O8_Q8 = 0, O8_XA8 = (size_t)TP * INNER;
constexpr size_t WS_BAR = 0;
constexpr size_t WS_GATES = 64 * 1024;
constexpr size_t WS_DEN = WS_GATES + (size_t)TT * 16 * 4;
constexpr size_t WS_STATS = WS_DEN + (size_t)TP * 8 * 4;
constexpr size_t WS_RST0 = WS_STATS + (size_t)TT * 2 * 4, WS_RST1 = WS_RST0 + (size_t)TP * 2 * 4;
constexpr size_t WS_ZERO_BYTES = 3 * MiB;
static_assert(WS_RST1 + (size_t)TP * 2 * 4 <= WS_ZERO_BYTES, "zero region");
constexpr size_t WS_CS = 3 * MiB, WS_MX = WS_CS + 512 * 1024, WS_EM = WS_MX + 512 * 1024;
constexpr size_t WS_MXL = WS_EM + 512 * 1024;
constexpr size_t WS_GT = 5 * MiB;
constexpr size_t WS_WDOWN = 8 * MiB;
constexpr size_t WS_SZ = 72 * MiB;
constexpr size_t WS_XA = 336 * MiB;
constexpr size_t WS_QP = 600 * MiB;
constexpr size_t WS_KWT = 856 * MiB;
constexpr size_t WS_VT = 1113 * MiB;
constexpr size_t WS_XM = 1370 * MiB;
constexpr size_t WS_XB = 600 * MiB, WS_WUP = 732 * MiB, WS_H = 600 * MiB, WS_PRE = 864 * MiB, WS_S = 1370 * MiB, WS_R = 1392 * MiB;
constexpr size_t WS_WCIN = 1656 * MiB, WS_WCOUT = 1752 * MiB, WS_X1F = 72 * MiB, WS_X1B = 336 * MiB, WS_U = 468 * MiB, WS_SZG = 600 * MiB, WS_C = 732 * MiB,
                 WS_PRE2 = 864 * MiB, WS_R2 = 1128 * MiB;
constexpr size_t WS_XQ = 864 * MiB, WS_WZQ = 930 * MiB;
constexpr size_t WS_X1Q = 996 * MiB, WS_WCINQ = 1062 * MiB;
constexpr size_t WS_LNST = 88 * MiB;
constexpr size_t WS_PART = 1784 * MiB;
constexpr size_t WS_S8 = 1370 * MiB, WS_S16 = 1580 * MiB, WS_VT8 = 1704 * MiB;
constexpr size_t S8_BH = (size_t)105 * 65536, S16_BH = (size_t)31 * 131072;
constexpr int P8 = 16384 + 128;
constexpr size_t WS_SMALL = 1914 * MiB;
constexpr size_t WS_SSP = WS_SMALL;
constexpr size_t WS_SQT = WS_SMALL + 1 * MiB;
constexpr size_t WS_SWK = WS_SMALL + 9 * MiB;
constexpr size_t WS_SVT = WS_SMALL + 17 * MiB;
constexpr size_t WS_HS = WS_SMALL + 25 * MiB;
constexpr size_t WS_END = WS_SMALL + 33 * MiB;
static_assert(WS_S + 544 * MiB <= WS_SMALL && WS_END <= 2048 * MiB, "ws map");

typedef __bf16 bf16v2_t __attribute__((ext_vector_type(2)));
typedef float f32v2_t __attribute__((ext_vector_type(2)));
DI unsigned pk_bf16(float lo, float hi) { const f32v2_t f = {lo, hi}; const bf16v2_t t = __builtin_convertvector(f, bf16v2_t); return __builtin_bit_cast(unsigned, t); }
DI float bf_lo(unsigned u) { return __uint_as_float(u << 16); }
DI float bf_hi(unsigned u) { return __uint_as_float(u & 0xffff0000u); }
DI float bf1(bf16_t b) { return __uint_as_float((unsigned)b << 16); }
DI bf16_t f2bf(float f) { return (bf16_t)(pk_bf16(f, 0.f) & 0xffffu); }
DI void unpack8(const u32x4 v, float (&f)[8]) { f[0] = bf_lo(v.x); f[1] = bf_hi(v.x); f[2] = bf_lo(v.y); f[3] = bf_hi(v.y); f[4] = bf_lo(v.z); f[5] = bf_hi(v.z); f[6] = bf_lo(v.w); f[7] = bf_hi(v.w); }
DI u32x4 pack8(const float (&f)[8]) { u32x4 v; v.x = pk_bf16(f[0], f[1]); v.y = pk_bf16(f[2], f[3]); v.z = pk_bf16(f[4], f[5]); v.w = pk_bf16(f[6], f[7]); return v; }
constexpr float FP8_SA_PRE = 8.0f, FP8_SA_PRE2 = 16.0f, FP8_SB_W = 4096.0f, FP8_SA_X1 = 16.0f, FP8_SB_WCIN = 1024.0f, FP8_SA_X = 16.0f, FP8_SB_WZ = 1024.0f, FP8_SA_Q = 1024.0f, FP8_SA_XA = 16.0f, FP8_SA_S = 64.0f, FP8_SA_V = 16.0f;
DI unsigned pk_fp8x4(float a, float b, float c, float d) {
    a = fminf(fmaxf(a, -448.f), 448.f); b = fminf(fmaxf(b, -448.f), 448.f); c = fminf(fmaxf(c, -448.f), 448.f); d = fminf(fmaxf(d, -448.f), 448.f);
    int r = 0; r = __builtin_amdgcn_cvt_pk_fp8_f32(a, b, r, false); r = __builtin_amdgcn_cvt_pk_fp8_f32(c, d, r, true); return (unsigned)r; }
DI float fexp(float x) { return __builtin_amdgcn_exp2f(x * 1.44269504088896341f); }
DI float frcp(float x) { return __builtin_amdgcn_rcpf(x); }
DI float fsilu(float x) { return x * frcp(1.0f + fexp(-x)); }
DI float fsigm(float x) { return frcp(1.0f + fexp(-x)); }
DI float logsig(float x) { return fminf(x, 0.f) - log1pf(expf(-fabsf(x))); }
#define LDS_BARRIER() do { asm volatile("s_waitcnt lgkmcnt(0)" ::: "memory"); __builtin_amdgcn_s_barrier(); asm volatile("" ::: "memory"); } while (0)
DI int lane_id() { int l; asm volatile("v_mbcnt_lo_u32_b32 %0, -1, 0\n\tv_mbcnt_hi_u32_b32 %0, -1, %0" : "=v"(l)); return l; }
template <class T> DI T ld_nt(const T* p) { return __builtin_nontemporal_load(p); }
template <class T> DI void st_nt(T* p, const T v) { __builtin_nontemporal_store(v, p); }
DI float wave_sum(float v) {
#pragma unroll
    for (int o = 1; o < 64; o <<= 1) v += __shfl_xor(v, o);
    return v;
}

#define XB_TMO      128
#define XB_XCNT(j)  (256  + 64 * (j))
#define XB_XSUB(j)  (1280 + 64 * (j))
#define XB_XGEN(j)  (2304 + 64 * (j))
#define XB_TOP      3328
#define XB_TOPGEN   3392
#define XCD_BAR_WORDS 3456
#define XB_SPIN_CAP (1u << 22)
__device__ __forceinline__ unsigned xb_ld(unsigned* p)              { return __hip_atomic_load(p, __ATOMIC_RELAXED, __HIP_MEMORY_SCOPE_AGENT); }
__device__ __forceinline__ unsigned xb_add(unsigned* p, unsigned v) { return __hip_atomic_fetch_add(p, v, __ATOMIC_RELAXED, __HIP_MEMORY_SCOPE_AGENT); }
__device__ __forceinline__ unsigned xb_xcc_id() { return (unsigned)__builtin_amdgcn_s_getreg((3 << 11) | 20) & 0xFu; }
#define XB_SPIN(cond, bar) do { unsigned _sp = 0; while (cond) { __builtin_amdgcn_s_sleep(1); \
    if ((++_sp & 255u) == 0u) { if (xb_ld(&(bar)[XB_TMO])) break; if (_sp > XB_SPIN_CAP) { atomicAdd(&(bar)[XB_TMO], 1u); break; } } } } while (0)
struct XcdBarrier { unsigned* bar; unsigned x; volatile LAS unsigned* st; int wave; };
__device__ __forceinline__ XcdBarrier xcd_barrier_post(unsigned* bar, volatile LAS unsigned* st, int wave) {
    XcdBarrier b; b.bar = bar; b.x = xb_xcc_id(); b.st = st; b.wave = wave;
    if (wave == 0 && lane_id() == 0) (void)xb_add(&bar[XB_XCNT(b.x)], 1u);
    return b;
}
__device__ __forceinline__ void xcd_barrier_complete(unsigned* bar, unsigned x, unsigned& nloc, unsigned& nx) {
    const unsigned G = gridDim.x * gridDim.y * gridDim.z;
    unsigned sum, cnt, mine, sp = 0u;
    for (;;) {
        sum = 0u; cnt = 0u; mine = 0u;
#pragma unroll
        for (unsigned j = 0; j < 16; ++j) { const unsigned c = xb_ld(&bar[XB_XCNT(j)]); sum += c; cnt += (c > 0u) ? 1u : 0u; mine = (j == x) ? c : mine; }
        if (sum == G) break;
        __builtin_amdgcn_s_sleep(1);
        if ((++sp & 255u) == 0u) { if (xb_ld(&bar[XB_TMO])) break; if (sp > XB_SPIN_CAP) { atomicAdd(&bar[XB_TMO], 1u); break; } }
    }
    nloc = mine > 0u ? mine : 1u; nx = cnt > 0u ? cnt : 1u;
}
__device__ __forceinline__ void xcd_barrier(const XcdBarrier& b) {
    asm volatile("s_waitcnt vmcnt(0)" ::: "memory");
    __syncthreads();
    if (b.wave == 0 && lane_id() == 0) {
        unsigned* bar = b.bar;
        __builtin_amdgcn_s_waitcnt(0);
        unsigned nloc = b.st[0], nx = b.st[1];
        if (nloc == 0u) { xcd_barrier_complete(bar, b.x, nloc, nx); b.st[0] = nloc; b.st[1] = nx; }
        const unsigned old = xb_add(&bar[XB_XSUB(b.x)], 1u);
        const unsigned gen = old / nloc;
        if (old + 1u == (gen + 1u) * nloc) {
            __builtin_amdgcn_fence(__ATOMIC_RELEASE, "agent");
            asm volatile("s_waitcnt vmcnt(0)" ::: "memory");
            const unsigned og = xb_add(&bar[XB_TOP], 1u);
            const unsigned tg = og / nx;
            if (og + 1u == (tg + 1u) * nx) xb_add(&bar[XB_TOPGEN], 1u);
            else XB_SPIN(xb_ld(&bar[XB_TOPGEN]) == tg, bar);
            __builtin_amdgcn_fence(__ATOMIC_ACQUIRE, "agent");
            xb_add(&bar[XB_XGEN(b.x)], 1u);
            asm volatile("s_waitcnt vmcnt(0)" ::: "memory");
        } else {
            XB_SPIN(xb_ld(&bar[XB_XGEN(b.x)]) == gen, bar);
            __builtin_amdgcn_fence(__ATOMIC_ACQUIRE, "agent");
            asm volatile("s_waitcnt vmcnt(0)" ::: "memory");
        }
    }
    __syncthreads();
}

namespace g8 {
constexpr int BM = 256, BK = 64, HALF = 128, HTB = HALF * BK * 2, STAGE_BYTES = 8 * HTB, NXCD = 8, WGM = 8;
__host__ __device__ __forceinline__ int lds_byte(int r, int c) { const int st = (r >> 4) * 2 + (c >> 5), rr = r & 15, cc = c & 31, ob = rr * 64 + cc * 2; return st * 1024 + (ob ^ (((ob >> 9) & 1) << 5)); }
__host__ __device__ __forceinline__ void stage_rc(int b, int& R, int& C) { const int st = b / 1024, sb = b % 1024, swz = sb ^ (((sb >> 9) & 1) << 5); R = (st >> 1) * 16 + swz / 64; C = (st & 1) * 32 + (swz % 64) / 2; }
__host__ __device__ __forceinline__ int perm32(int rho) { const int n = rho >> 4, i = rho & 15; return 8 * (i >> 2) + 4 * n + (i & 3); }

typedef int i32x8 __attribute__((ext_vector_type(8)));
DI i32x8 cat8(const bf16x8 lo, const bf16x8 hi) { const u32x4 a = __builtin_bit_cast(u32x4, lo), b = __builtin_bit_cast(u32x4, hi); i32x8 r; r[0] = (int)a.x; r[1] = (int)a.y; r[2] = (int)a.z; r[3] = (int)a.w; r[4] = (int)b.x; r[5] = (int)b.y; r[6] = (int)b.z; r[7] = (int)b.w; return r; }
struct GUnit { const char* A; const char* B; int nt; int i0, i1, i2; };

struct DenseSched {
    int wave;
    const char* A; const char* B; size_t tstepA, tstepB; int nM, nN, nMf, ksp, G, c, nt, pmode;
    DI void init(const void* A_, const void* B_, int M, int N, int Kbytes, int G_, int c_, int nMfull = -1, int ksp_ = 0) { A = (const char*)A_; B = (const char*)B_; tstepA = (size_t)BM * Kbytes; tstepB = (size_t)BM * Kbytes; nM = M / BM; nN = N / BM;
        nMf = nMfull < 0 ? nM : nMfull; ksp = ksp_; G = G_; c = c_; nt = Kbytes / 128; pmode = 0; }
    int rag_r0 = -1, rag_w1 = 0, rag_w2 = 0, rag_w3 = 0;
    DI bool next(int i, GUnit& u) const {
        long L = (long)i * G + c; const int nwg = nMf * nN;
        if (rag_r0 >= 0 && i >= rag_r0) { if (i == rag_r0) { if (c >= rag_w1) return false; } else if (i == rag_r0 + 1) { if (c >= rag_w2) return false; L = (long)rag_r0 * G + rag_w1 + c; }
            else if (i == rag_r0 + 2) { if (c >= rag_w3) return false; L = (long)rag_r0 * G + rag_w1 + rag_w2 + c; } else return false; }
        if (L >= nwg) {
            if (!ksp) return false;
            const int L2 = (int)(L - nwg); if (L2 >= (nM - nMf) * nN * ksp) return false;
            const int sp = L2 % ksp, uu = L2 / ksp, pm = nMf + uu / nN, pn = uu % nN, ntu = nt / ksp;
            u.A = A + (size_t)pm * tstepA + (size_t)sp * ntu * 128; u.B = B + (size_t)pn * tstepB + (size_t)sp * ntu * 128; u.nt = ntu; u.i0 = 1 + sp; u.i1 = pm; u.i2 = pn; return true; }
        int wgid = (int)L; { const int q = nwg / NXCD, r = nwg % NXCD, xcd = wgid % NXCD, off = wgid / NXCD; wgid = (xcd < r ? xcd * (q + 1) : r * (q + 1) + (xcd - r) * q) + off; }
        const int nig = WGM * nN, gid = wgid / nig, fm = gid * WGM, gsz = (nMf - fm) < WGM ? (nMf - fm) : WGM;
        int pm = fm + ((wgid % nig) % gsz); const int pn = (wgid % nig) / gsz;
        if (pmode == 1) pm += pm / 15; else if (pmode == 2) pm = pm < 4 ? 16 * pm + 15 : 60 + pm;
        u.A = A + (size_t)pm * tstepA; u.B = B + (size_t)pn * tstepB; u.nt = nt; u.i0 = 0; u.i1 = pm; u.i2 = pn; return true;
    }
};

template <class Epi, class Sched, bool ATILED, bool FP8 = false>
__device__ __forceinline__ void gemm_phase(LAS unsigned char* lds, const unsigned ldaB, const unsigned ldbB, const Sched& S, const Epi& E, const int fp8_scale_a = 0x7f7f7f7f, const int fp8_scale_b = 0x7f7f7f7f) {
    const int wid = __builtin_amdgcn_readfirstlane(S.wave);
    int tid = wid * 64 + lane_id(); asm volatile("" : "+v"(tid));
    const int lane = tid & 63, wr = wid >> 2, wc = wid & 3, fr = lane & 15, fq = lane >> 4;
    unsigned voffA[2], voffB[2];
#pragma unroll
    for (int i = 0; i < 2; ++i) { int R, C; stage_rc(tid * 16 + i * 8192, R, C); const int Rb = Epi::PERM ? ((R & ~31) + perm32(R & 31)) : R;
        voffA[i] = (unsigned)R * ldaB + (unsigned)C * 2u; voffB[i] = (unsigned)Rb * ldbB + (unsigned)C * 2u; }
    const size_t kstep = (size_t)(BK * 2);
    const size_t hstepA = (size_t)HALF * ldaB, hstepB = (size_t)HALF * ldbB;
    const unsigned ldsw = (unsigned)wid * 1024u;
    const int aoff = lds_byte(wr * 64 + fr, fq * 8), boff = lds_byte(wc * 32 + fr, fq * 8);
#define G8_KA(p, kt) (ATILED ? ((p) + (size_t)((kt) >> 2) * 131072u + (size_t)((kt) & 3) * 128u) : ((p) + (size_t)(kt) * 128u))
#define G8_SA(b, h) (((b) * 2 + (h)) * HTB)
#define G8_SB(b, h) ((4 + (b) * 2 + (h)) * HTB)
#define G8_STAGE(bufoff, gbase, voff) do { _Pragma("unroll") for (int _i = 0; _i < 2; ++_i) \
        __builtin_amdgcn_global_load_lds((const unsigned*)((const char*)(gbase) + (voff)[_i]), (LAS unsigned*)(lds + (bufoff) + ldsw + _i * 8192), 16, 0, 0); } while (0)
#define G8_RDA(b, h, m, k) (*(const LAS bf16x8*)(lds + G8_SA(b, h) + aoff + (m) * 2048 + (k) * 1024))
#define G8_RDB(b, h, n, k) (*(const LAS bf16x8*)(lds + G8_SB(b, h) + boff + (n) * 2048 + (k) * 1024))
#define G8_LDA(dst, b, h) do { _Pragma("unroll") for (int m = 0; m < 4; ++m) { if constexpr (FP8) dst##8[m] = cat8(G8_RDA(b, h, m, 0), G8_RDA(b, h, m, 1)); else { dst[m][0] = G8_RDA(b, h, m, 0); dst[m][1] = G8_RDA(b, h, m, 1); } } } while (0)
#define G8_LDB(dst, b, h) do { _Pragma("unroll") for (int n = 0; n < 2; ++n) { if constexpr (FP8) dst##8[n] = cat8(G8_RDB(b, h, n, 0), G8_RDB(b, h, n, 1)); else { dst[n][0] = G8_RDB(b, h, n, 0); dst[n][1] = G8_RDB(b, h, n, 1); } } } while (0)
#define G8_MMA(ai, bj, At, Bt) do { __builtin_amdgcn_s_setprio(1); _Pragma("unroll") for (int m = 0; m < 4; ++m) _Pragma("unroll") for (int n = 0; n < 2; ++n) { \
        if constexpr (FP8) { asm volatile("v_mfma_scale_f32_16x16x128_f8f6f4 %0, %1, %2, %0, %3, %4 op_sel_hi:[0,0,0]" : "+v"(acc[ai][bj][m][n]) : "v"(Bt##8[n]), "v"(At##8[m]), "v"(fp8_sb_v), "v"(fp8_sa_v)); } \
        else { _Pragma("unroll") for (int k = 0; k < 2; ++k) acc[ai][bj][m][n] = __builtin_amdgcn_mfma_f32_16x16x32_bf16(Bt[n][k], At[m][k], acc[ai][bj][m][n], 0, 0, 0); } } \
        __builtin_amdgcn_s_setprio(0); } while (0)
#define G8_WAIT_V(n) asm volatile("s_waitcnt vmcnt(" #n ")" ::: "memory")
#define G8_WAIT_L(n) asm volatile("s_waitcnt lgkmcnt(" #n ")" ::: "memory")
#define G8_BAR __builtin_amdgcn_s_barrier()
#define G8_SCHED __builtin_amdgcn_sched_barrier(0)
    GUnit cur, nxt; int ui = 0;
    if (!S.next(0, cur)) return;
    f32x4 acc[2][2][4][2];
#pragma unroll
    for (int a = 0; a < 2; ++a)
#pragma unroll
        for (int b = 0; b < 2; ++b)
#pragma unroll
            for (int m = 0; m < 4; ++m)
#pragma unroll
                for (int n = 0; n < 2; ++n) acc[a][b][m][n] = (f32x4){0.f, 0.f, 0.f, 0.f};
    const int fp8_sb_v = fp8_scale_b, fp8_sa_v = fp8_scale_a;
    bf16x8 At[4][2], B0[2][2], B1[2][2]; i32x8 At8[4], B08[2], B18[2];
    const char* cA = cur.A; const char* cB = cur.B;
    G8_STAGE(G8_SB(0, 0), cB, voffB); G8_STAGE(G8_SB(0, 1), cB + hstepB, voffB); G8_STAGE(G8_SA(0, 0), cA, voffA); G8_STAGE(G8_SA(0, 1), cA + hstepA, voffA);
    if (wr == 1) G8_BAR;
    G8_WAIT_V(2); G8_BAR;
    G8_STAGE(G8_SB(1, 0), cB + kstep, voffB); G8_STAGE(G8_SA(1, 0), G8_KA(cA, 1), voffA); G8_STAGE(G8_SB(1, 1), cB + hstepB + kstep, voffB);
    G8_WAIT_V(6); G8_BAR;
    for (;;) {
        const bool has_next = S.next(ui + 1, nxt);
        const char* nA = has_next ? nxt.A : cA; const char* nB = has_next ? nxt.B : cB;
        const int nt = cur.nt;
        for (int t = 0; t < nt; t += 2) {
            const bool last = (t == nt - 2);
            const char* a1 = G8_KA(cA, t + 1);
            const char* a2 = last ? nA : G8_KA(cA, t + 2); const char* b2 = last ? nB : cB + (size_t)(t + 2) * kstep;
            const char* a3 = a2 + kstep; const char* b3 = b2 + kstep;
            G8_LDB(B0, 0, 0); G8_LDB(B1, 0, 1); G8_SCHED; G8_LDA(At, 0, 0); G8_STAGE(G8_SA(1, 1), a1 + hstepA, voffA);
            G8_WAIT_V(8); G8_WAIT_L(0); G8_BAR; G8_MMA(0, 0, At, B0); G8_MMA(0, 1, At, B1); G8_BAR; G8_SCHED;
            G8_LDA(At, 0, 1); G8_STAGE(G8_SB(0, 0), b2, voffB); G8_STAGE(G8_SB(0, 1), b2 + hstepB, voffB); G8_STAGE(G8_SA(0, 0), a2, voffA);
            G8_WAIT_V(8); G8_WAIT_L(0); G8_BAR; G8_MMA(1, 0, At, B0); G8_MMA(1, 1, At, B1); G8_BAR; G8_SCHED;
            G8_LDB(B0, 1, 0); G8_LDB(B1, 1, 1); G8_SCHED; G8_LDA(At, 1, 0); G8_STAGE(G8_SA(0, 1), a2 + hstepA, voffA);
            G8_WAIT_V(8); G8_WAIT_L(0); G8_BAR; G8_MMA(0, 0, At, B0); G8_MMA(0, 1, At, B1); G8_BAR; G8_SCHED;
            G8_LDA(At, 1, 1); G8_STAGE(G8_SB(1, 0), b3, voffB); G8_STAGE(G8_SB(1, 1), b3 + hstepB, voffB); G8_STAGE(G8_SA(1, 0), a3, voffA);
            G8_WAIT_V(8); G8_WAIT_L(0); G8_BAR; G8_MMA(1, 0, At, B0); G8_MMA(1, 1, At, B1); G8_BAR; G8_SCHED;
        }
        if constexpr (FP8) asm volatile("s_nop 15\n\ts_nop 15\n\ts_nop 15" ::: "memory");
        if (wr == 0) G8_BAR;
        E(acc, cur, wr, wc, fr, fq);
        if (!has_next) break;
#pragma unroll
        for (int a = 0; a < 2; ++a)
#pragma unroll
            for (int b = 0; b < 2; ++b)
#pragma unroll
                for (int m = 0; m < 4; ++m)
#pragma unroll
                    for (int n = 0; n < 2; ++n) acc[a][b][m][n] = (f32x4){0.f, 0.f, 0.f, 0.f};
        cur = nxt; cA = nA; cB = nB; ++ui;
        if (wr == 1) G8_BAR;
    }
    G8_WAIT_V(0);
    G8_BAR;
#undef G8_KA
#undef G8_SA
#undef G8_SB
#undef G8_STAGE
#undef G8_LDA
#undef G8_RDA
#undef G8_RDB
#undef G8_LDB
#undef G8_MMA
#undef G8_WAIT_V
#undef G8_WAIT_L
#undef G8_BAR
#undef G8_SCHED
}

struct GUnitM { const char* A8; const char* B8; const char* A16; const char* B16; int nt8, nt; int i0, i1, i2; };
typedef int i32x4 __attribute__((ext_vector_type(4)));
template <class Epi, class Sched>
__device__ __forceinline__ void gemm_phase_mixed(LAS unsigned char* lds, const unsigned ldb8, const unsigned ldb16, const Sched& S, const Epi& E, const int scale_b8, const int scale_a8) {
    const int wid = __builtin_amdgcn_readfirstlane(S.wave);
    int tid = wid * 64 + lane_id(); asm volatile("" : "+v"(tid));
    const int lane = tid & 63, wr = wid >> 2, wc = wid & 3, fr = lane & 15, fq = lane >> 4;
    unsigned voffA8[2], rowB[2];
#pragma unroll
    for (int i = 0; i < 2; ++i) { int R, C; stage_rc(tid * 16 + i * 8192, R, C); const int Rb = Epi::PERM ? ((R & ~31) + perm32(R & 31)) : R;
        voffA8[i] = (unsigned)R * 256u + (unsigned)C * 2u; rowB[i] = (unsigned)Rb; }
#define GM_VA(is8, i) ((is8) ? voffA8[i] : voffA8[i] + (voffA8[i] & ~255u))
#define GM_VB(is8, i) (rowB[i] * ((is8) ? ldb8 : ldb16) + (voffA8[i] & 255u))
    const unsigned ldsw = (unsigned)wid * 1024u;
    const int aoff = lds_byte(wr * 64 + fr, fq * 8), boff = lds_byte(wc * 32 + fr, fq * 8);
#define GM_SA(b, h) (((b) * 2 + (h)) * HTB)
#define GM_SB(b, h) ((4 + (b) * 2 + (h)) * HTB)
#define GM_PA(u, kt) ((kt) < (u).nt8 ? (u).A8 + (size_t)((kt) >> 1) * 65536u + (size_t)((kt) & 1) * 128u : (u).A16 + (size_t)(((kt) - (u).nt8) >> 2) * 131072u + (size_t)(((kt) - (u).nt8) & 3) * 128u)
#define GM_PB(u, kt) ((kt) < (u).nt8 ? (u).B8 + (size_t)(kt) * 128u : (u).B16 + (size_t)((kt) - (u).nt8) * 128u)
#define GM_STAGE_A(bufoff, gbase, is8, half) do { const char* _g = (gbase) + ((half) ? ((is8) ? 32768u : 65536u) : 0u); _Pragma("unroll") for (int _i = 0; _i < 2; ++_i) \
        __builtin_amdgcn_global_load_lds((const unsigned*)(_g + GM_VA(is8, _i)), (LAS unsigned*)(lds + (bufoff) + ldsw + _i * 8192), 16, 0, 0); } while (0)
#define GM_STAGE_B(bufoff, gbase, is8, half) do { const char* _g = (gbase) + ((half) ? (size_t)HALF * ((is8) ? ldb8 : ldb16) : (size_t)0); _Pragma("unroll") for (int _i = 0; _i < 2; ++_i) \
        __builtin_amdgcn_global_load_lds((const unsigned*)(_g + GM_VB(is8, _i)), (LAS unsigned*)(lds + (bufoff) + ldsw + _i * 8192), 16, 0, 0); } while (0)
#define GM_RDA(b, h, m, k) (*(const LAS bf16x8*)(lds + GM_SA(b, h) + aoff + (m) * 2048 + (k) * 1024))
#define GM_RDB(b, h, n, k) (*(const LAS bf16x8*)(lds + GM_SB(b, h) + boff + (n) * 2048 + (k) * 1024))
#define GM_LDA8(b, h) do { _Pragma("unroll") for (int m = 0; m < 4; ++m) At8[m] = cat8(GM_RDA(b, h, m, 0), GM_RDA(b, h, m, 1)); } while (0)
#define GM_LDB8(dst, b, h) do { _Pragma("unroll") for (int n = 0; n < 2; ++n) dst##8[n] = cat8(GM_RDB(b, h, n, 0), GM_RDB(b, h, n, 1)); } while (0)
#define GM_LDA16(b, h) do { _Pragma("unroll") for (int m = 0; m < 4; ++m) { At[m][0] = GM_RDA(b, h, m, 0); At[m][1] = GM_RDA(b, h, m, 1); } } while (0)
#define GM_LDB16(dst, b, h) do { _Pragma("unroll") for (int n = 0; n < 2; ++n) { dst[n][0] = GM_RDB(b, h, n, 0); dst[n][1] = GM_RDB(b, h, n, 1); } } while (0)
#define GM_MMA8(ai, bj, Bt) do { __builtin_amdgcn_s_setprio(1); _Pragma("unroll") for (int m = 0; m < 4; ++m) _Pragma("unroll") for (int n = 0; n < 2; ++n) \
        asm volatile("v_mfma_scale_f32_16x16x128_f8f6f4 %0, %1, %2, %0, %3, %4 op_sel_hi:[0,0,0]" : "+v"(acc[ai][bj][m][n]) : "v"(Bt##8[n]), "v"(At8[m]), "v"(sb8_v), "v"(sa8_v)); \
        __builtin_amdgcn_s_setprio(0); } while (0)
#define GM_MMA16(ai, bj, Bt) do { __builtin_amdgcn_s_setprio(1); _Pragma("unroll") for (int m = 0; m < 4; ++m) _Pragma("unroll") for (int n = 0; n < 2; ++n) _Pragma("unroll") for (int k = 0; k < 2; ++k) \
        acc[ai][bj][m][n] = __builtin_amdgcn_mfma_f32_16x16x32_bf16(Bt[n][k], At[m][k], acc[ai][bj][m][n], 0, 0, 0); __builtin_amdgcn_s_setprio(0); } while (0)
#define GM_TRIP(LDA_, LDB_, MMA_, c8_) do { \
            const bool last = (t == nt - 2); \
            const char* a1 = GM_PA(cur, t) + 128; \
            bool n8; const char* a2; const char* b2; \
            if (!last) { n8 = (t + 2) < cur.nt8; a2 = GM_PA(cur, t + 2); b2 = GM_PB(cur, t + 2); } \
            else if (has_next) { n8 = 0 < nxt.nt8; a2 = GM_PA(nxt, 0); b2 = GM_PB(nxt, 0); } \
            else { n8 = 0 < cur.nt8; a2 = GM_PA(cur, 0); b2 = GM_PB(cur, 0); } \
            const char* a3 = a2 + 128; const char* b3 = b2 + 128; \
            LDB_(B0, 0, 0); LDB_(B1, 0, 1); GM_SCHED; LDA_(0, 0); GM_STAGE_A(GM_SA(1, 1), a1, c8_, 1); \
            GM_WAIT_V(8); GM_WAIT_L(0); GM_BAR; MMA_(0, 0, B0); MMA_(0, 1, B1); GM_BAR; GM_SCHED; \
            LDA_(0, 1); GM_STAGE_B(GM_SB(0, 0), b2, n8, 0); GM_STAGE_B(GM_SB(0, 1), b2, n8, 1); GM_STAGE_A(GM_SA(0, 0), a2, n8, 0); \
            GM_WAIT_V(8); GM_WAIT_L(0); GM_BAR; MMA_(1, 0, B0); MMA_(1, 1, B1); GM_BAR; GM_SCHED; \
            LDB_(B0, 1, 0); LDB_(B1, 1, 1); GM_SCHED; LDA_(1, 0); GM_STAGE_A(GM_SA(0, 1), a2, n8, 1); \
            GM_WAIT_V(8); GM_WAIT_L(0); GM_BAR; MMA_(0, 0, B0); MMA_(0, 1, B1); GM_BAR; GM_SCHED; \
            LDA_(1, 1); GM_STAGE_B(GM_SB(1, 0), b3, n8, 0); GM_STAGE_B(GM_SB(1, 1), b3, n8, 1); GM_STAGE_A(GM_SA(1, 0), a3, n8, 0); \
            GM_WAIT_V(8); GM_WAIT_L(0); GM_BAR; MMA_(1, 0, B0); MMA_(1, 1, B1); GM_BAR; GM_SCHED; } while (0)
#define GM_WAIT_V(n) asm volatile("s_waitcnt vmcnt(" #n ")" ::: "memory")
#define GM_WAIT_L(n) asm volatile("s_waitcnt lgkmcnt(" #n ")" ::: "memory")
#define GM_BAR __builtin_amdgcn_s_barrier()
#define GM_SCHED __builtin_amdgcn_sched_barrier(0)
    GUnitM cur, nxt; int ui = 0;
    if (!S.next(0, cur)) return;
    f32x4 acc[2][2][4][2];
#pragma unroll
    for (int a = 0; a < 2; ++a)
#pragma unroll
        for (int b = 0; b < 2; ++b)
#pragma unroll
            for (int m = 0; m < 4; ++m)
#pragma unroll
                for (int n = 0; n < 2; ++n) acc[a][b][m][n] = (f32x4){0.f, 0.f, 0.f, 0.f};
    const int sb8_v = scale_b8, sa8_v = scale_a8;
    i32x8 At8[4], B08[2], B18[2]; bf16x8 At[4][2], B0[2][2], B1[2][2];
    { const bool p8 = 0 < cur.nt8; const char* a0 = GM_PA(cur, 0); const char* b0 = GM_PB(cur, 0);
      GM_STAGE_B(GM_SB(0, 0), b0, p8, 0); GM_STAGE_B(GM_SB(0, 1), b0, p8, 1); GM_STAGE_A(GM_SA(0, 0), a0, p8, 0); GM_STAGE_A(GM_SA(0, 1), a0, p8, 1);
      if (wr == 1) GM_BAR;
      GM_WAIT_V(2); GM_BAR;
      GM_STAGE_B(GM_SB(1, 0), b0 + 128, p8, 0); GM_STAGE_A(GM_SA(1, 0), a0 + 128, p8, 0); GM_STAGE_B(GM_SB(1, 1), b0 + 128, p8, 1);
      GM_WAIT_V(6); GM_BAR; }
    for (;;) {
        const bool has_next = S.next(ui + 1, nxt);
        const int nt = cur.nt, nt8 = cur.nt8;
        for (int t = 0; t < nt8; t += 2) GM_TRIP(GM_LDA8, GM_LDB8, GM_MMA8, true);
        for (int t = nt8; t < nt; t += 2) GM_TRIP(GM_LDA16, GM_LDB16, GM_MMA16, false);
        asm volatile("s_nop 15\n\ts_nop 15\n\ts_nop 15" ::: "memory");
        if (wr == 0) GM_BAR;
        { int tz = lane_id(); asm volatile("" : "+v"(tz));
          const int ln = tz & 63; E(acc, cur, wr, wc, ln & 15, ln >> 4); }
        if (!has_next) break;
#pragma unroll
        for (int a = 0; a < 2; ++a)
#pragma unroll
            for (int b = 0; b < 2; ++b)
#pragma unroll
                for (int m = 0; m < 4; ++m)
#pragma unroll
                    for (int n = 0; n < 2; ++n) acc[a][b][m][n] = (f32x4){0.f, 0.f, 0.f, 0.f};
        cur = nxt; ++ui;
        if (wr == 1) GM_BAR;
    }
    GM_WAIT_V(0);
    GM_BAR;
#undef GM_VA
#undef GM_VB
#undef GM_SA
#undef GM_SB
#undef GM_PA
#undef GM_PB
#undef GM_STAGE_A
#undef GM_STAGE_B
#undef GM_RDA
#undef GM_RDB
#undef GM_LDA8
#undef GM_LDB8
#undef GM_LDA16
#undef GM_LDB16
#undef GM_MMA8
#undef GM_MMA16
#undef GM_TRIP
#undef GM_WAIT_V
#undef GM_WAIT_L
#undef GM_BAR
#undef GM_SCHED
}
}
using g8::GUnit;
using g8::GUnitM;
using g8::HALF;

struct Params {
    const float *x_prompt, *x_sample, *st_C, *st_n, *st_m, *st_mconv, *st_cconv;
    const float *w_up, *w_mconv, *b_mconv, *w_q, *w_k, *w_v, *w_gate, *b_gate, *mh_gain, *skip, *w_down;
    const float *w_cin, *b_cin, *w_dw, *b_dw, *cln_g, *cln_b, *w_cout, *b_cout, *pln_g, *pln_b;
    float* out; unsigned char* ws; int ph_lo, ph_hi;
};
struct Frame { LAS unsigned char* lds; int tid, lane, wave, G, bx, vcu, dry; };

struct EpiUp {
    static constexpr bool PERM = true;
    bf16_t* base; int act; float sc;
    DI void operator()(const f32x4 (&acc)[2][2][4][2], const GUnit& u, int wr, int wc, int fr, int fq) const {
        const int row0 = u.i1 * 256 + wr * 64 + fr, col0 = u.i2 * 256 + wc * 32 + 8 * fq;
#pragma unroll
        for (int ai = 0; ai < 2; ++ai)
#pragma unroll
            for (int m = 0; m < 4; ++m) { bf16_t* rowp = base + (size_t)(row0 + ai * HALF + m * 16) * INNER + col0;
#pragma unroll
                for (int bj = 0; bj < 2; ++bj) { f32x4 v0 = acc[ai][bj][m][0], v1 = acc[ai][bj][m][1];
                    if (act) {
#pragma unroll
                        for (int j = 0; j < 4; ++j) { v0[j] = fsilu(v0[j] * sc); v1[j] = fsilu(v1[j] * sc); } }
                    u32x4 w; w.x = pk_bf16(v0[0], v0[1]); w.y = pk_bf16(v0[2], v0[3]); w.z = pk_bf16(v1[0], v1[1]); w.w = pk_bf16(v1[2], v1[3]);
                    *(u32x4*)(rowp + bj * HALF) = w; } }
    }
};
struct EpiS {
    static constexpr bool PERM = true;
    bf16_t* Sb; const float* cs; const float* mx; float* den; int dry; float sc; int far;
    DI void operator()(const f32x4 (&acc)[2][2][4][2], const GUnit& u, int wr, int wc, int fr, int fq) const {
        const int bh = u.i0, pm = u.i1, pn = u.i2;
        bf16_t* tile = (bf16_t*)((unsigned char*)Sb + WS_S16 - WS_S + (size_t)bh * S16_BH + (size_t)(pm + pn) * 131072);
        unsigned char* tile8 = (unsigned char*)Sb + (size_t)bh * S8_BH + (size_t)((pm - 2) * (pm - 1) / 2 + pn) * 65536;
        const float* csb = cs + bh * 4096 + pn * 256; const float* mxb = mx + bh * 4096 + pm * 256; float* denb = den + bh * 4096 + pm * 256;
        const bool diag = (pm == pn);
        f32x4 cv[2][2];
#pragma unroll
        for (int bj = 0; bj < 2; ++bj)
#pragma unroll
            for (int n = 0; n < 2; ++n) cv[bj][n] = *(const f32x4*)(csb + bj * HALF + wc * 32 + 8 * fq + 4 * n);
#pragma unroll
        for (int ai = 0; ai < 2; ++ai)
#pragma unroll
            for (int m = 0; m < 4; ++m) { const int rloc = ai * HALF + wr * 64 + m * 16 + fr; const float mxt = mxb[rloc]; float rs = 0.f;
                const int rowlim = diag ? rloc - (wc * 32 + 8 * fq) : 0x10000;
#pragma unroll
                for (int bj = 0; bj < 2; ++bj) { f32x4 v[2];
#pragma unroll
                    for (int n = 0; n < 2; ++n) { v[n] = acc[ai][bj][m][n];
#pragma unroll
                        for (int j = 0; j < 4; ++j) { const bool masked = (bj * HALF + 4 * n + j) > rowlim;
                            const float d = masked ? 0.f : fexp(cv[bj][n][j] - mxt) * sc; v[n][j] *= d; rs += v[n][j]; } }
                    if (far) { u32x2 w8; w8.x = pk_fp8x4(v[0][0] * FP8_SA_S, v[0][1] * FP8_SA_S, v[0][2] * FP8_SA_S, v[0][3] * FP8_SA_S); w8.y = pk_fp8x4(v[1][0] * FP8_SA_S, v[1][1] * FP8_SA_S, v[1][2] * FP8_SA_S, v[1][3] * FP8_SA_S);
                        *(u32x2*)(tile8 + (size_t)rloc * 256 + bj * HALF + wc * 32 + 8 * fq) = w8; }
                    else { u32x4 w; w.x = pk_bf16(v[0][0], v[0][1]); w.y = pk_bf16(v[0][2], v[0][3]); w.z = pk_bf16(v[1][0], v[1][1]); w.w = pk_bf16(v[1][2], v[1][3]);
                        *(u32x4*)(tile + (size_t)rloc * 256 + bj * HALF + wc * 32 + 8 * fq) = w; } }
                rs += __shfl_xor(rs, 16); rs += __shfl_xor(rs, 32);
                if (fq == 0 && !dry) atomicAdd(denb + rloc, rs); }
    }
};
struct EpiState {
    static constexpr bool PERM = false;
    float* C;
    DI void operator()(const f32x4 (&acc)[2][2][4][2], const GUnit& u, int wr, int wc, int fr, int fq) const {
        float* base = C + ((size_t)u.i0 << 20);
        const int row0 = u.i1 * 256 + wr * 64 + fr, col0 = u.i2 * 256 + wc * 32 + 4 * fq;
#pragma unroll
        for (int ai = 0; ai < 2; ++ai)
#pragma unroll
            for (int m = 0; m < 4; ++m) { float* rowp = base + (size_t)(row0 + ai * HALF + m * 16) * 1024 + col0;
#pragma unroll
                for (int bj = 0; bj < 2; ++bj)
#pragma unroll
                    for (int n = 0; n < 2; ++n) st_nt((f32x4*)(rowp + bj * HALF + n * 16), acc[ai][bj][m][n]); }
    }
};
struct EpiSV {
    static constexpr bool PERM = true;
    bf16_t* hb; const float* den; const float* em;
    template <class U> DI void operator()(const f32x4 (&acc)[2][2][4][2], const U& u, int wr, int wc, int fr, int fq) const {
        const int bh = u.i0, pm = u.i1, pn = u.i2, b = bh >> 3, h = bh & 7;
        const float* denb = den + bh * 4096 + pm * 256; const float* emb = em + bh * 4096 + pm * 256;
        bf16_t* base = hb + (size_t)(b * 4096 + pm * 256) * INNER + h * 1024 + pn * 256 + wc * 32 + 8 * fq;
        float dn[2][4], ee[2][4];
#pragma unroll
        for (int ai = 0; ai < 2; ++ai)
#pragma unroll
            for (int m = 0; m < 4; ++m) { const int rloc = ai * HALF + wr * 64 + m * 16 + fr; dn[ai][m] = denb[rloc]; ee[ai][m] = emb[rloc]; }
        __builtin_amdgcn_sched_barrier(0);
#pragma unroll
        for (int ai = 0; ai < 2; ++ai)
#pragma unroll
            for (int m = 0; m < 4; ++m) { const int rloc = ai * HALF + wr * 64 + m * 16 + fr; const float g = 1.0f / fmaxf(fabsf(dn[ai][m]), ee[ai][m]);
#pragma unroll
                for (int bj = 0; bj < 2; ++bj) { const f32x4 v0 = acc[ai][bj][m][0] * g, v1 = acc[ai][bj][m][1] * g;
                    u32x4 w; w.x = pk_bf16(v0[0], v0[1]); w.y = pk_bf16(v0[2], v0[3]); w.z = pk_bf16(v1[0], v1[1]); w.w = pk_bf16(v1[2], v1[3]);
                    *(u32x4*)(base + (size_t)rloc * INNER + bj * HALF) = w; } }
    }
};
struct EpiRes {
    static constexpr bool PERM = true;
    const float* resA; const float* resB; const float* bias; bf16_t* r; float* part; float sc;
    float* rstat;
    const bf16_t* resLn; const float* lnst; const float* lng; const float* lnb;
    DI void operator()(const f32x4 (&acc)[2][2][4][2], const GUnit& u, int wr, int wc, int fr, int fq) const {
        const int pm = u.i1, row0 = pm * 256 + wr * 64 + fr, col0 = u.i2 * 256 + wc * 32 + 8 * fq;
        f32x4 bv[2][2];
#pragma unroll
        for (int bj = 0; bj < 2; ++bj)
#pragma unroll
            for (int n = 0; n < 2; ++n) bv[bj][n] = bias ? *(const f32x4*)(bias + col0 + bj * HALF + n * 4) : (f32x4){0.f, 0.f, 0.f, 0.f};
        if (u.i0 == 0) {
            f32x4 lg[2][2], lb[2][2];
            if (resLn) {
#pragma unroll
                for (int bj = 0; bj < 2; ++bj)
#pragma unroll
                    for (int n = 0; n < 2; ++n) { lg[bj][n] = *(const f32x4*)(lng + col0 + bj * HALF + n * 4); lb[bj][n] = *(const f32x4*)(lnb + col0 + bj * HALF + n * 4); }
                __builtin_amdgcn_sched_barrier(0);
#pragma unroll
                for (int bj = 0; bj < 2; ++bj)
#pragma unroll
                    for (int n = 0; n < 2; ++n) { lg[bj][n] = lg[bj][n] * ALPHA; lb[bj][n] = lb[bj][n] * ALPHA + bv[bj][n]; } }
#define ER_FINISH(xr_) do { f32x4 v[2]; \
                    _Pragma("unroll") for (int n = 0; n < 2; ++n) { v[n] = (xr_)[n] + acc[ai][bj][m][n] * sc; \
                        s1 += (v[n][0] + v[n][1]) + (v[n][2] + v[n][3]); s2 += (v[n][0] * v[n][0] + v[n][1] * v[n][1]) + (v[n][2] * v[n][2] + v[n][3] * v[n][3]); } \
                    u32x4 w; w.x = pk_bf16(v[0][0], v[0][1]); w.y = pk_bf16(v[0][2], v[0][3]); w.z = pk_bf16(v[1][0], v[1][1]); w.w = pk_bf16(v[1][2], v[1][3]); \
                    *(u32x4*)(r + ro + bj * HALF) = w; } while (0)
#define ER_STATS() do { s1 += __shfl_xor(s1, 16); s1 += __shfl_xor(s1, 32); s2 += __shfl_xor(s2, 16); s2 += __shfl_xor(s2, 32); \
                    if (fq == 0) { atomicAdd(rstat + (size_t)row * 2, s1); atomicAdd(rstat + (size_t)row * 2 + 1, s2); } } while (0)
#pragma unroll
        for (int ai = 0; ai < 2; ++ai) {
            if (resLn) {
                u32x4 rw[4][2]; float mn[4], rs[4];
#pragma unroll
                for (int m = 0; m < 4; ++m) { const int row = row0 + ai * HALF + m * 16; const size_t ro = (size_t)row * DM + col0;
                    mn[m] = lnst[(size_t)row * 2]; rs[m] = lnst[(size_t)row * 2 + 1];
#pragma unroll
                    for (int bj = 0; bj < 2; ++bj) rw[m][bj] = ld_nt((const u32x4*)(resLn + ro + bj * HALF)); }
                __builtin_amdgcn_sched_barrier(0);
#pragma unroll
                for (int m = 0; m < 4; ++m) { const int row = row0 + ai * HALF + m * 16; const size_t ro = (size_t)row * DM + col0; const float mean = mn[m], rstd = rs[m];
                    float s1 = 0.f, s2 = 0.f;
#pragma unroll
                    for (int bj = 0; bj < 2; ++bj) { const u32x4 q = rw[m][bj]; f32x4 xr[2];
                        xr[0] = ((f32x4){bf_lo(q.x), bf_hi(q.x), bf_lo(q.y), bf_hi(q.y)} - mean) * rstd * lg[bj][0] + lb[bj][0]; xr[1] = ((f32x4){bf_lo(q.z), bf_hi(q.z), bf_lo(q.w), bf_hi(q.w)} - mean) * rstd * lg[bj][1] + lb[bj][1];
                        ER_FINISH(xr); }
                    ER_STATS(); }
            } else {
#pragma unroll
              for (int mh = 0; mh < 4; mh += 2) {
                f32x4 xq[2][2][2];
#pragma unroll
                for (int m = mh; m < mh + 2; ++m) { const size_t ro = (size_t)(row0 + ai * HALF + m * 16) * DM + col0;
#pragma unroll
                    for (int bj = 0; bj < 2; ++bj) { xq[m - mh][bj][0] = ld_nt((const f32x4*)(resA + ro + bj * HALF)); xq[m - mh][bj][1] = ld_nt((const f32x4*)(resA + ro + bj * HALF + 4)); } }
                __builtin_amdgcn_sched_barrier(0);
#pragma unroll
                for (int m = mh; m < mh + 2; ++m) { const int row = row0 + ai * HALF + m * 16; const size_t ro = (size_t)row * DM + col0;
                    float s1 = 0.f, s2 = 0.f;
#pragma unroll
                    for (int bj = 0; bj < 2; ++bj) { f32x4 xr[2]; xr[0] = xq[m - mh][bj][0] * ALPHA + bv[bj][0]; xr[1] = xq[m - mh][bj][1] * ALPHA + bv[bj][1]; ER_FINISH(xr); }
                    ER_STATS(); }
              }
            }
        }
#undef ER_FINISH
#undef ER_STATS
        } else {
            const bool first = (u.i0 == 1); float* pr = part + (size_t)(u.i0 - 1) * TS * DM - (size_t)TP * DM; const float* res = resB + (size_t)(row0 - TP) * DM;
#pragma unroll
        for (int ai = 0; ai < 2; ++ai)
#pragma unroll
          for (int mh = 0; mh < 4; mh += 2) { f32x4 xq[2][2][2];
            if (first) {
#pragma unroll
                for (int m = mh; m < mh + 2; ++m) { const size_t ro = (size_t)(ai * HALF + m * 16) * DM + col0;
#pragma unroll
                    for (int bj = 0; bj < 2; ++bj)
#pragma unroll
                        for (int n = 0; n < 2; ++n) xq[m - mh][bj][n] = *(const f32x4*)(res + ro + bj * HALF + n * 4); }
                __builtin_amdgcn_sched_barrier(0); }
#pragma unroll
            for (int m = mh; m < mh + 2; ++m) { const size_t ro = (size_t)(ai * HALF + m * 16) * DM + col0; float* rowp = pr + (size_t)row0 * DM + ro;
#pragma unroll
                for (int bj = 0; bj < 2; ++bj)
#pragma unroll
                    for (int n = 0; n < 2; ++n) { f32x4 v = acc[ai][bj][m][n] * sc;
                        if (first) v += xq[m - mh][bj][n] * ALPHA + bv[bj][n];
                        *(f32x4*)(rowp + bj * HALF + n * 4) = v; } } }
        }
    }
};
struct EpiCin {
    static constexpr bool PERM = true;
    bf16_t* ub; bf16_t* szg; const float* bias; float sc;
    DI void operator()(const f32x4 (&acc)[2][2][4][2], const GUnit& u, int wr, int wc, int fr, int fq) const {
        const int pm = u.i1, pn = u.i2, row0 = pm * 256 + wr * 64 + fr;
        if (pn < 32) {
            const int ch0 = pn * 128 + wc * 32 + 8 * fq;
            f32x4 ba[2], bg[2];
#pragma unroll
            for (int n = 0; n < 2; ++n) { ba[n] = *(const f32x4*)(bias + ch0 + 4 * n); bg[n] = *(const f32x4*)(bias + 4096 + ch0 + 4 * n); }
#pragma unroll
            for (int ai = 0; ai < 2; ++ai)
#pragma unroll
                for (int m = 0; m < 4; ++m) { f32x4 o[2];
#pragma unroll
                    for (int n = 0; n < 2; ++n) { const f32x4 a = acc[ai][0][m][n] * sc + ba[n], g = acc[ai][1][m][n] * sc + bg[n];
#pragma unroll
                        for (int j = 0; j < 4; ++j) o[n][j] = a[j] * fsigm(g[j]); }
                    u32x4 w; w.x = pk_bf16(o[0][0], o[0][1]); w.y = pk_bf16(o[0][2], o[0][3]); w.z = pk_bf16(o[1][0], o[1][1]); w.w = pk_bf16(o[1][2], o[1][3]);
                    *(u32x4*)(ub + (size_t)(row0 + ai * HALF + m * 16) * DM + ch0) = w; }
        } else {
            const int ch0 = (pn - 32) * 256 + wc * 32 + 8 * fq;
            f32x4 bzz[2][2];
#pragma unroll
            for (int bj = 0; bj < 2; ++bj)
#pragma unroll
                for (int n = 0; n < 2; ++n) bzz[bj][n] = *(const f32x4*)(bias + 8192 + ch0 + bj * HALF + 4 * n);
            __builtin_amdgcn_sched_barrier(0);
#pragma unroll
            for (int bj = 0; bj < 2; ++bj) {
#pragma unroll
                for (int ai = 0; ai < 2; ++ai)
#pragma unroll
                    for (int m = 0; m < 4; ++m) { f32x4 o[2];
#pragma unroll
                        for (int n = 0; n < 2; ++n) { const f32x4 z = acc[ai][bj][m][n] * sc + bzz[bj][n];
#pragma unroll
                            for (int j = 0; j < 4; ++j) o[n][j] = fsilu(z[j]); }
                        u32x4 w; w.x = pk_bf16(o[0][0], o[0][1]); w.y = pk_bf16(o[0][2], o[0][3]); w.z = pk_bf16(o[1][0], o[1][1]); w.w = pk_bf16(o[1][2], o[1][3]);
                        *(u32x4*)(szg + (size_t)(row0 + ai * HALF + m * 16) * DM + ch0 + bj * HALF) = w; } }
        }
    }
};

struct SchedS {
    const char* qp; const char* xa; int G, c, far, wave;
    DI bool next(int i, GUnit& u) const {
        const int per = far ? 105 : 31, L = i * G + c; if (L >= 32 * per) return false;
        const int bh = L / per, rr = L - bh * per; int pm, pn;
        if (far) { int q = 0; while ((q + 1) * (q + 2) / 2 <= rr) ++q; pn = rr - q * (q + 1) / 2; pm = q + 2; }
        else if (rr < 16) { pm = rr; pn = rr; } else { pm = rr - 15; pn = rr - 16; }
        const int b = bh >> 3, h = bh & 7; const size_t es = far ? 1 : 2;
        u.A = qp + ((size_t)(b * 4096 + pm * 256) * INNER + h * 1024) * es; u.B = xa + ((size_t)(b * 4096 + pn * 256) * INNER + h * 1024) * es;
        u.nt = far ? 8 : 16; u.i0 = bh; u.i1 = pm; u.i2 = pn; return true;
    }
};
struct SchedState {
    const char* kwT; const char* vT; int G, c, wave;
    DI bool next(int i, GUnit& u) const {
        const int L = i * G + c; if (L >= 512) return false;
        const int bh = L >> 4, pm = (L >> 2) & 3, pn = L & 3, b = bh >> 3, h = bh & 7;
        u.A = kwT + ((size_t)(h * 1024 + pm * 256) * TPP + b * 4096) * 2; u.B = vT + ((size_t)(h * 1024 + pn * 256) * TPP + b * 4096) * 2;
        u.nt = 64; u.i0 = bh; u.i1 = pm; u.i2 = pn; return true;
    }
};
struct SchedSV {
    const char* S8; const char* S16; const char* vT8; const char* vT; int G, c, wave;
    DI bool next(int i, GUnitM& u) const {
        const int slot = c + G * (i >> 3); if (slot >= 256) return false;
        const int sub = i & 7, bh = slot >> 3, j = slot & 7, pn = j & 3, set = j >> 2, p = 4 * set + (sub >> 1), pm = (sub & 1) ? 15 - p : p, b = bh >> 3, h = bh & 7;
        const int pn0 = pm >= 1 ? pm - 1 : 0;
        u.nt8 = pm >= 2 ? 2 * (pm - 1) : 0; u.nt = u.nt8 + (pm >= 1 ? 8 : 4);
        u.A8 = S8 + (size_t)bh * S8_BH + (size_t)((pm - 2) * (pm - 1) / 2) * 65536; u.A16 = S16 + (size_t)bh * S16_BH + (size_t)(pm + pn0) * 131072;
        u.B8 = vT8 + (size_t)(h * 1024 + pn * 256) * P8 + b * 4096; u.B16 = vT + ((size_t)(h * 1024 + pn * 256) * TPP + b * 4096 + pn0 * 256) * 2;
        u.i0 = bh; u.i1 = pm; u.i2 = pn; return true;
    }
};

template <bool ALSO_FP8>
DI void transpose_item(const float* W, int K, int N, bf16_t* WT, int k0, int n0, int orow0, LAS float* scr, int lane, unsigned char* WQ = nullptr, float qscale = 1.f) {
#pragma unroll 8
    for (int i = 0; i < 32; ++i) { const int kk = 2 * i + (lane >> 5); scr[kk * 33 + (lane & 31)] = ld_nt(W + (size_t)(k0 + kk) * N + n0 + (lane & 31)); }
    asm volatile("s_waitcnt lgkmcnt(0)" ::: "memory");
    const int c = lane & 7;
#pragma unroll
    for (int j = 0; j < 4; ++j) { const int n = (lane >> 3) + 8 * j; const LAS float* s = scr + (8 * c) * 33 + n;
        u32x4 o; o.x = pk_bf16(s[0 * 33], s[1 * 33]); o.y = pk_bf16(s[2 * 33], s[3 * 33]); o.z = pk_bf16(s[4 * 33], s[5 * 33]); o.w = pk_bf16(s[6 * 33], s[7 * 33]);
        *(u32x4*)(WT + (size_t)(orow0 + n) * K + k0 + 8 * c) = o;
        if constexpr (ALSO_FP8) { u32x2 q; q.x = pk_fp8x4(s[0 * 33] * qscale, s[1 * 33] * qscale, s[2 * 33] * qscale, s[3 * 33] * qscale); q.y = pk_fp8x4(s[4 * 33] * qscale, s[5 * 33] * qscale, s[6 * 33] * qscale, s[7 * 33] * qscale);
            *(u32x2*)(WQ + (size_t)(orow0 + n) * K + k0 + 8 * c) = q; } }
    asm volatile("s_waitcnt lgkmcnt(0)" ::: "memory");
}
DI void transpose_item_fp8(const float* W, int K, int N, unsigned char* WT, int k0, int n0, float scale, LAS float* scr, int lane) {
#pragma unroll 8
    for (int i = 0; i < 32; ++i) { const int kk = 2 * i + (lane >> 5); scr[kk * 33 + (lane & 31)] = ld_nt(W + (size_t)(k0 + kk) * N + n0 + (lane & 31)); }
    asm volatile("s_waitcnt lgkmcnt(0)" ::: "memory");
    const int c = lane & 7;
#pragma unroll
    for (int j = 0; j < 4; ++j) { const int n = (lane >> 3) + 8 * j; const LAS float* s = scr + (8 * c) * 33 + n;
        u32x2 o; o.x = pk_fp8x4(s[0 * 33] * scale, s[1 * 33] * scale, s[2 * 33] * scale, s[3 * 33] * scale); o.y = pk_fp8x4(s[4 * 33] * scale, s[5 * 33] * scale, s[6 * 33] * scale, s[7 * 33] * scale);
        *(u32x2*)(WT + (size_t)(n0 + n) * K + k0 + 8 * c) = o; }
    asm volatile("s_waitcnt lgkmcnt(0)" ::: "memory");
}
DI void transpose_weight_fp8(const Frame& F, const float* W, int K, int N, unsigned char* WT, float scale) {
    LAS float* scr = (LAS float*)(F.lds + F.wave * 16384);
    const int gw = F.vcu * NWAVES + F.wave, NGW = F.G * NWAVES, nblk = N / 32, nitems = (K / 64) * nblk;
    for (int it = gw; it < nitems; it += NGW) { const int kb = it / nblk, nb = it - kb * nblk; transpose_item_fp8(W, K, N, WT, 64 * kb, 32 * nb, scale, scr, F.lane); }
}
DI void transpose_weight(const Frame& F, const float* W, int K, int N, bf16_t* WT, bool cin_map, unsigned char* WQ = nullptr, float qscale = 1.f) {
    LAS float* scr = (LAS float*)(F.lds + F.wave * 16384);
    const int gw = F.vcu * NWAVES + F.wave, NGW = F.G * NWAVES, nblk = N / 32, nitems = (K / 64) * nblk;
    for (int it = gw; it < nitems; it += NGW) { const int kb = it / nblk, nb = it - kb * nblk, n0 = 32 * nb; int orow0 = n0;
        if (cin_map) { if (n0 < 4096) orow0 = 256 * (n0 >> 7) + (n0 & 127); else if (n0 < 8192) orow0 = 256 * ((n0 - 4096) >> 7) + 128 + (n0 & 127); }
        if (cin_map) transpose_item<true>(W, K, N, WT, 64 * kb, n0, orow0, scr, F.lane, WQ, qscale); else transpose_item<false>(W, K, N, WT, 64 * kb, n0, orow0, scr, F.lane); }
}

DI void phase_prologue(const Frame& F, const Params& p) {
    unsigned char* ws = p.ws;
    { LAS float* scr = (LAS float*)(F.lds + F.wave * 16384);
      const int gw = F.vcu * NWAVES + F.wave, NGW = F.G * NWAVES, nblk = 2 * INNER / 32, nitems = (DM / 64) * nblk;
      for (int it = gw; it < nitems; it += NGW) { const int kb = it / nblk, nb = it - kb * nblk, n0 = 32 * nb;
          if (n0 < INNER) transpose_item<false>(p.w_up, DM, 2 * INNER, (bf16_t*)(ws + WS_WUP), 64 * kb, n0, n0, scr, F.lane);
          else transpose_item_fp8(p.w_up, DM, 2 * INNER, ws + WS_WZQ - (size_t)INNER * DM, 64 * kb, n0, FP8_SB_WZ, scr, F.lane); } }
    const size_t gt = (size_t)F.vcu * NTHR + F.tid, NT = (size_t)F.G * NTHR;
    bf16_t* xb = (bf16_t*)(ws + WS_XB);
    for (size_t i0 = gt; i0 < (size_t)TT * (DM / 8); i0 += 4 * NT) {
        f32x4 a[4], b[4];
#pragma unroll
        for (int u = 0; u < 4; ++u) { const size_t i = i0 + (size_t)u * NT; if (i < (size_t)TT * (DM / 8)) { const size_t tok = i >> 9; const int c8 = (int)(i & 511) * 8;
            const float* src = tok < TP ? p.x_prompt + tok * DM + c8 : p.x_sample + (tok - TP) * DM + c8; a[u] = ld_nt((const f32x4*)src); b[u] = ld_nt((const f32x4*)(src + 4)); } }
#pragma unroll
        for (int u = 0; u < 4; ++u) { const size_t i = i0 + (size_t)u * NT; if (i < (size_t)TT * (DM / 8)) { const size_t tok = i >> 9; const int c8 = (int)(i & 511) * 8;
            u32x4 w; w.x = pk_bf16(a[u][0], a[u][1]); w.y = pk_bf16(a[u][2], a[u][3]); w.z = pk_bf16(b[u][0], b[u][1]); w.w = pk_bf16(b[u][2], b[u][3]);
            *(u32x4*)(xb + tok * DM + c8) = w;
            u32x2 q8; q8.x = pk_fp8x4(a[u][0] * FP8_SA_X, a[u][1] * FP8_SA_X, a[u][2] * FP8_SA_X, a[u][3] * FP8_SA_X); q8.y = pk_fp8x4(b[u][0] * FP8_SA_X, b[u][1] * FP8_SA_X, b[u][2] * FP8_SA_X, b[u][3] * FP8_SA_X);
            *(u32x2*)(ws + WS_XQ + tok * DM + c8) = q8; } }
    }
    for (size_t i = gt; i < (WS_ZERO_BYTES - WS_GATES) / 16; i += NT) *(u32x4*)(ws + WS_GATES + 16 * i) = (u32x4){0u, 0u, 0u, 0u};
    for (size_t i = gt; i < (size_t)32 * 1024 / 4; i += NT) *(f32x4*)(p.out + O_PN + 4 * i) = (f32x4){0.f, 0.f, 0.f, 0.f};
    bf16_t* GT = (bf16_t*)(ws + WS_GT);
    for (size_t i = gt; i < (size_t)2 * 16 * INNER; i += NT) { const int c = (int)(i & 8191), g = (int)(i >> 13) & 15, which = (int)(i >> 17);
        const int n = c >> 2, d = c & 3; float s = 0.f;
        if (which == 0) {
#pragma unroll
            for (int e = 0; e < 4; ++e) s += p.w_q[n * 16 + d * 4 + e] * p.w_gate[(size_t)(0 * INNER + 4 * n + e) * 16 + g] + p.w_k[n * 16 + d * 4 + e] * p.w_gate[(size_t)(1 * INNER + 4 * n + e) * 16 + g];
        } else {
#pragma unroll
            for (int e = 0; e < 4; ++e) s += p.w_v[n * 16 + d * 4 + e] * p.w_gate[(size_t)(2 * INNER + 4 * n + e) * 16 + g];
        }
        GT[i] = f2bf(s); }
}

template <bool SAMP>
DI void passA_item(const Frame& F, const Params& p, int tg, int cg, int step0 = 0, int nstep = 4) {
    unsigned char* ws = p.ws;
    const bf16_t* __restrict__ xm = (const bf16_t*)(ws + WS_XM); bf16_t* __restrict__ xa = (bf16_t*)(ws + WS_XA); const bf16_t* __restrict__ GT = (const bf16_t*)(ws + WS_GT); float* gates = (float*)(ws + WS_GATES);
    LAS f32x4* red = (LAS f32x4*)F.lds;
    LAS unsigned short* tVw = (LAS unsigned short*)(F.lds + 32768 + F.wave * 4096);
    const int fr = F.lane & 15, fq = F.lane >> 4;
    f32x4 accg[4];
#pragma unroll
    for (int j = 0; j < 4; ++j) accg[j] = (f32x4){0.f, 0.f, 0.f, 0.f};
    const int tokb = tg * 64 + fr;
    for (int step = step0; step < step0 + nstep; ++step) {
        const int c = cg * 1024 + F.wave * 128 + 32 * step + 8 * fq;
        f32x4 wv[5][2];
#pragma unroll
        for (int j = 0; j < 4; ++j) { wv[j][0] = *(const f32x4*)(p.w_mconv + (size_t)j * INNER + c); wv[j][1] = *(const f32x4*)(p.w_mconv + (size_t)j * INNER + c + 4); }
        wv[4][0] = *(const f32x4*)(p.b_mconv + c); wv[4][1] = *(const f32x4*)(p.b_mconv + c + 4);
        const bf16x8 ga = *(const bf16x8*)(GT + (size_t)(0 * 16 + fr) * INNER + c), gm = *(const bf16x8*)(GT + (size_t)(1 * 16 + fr) * INNER + c);
        f32x4 wvv[2][4];
        if (!SAMP) {
#pragma unroll
            for (int bb = 0; bb < 2; ++bb)
#pragma unroll
                for (int d = 0; d < 4; ++d) wvv[bb][d] = *(const f32x4*)(p.w_v + (size_t)((c >> 2) + bb) * 16 + 4 * d); }
#pragma unroll
      for (int th = 0; th < 2; ++th) {
        u32x4 raw[4][4];
#pragma unroll
        for (int tl = 2 * th; tl < 2 * th + 2; ++tl) { const int tok = tokb + 16 * tl; const int t = SAMP ? ((tok - TP) & 31) : (tok & 4095);
#pragma unroll
            for (int j = 0; j < 4; ++j) { const int back = (3 - j) < t ? (3 - j) : t;
                raw[tl][j] = *(const u32x4*)(xm + (size_t)(tok - back) * INNER + c); } }
#pragma unroll
        for (int tl = 2 * th; tl < 2 * th + 2; ++tl) { const int tok = tokb + 16 * tl; const int t = SAMP ? ((tok - TP) & 31) : (tok & 4095);
            float xc[8];
#pragma unroll
            for (int i = 0; i < 8; ++i) xc[i] = wv[4][i >> 2][i & 3];
#pragma unroll
            for (int j = 0; j < 4; ++j) { const int tj = t + j - 3; float xin[8]; unpack8(raw[tl][j], xin);
                if (tj < 0) {
                    if (SAMP) { const int bsm = (tok - TP) >> 5; const float* hp = p.st_mconv + (size_t)(bsm * 3 + tj + 3) * INNER + c; const f32x4 h0 = *(const f32x4*)hp, h1 = *(const f32x4*)(hp + 4);
                        xin[0] = h0[0]; xin[1] = h0[1]; xin[2] = h0[2]; xin[3] = h0[3]; xin[4] = h1[0]; xin[5] = h1[1]; xin[6] = h1[2]; xin[7] = h1[3]; }
                    else {
#pragma unroll
                        for (int i = 0; i < 8; ++i) xin[i] = 0.f; } }
#pragma unroll
                for (int i = 0; i < 8; ++i) xc[i] += wv[j][i >> 2][i & 3] * xin[i]; }
#pragma unroll
            for (int i = 0; i < 8; ++i) xc[i] = fsilu(xc[i]);
            const u32x4 xa4 = pack8(xc);
            *(u32x4*)(xa + (size_t)tok * INNER + c) = xa4;
            if (!SAMP) { u32x2 x8v; x8v.x = pk_fp8x4(xc[0] * FP8_SA_XA, xc[1] * FP8_SA_XA, xc[2] * FP8_SA_XA, xc[3] * FP8_SA_XA); x8v.y = pk_fp8x4(xc[4] * FP8_SA_XA, xc[5] * FP8_SA_XA, xc[6] * FP8_SA_XA, xc[7] * FP8_SA_XA);
                *(u32x2*)((unsigned char*)p.out + O8_XA8 + (size_t)tok * INNER + c) = x8v; }
            accg[tl] = __builtin_amdgcn_mfma_f32_16x16x32_bf16(__builtin_bit_cast(bf16x8, xa4), ga, accg[tl], 0, 0, 0);
            accg[tl] = __builtin_amdgcn_mfma_f32_16x16x32_bf16(__builtin_bit_cast(bf16x8, raw[tl][3]), gm, accg[tl], 0, 0, 0);
            if (!SAMP) {
                float xv[8]; unpack8(raw[tl][3], xv);
                const int col = 16 * tl + fr, dw = ((col >> 1) ^ (8 * fq)) << 1;
#pragma unroll
                for (int bb = 0; bb < 2; ++bb)
#pragma unroll
                    for (int e = 0; e < 4; ++e) { const float v = xv[4 * bb] * wvv[bb][0][e] + xv[4 * bb + 1] * wvv[bb][1][e] + xv[4 * bb + 2] * wvv[bb][2][e] + xv[4 * bb + 3] * wvv[bb][3][e];
                        tVw[(8 * fq + 4 * bb + e) * 64 + dw + (col & 1)] = f2bf(v); } }
        }
      }
        if (!SAMP) {
            asm volatile("s_waitcnt lgkmcnt(0)" ::: "memory");
#pragma unroll
            for (int k = 0; k < 4; ++k) { const int q = F.lane + 64 * k, row = q >> 3, ch = q & 7;
                const u32x4 vrow = *(const LAS u32x4*)(tVw + row * 64 + ((((4 * ch) ^ (8 * (row >> 3)))) << 1));
                const size_t chan = (size_t)(cg * 1024 + F.wave * 128 + 32 * step + row);
                *(u32x4*)((bf16_t*)(ws + WS_VT) + chan * TPP + tg * 64 + 8 * ch) = vrow;
                float vf[8]; unpack8(vrow, vf); u32x2 v8; v8.x = pk_fp8x4(vf[0] * FP8_SA_V, vf[1] * FP8_SA_V, vf[2] * FP8_SA_V, vf[3] * FP8_SA_V); v8.y = pk_fp8x4(vf[4] * FP8_SA_V, vf[5] * FP8_SA_V, vf[6] * FP8_SA_V, vf[7] * FP8_SA_V);
                *(u32x2*)(ws + WS_VT8 + chan * P8 + tg * 64 + 8 * ch) = v8; }
            asm volatile("s_waitcnt lgkmcnt(0)" ::: "memory"); }
    }
    __syncthreads();
#pragma unroll
    for (int tl = 0; tl < 4; ++tl) red[(F.wave * 4 + tl) * 64 + F.lane] = accg[tl];
    __syncthreads();
    if (F.tid < 256 && !F.dry) { const int tl = F.tid >> 6, ln = F.tid & 63; f32x4 sacc = (f32x4){0.f, 0.f, 0.f, 0.f};
#pragma unroll
        for (int w = 0; w < NWAVES; ++w) sacc += red[(w * 4 + tl) * 64 + ln];
#pragma unroll
        for (int j = 0; j < 4; ++j) atomicAdd(gates + (size_t)(tg * 64 + 16 * tl + 4 * (ln >> 4) + j) * 16 + (ln & 15), sacc[j]); }
}
DI void phase_passA(const Frame& F, const Params& p) {
    unsigned char* ws = p.ws;
    const bf16_t* xm = (const bf16_t*)(ws + WS_XM);
    for (int it = F.vcu; it < (TP / 64) * 8 + (TS / 64) * 8 * 4; it += F.G) { const int item = (TP / 64) * 8 + (TS / 64) * 8 * 4 - 1 - it;
        if (item < (TP / 64) * 8) passA_item<false>(F, p, item >> 3, item & 7);
        else { const int si = item - (TP / 64) * 8; passA_item<true>(F, p, TP / 64 + (si >> 5), (si >> 2) & 7, si & 3, 1); } }
    const size_t gt = (size_t)F.vcu * NTHR + F.tid, NT = (size_t)F.G * NTHR;
    for (size_t i = gt; i < (size_t)(4 + 16) * 3 * (INNER / 8); i += NT) { const int c8 = (int)(i & 1023) * 8, ri = (int)(i >> 10), sq = ri / 3, k = ri - sq * 3;
        size_t tok; float* dst;
        if (sq < 4) { tok = (size_t)sq * 4096 + 4093 + k; dst = p.out + O_PMC + (size_t)(sq * 3 + k) * INNER + c8; }
        else { const int b = sq - 4; tok = (size_t)TP + b * 32 + 29 + k; dst = p.out + O_SMC + (size_t)(b * 3 + k) * INNER + c8; }
        float f[8]; unpack8(*(const u32x4*)(xm + tok * INNER + c8), f);
        *(f32x4*)dst = (f32x4){f[0], f[1], f[2], f[3]}; *(f32x4*)(dst + 4) = (f32x4){f[4], f[5], f[6], f[7]}; }
}

DI void headwise8(const float (&x)[8], const float* W, int n0, float scale, float (&y)[8]) {
#pragma unroll
    for (int bb = 0; bb < 2; ++bb) { const float* w = W + (size_t)(n0 + bb) * 16; const f32x4 w0 = *(const f32x4*)w, w1 = *(const f32x4*)(w + 4), w2 = *(const f32x4*)(w + 8), w3 = *(const f32x4*)(w + 12);
#pragma unroll
        for (int e = 0; e < 4; ++e) y[4 * bb + e] = (x[4 * bb] * w0[e] + x[4 * bb + 1] * w1[e] + x[4 * bb + 2] * w2[e] + x[4 * bb + 3] * w3[e]) * scale; }
}

DI float block_excl_add(float v, LAS float* sm, int lane, int wave) {
    float incl = v;
#pragma unroll
    for (int o = 1; o < 64; o <<= 1) { const float t = __shfl_up(incl, o); if (lane >= o) incl += t; }
    __syncthreads();
    if (lane == 63) sm[wave] = incl;
    __syncthreads();
    float woff = 0.f;
#pragma unroll
    for (int w = 0; w < NWAVES; ++w) { const float t = sm[w]; if (w < wave) woff += t; }
    return woff + incl - v;
}
DI float block_excl_max(float v, LAS float* sm, int lane, int wave) {
    float incl = v;
#pragma unroll
    for (int o = 1; o < 64; o <<= 1) { const float t = __shfl_up(incl, o); if (lane >= o) incl = fmaxf(incl, t); }
    float excl = __shfl_up(incl, 1); if (lane == 0) excl = -3.0e38f;
    __syncthreads();
    if (lane == 63) sm[wave] = incl;
    __syncthreads();
    float woff = -3.0e38f;
#pragma unroll
    for (int w = 0; w < NWAVES; ++w) { const float t = sm[w]; if (w < wave) woff = fmaxf(woff, t); }
    return fmaxf(woff, excl);
}
DI void scan_prompt(const Frame& F, const Params& p, int bh) {
    unsigned char* ws = p.ws;
    const float* gates = (const float*)(ws + WS_GATES); float* cs = (float*)(ws + WS_CS); float* mx = (float*)(ws + WS_MX); float* em = (float*)(ws + WS_EM); float* mxl = (float*)(ws + WS_MXL);
    LAS float* sm = (LAS float*)(F.lds + 1024);
    const int b = bh >> 3, h = bh & 7; const float bi = p.b_gate[h], bf = p.b_gate[8 + h];
    const float* gp = gates + (size_t)(b * 4096 + 8 * F.tid) * 16;
    float ig[8], lf[8];
#pragma unroll
    for (int k = 0; k < 8; ++k) { ig[k] = gp[k * 16 + h]; lf[k] = gp[k * 16 + 8 + h]; }
    float s = 0.f;
#pragma unroll
    for (int k = 0; k < 8; ++k) { ig[k] += bi; lf[k] = logsig(lf[k] + bf); s += lf[k]; }
    float run = block_excl_add(s, sm, F.lane, F.wave);
    float c[8], B[8], mloc = -3.0e38f;
#pragma unroll
    for (int k = 0; k < 8; ++k) { run += lf[k]; B[k] = run; c[k] = ig[k] - run; mloc = fmaxf(mloc, c[k]); }
    float rm = fmaxf(0.f, block_excl_max(mloc, sm, F.lane, F.wave));
    f32x4 oc[2], om[2], oe[2];
#pragma unroll
    for (int k = 0; k < 8; ++k) { rm = fmaxf(rm, c[k]); oc[k >> 2][k & 3] = c[k]; om[k >> 2][k & 3] = rm; oe[k >> 2][k & 3] = expf(-(B[k] + rm)); }
    const size_t o = (size_t)bh * 4096 + 8 * F.tid;
    *(f32x4*)(cs + o) = oc[0]; *(f32x4*)(cs + o + 4) = oc[1]; *(f32x4*)(mx + o) = om[0]; *(f32x4*)(mx + o + 4) = om[1]; *(f32x4*)(em + o) = oe[0]; *(f32x4*)(em + o + 4) = oe[1];
    if (F.tid == NTHR - 1) { p.out[O_PM + bh] = B[7] + rm; mxl[bh] = rm; }
}

DI void sample_prep(const Frame& F, const Params& p, int bh) {
    unsigned char* ws = p.ws;
    const float* gates = (const float*)(ws + WS_GATES); const bf16_t* __restrict__ xa = (const bf16_t*)(ws + WS_XA); const bf16_t* __restrict__ xm = (const bf16_t*)(ws + WS_XM);
    bf16_t* __restrict__ Sp = (bf16_t*)(ws + WS_SSP); bf16_t* __restrict__ qt = (bf16_t*)(ws + WS_SQT); bf16_t* __restrict__ wkT = (bf16_t*)(ws + WS_SWK); bf16_t* __restrict__ vTs = (bf16_t*)(ws + WS_SVT); float* scb = (float*)(ws + WS_MXL + 1024);
    LAS float* red = (LAS float*)(F.lds + 4096);
    LAS float* scr = (LAS float*)(F.lds + F.wave * 512);
    const int lane = F.lane, b = bh >> 3, h = bh & 7, r = lane & 31, hf = lane >> 5, tok0 = TP + 32 * b;
    const float ig = gates[(size_t)(tok0 + r) * 16 + h] + p.b_gate[h], lf = logsig(gates[(size_t)(tok0 + r) * 16 + 8 + h] + p.b_gate[8 + h]);
    float bc = lf;
#pragma unroll
    for (int o = 1; o < 32; o <<= 1) { const float v = __shfl_up(bc, o, 32); if (r >= o) bc += v; }
    const float m0 = p.st_m[bh], c = ig - bc;
    float pmx = c;
#pragma unroll
    for (int o = 1; o < 32; o <<= 1) { const float v = __shfl_up(pmx, o, 32); if (r >= o) pmx = fmaxf(pmx, v); }
    const float mxt = fmaxf(m0, pmx), m_t = bc + mxt, inter = expf(m0 - mxt), emt = expf(-m_t);
    const float mx31 = __shfl(mxt, 31), b31 = __shfl(bc, 31);
    const float w_s = expf(c - mx31), scv = expf(m0 - mx31);
    const int dkw = 128 * F.wave;
    const bf16_t* xar = xa + (size_t)(tok0 + r) * INNER + h * 1024 + dkw + 8 * hf; const bf16_t* xmr = xm + (size_t)(tok0 + r) * INNER + h * 1024 + dkw + 8 * hf;
    const float* n0v = p.st_n + (size_t)bh * 1024 + dkw + 8 * hf;
    f32x16 accS;
#pragma unroll
    for (int i = 0; i < 16; ++i) accS[i] = 0.f;
    float qn = 0.f;
#pragma unroll 4
    for (int kk = 0; kk < 8; ++kk) {
        float x[8], q[8], k[8]; unpack8(*(const u32x4*)(xar + 16 * kk), x);
        const int n0 = (h * 1024 + dkw + 16 * kk + 8 * hf) >> 2;
        headwise8(x, p.w_q, n0, 1.0f, q); headwise8(x, p.w_k, n0, 0.03125f, k);
        const f32x4 na = *(const f32x4*)(n0v + 16 * kk), nb = *(const f32x4*)(n0v + 16 * kk + 4);
        qn += q[0] * na[0] + q[1] * na[1] + q[2] * na[2] + q[3] * na[3] + q[4] * nb[0] + q[5] * nb[1] + q[6] * nb[2] + q[7] * nb[3];
        accS = __builtin_amdgcn_mfma_f32_32x32x16_bf16(__builtin_bit_cast(bf16x8, pack8(q)), __builtin_bit_cast(bf16x8, pack8(k)), accS, 0, 0, 0);
    }
    __syncthreads();
#pragma unroll
    for (int i = 0; i < 16; ++i) red[(F.wave * 17 + i) * 64 + lane] = accS[i];
    red[(F.wave * 17 + 16) * 64 + lane] = qn;
    __syncthreads();
    qn = 0.f;
#pragma unroll
    for (int i = 0; i < 16; ++i) accS[i] = 0.f;
#pragma unroll
    for (int w = 0; w < NWAVES; ++w) {
#pragma unroll
        for (int i = 0; i < 16; ++i) accS[i] += red[(w * 17 + i) * 64 + lane];
        qn += red[(w * 17 + 16) * 64 + lane]; }
    qn += __shfl_xor(qn, 32);
    float sv[16];
#pragma unroll
    for (int i = 0; i < 16; ++i) { const int t = (i & 3) + 8 * (i >> 2) + 4 * hf; const float mxq = __shfl(mxt, t);
        const float d = (r <= t) ? expf(c - mxq) : 0.f; sv[i] = accS[i] * d;
        float rs = sv[i];
#pragma unroll
        for (int o = 1; o < 32; o <<= 1) rs += __shfl_xor(rs, o);
        if (r == 0) scr[t] = rs; }
    asm volatile("s_waitcnt lgkmcnt(0)" ::: "memory");
    const float den = scr[r] + inter * qn, g = 1.0f / fmaxf(fabsf(den), emt), f = inter * g;
    asm volatile("s_waitcnt lgkmcnt(0)" ::: "memory");
    if (hf == 0) scr[32 + r] = g;
    asm volatile("s_waitcnt lgkmcnt(0)" ::: "memory");
    if (F.wave == 0) {
#pragma unroll
        for (int i = 0; i < 16; ++i) { const int t = (i & 3) + 8 * (i >> 2) + 4 * hf; Sp[(size_t)(bh * 32 + t) * 32 + r] = f2bf(sv[i] * scr[32 + t]); } }
    asm volatile("s_waitcnt lgkmcnt(0)" ::: "memory");
#pragma unroll 2
    for (int kk = 0; kk < 8; ++kk) {
        float x[8], xv[8], q[8], k[8], v[8]; unpack8(*(const u32x4*)(xar + 16 * kk), x); unpack8(*(const u32x4*)(xmr + 16 * kk), xv);
        const int dk0 = dkw + 16 * kk + 8 * hf, n0 = (h * 1024 + dk0) >> 2;
        const float n0s[8] = {p.st_n[(size_t)bh * 1024 + dk0], p.st_n[(size_t)bh * 1024 + dk0 + 1], p.st_n[(size_t)bh * 1024 + dk0 + 2], p.st_n[(size_t)bh * 1024 + dk0 + 3],
                              p.st_n[(size_t)bh * 1024 + dk0 + 4], p.st_n[(size_t)bh * 1024 + dk0 + 5], p.st_n[(size_t)bh * 1024 + dk0 + 6], p.st_n[(size_t)bh * 1024 + dk0 + 7]};
        headwise8(x, p.w_q, n0, 1.0f, q); headwise8(x, p.w_k, n0, 0.03125f, k); headwise8(xv, p.w_v, n0, 1.0f, v);
#pragma unroll
        for (int i = 0; i < 8; ++i) q[i] *= f;
        *(u32x4*)(qt + (size_t)(bh * 32 + r) * 1024 + dk0) = pack8(q);
#pragma unroll
        for (int i = 0; i < 8; ++i) { const float wk = k[i] * w_s; wkT[(size_t)(bh * 1024 + dk0 + i) * 32 + r] = f2bf(wk); vTs[(size_t)(bh * 1024 + dk0 + i) * 32 + r] = f2bf(v[i]);
            float ns = wk;
#pragma unroll
            for (int o = 1; o < 32; o <<= 1) ns += __shfl_xor(ns, o);
            if (r == 0) p.out[O_SN + (size_t)bh * 1024 + dk0 + i] = scv * n0s[i] + ns; }
    }
    if (F.tid == 0) { p.out[O_SM + bh] = b31 + mx31; scb[bh] = scv; }
    __syncthreads();
}

DI void phase_passB(const Frame& F, const Params& p) {
    unsigned char* ws = p.ws;
    const bf16_t* __restrict__ xa = (const bf16_t*)(ws + WS_XA); const bf16_t* __restrict__ xm = (const bf16_t*)(ws + WS_XM); bf16_t* __restrict__ qp = (bf16_t*)(ws + WS_QP); bf16_t* __restrict__ kwT = (bf16_t*)(ws + WS_KWT); bf16_t* __restrict__ vT = (bf16_t*)(ws + WS_VT);
    const float* cs = (const float*)(ws + WS_CS); const float* mxl = (const float*)(ws + WS_MXL);
    unsigned char* __restrict__ q8 = (unsigned char*)p.out + O8_Q8; unsigned char* __restrict__ xa8 = (unsigned char*)p.out + O8_XA8;
    LAS bf16_t* tK = (LAS bf16_t*)F.lds;
    const int g = F.tid & 7, tl = F.tid >> 3;
    for (int item = F.vcu; item < 2048; item += F.G) {
        const int cb = item & 127, tb = item >> 7, b = tb >> 2, h = cb >> 4, bh = b * 8 + h, c = cb * 64 + 8 * g, n0 = c >> 2;
        float wqk[2][4][4], wkk[2][4][4], wvv[2][4][4];
#pragma unroll
        for (int bb = 0; bb < 2; ++bb) { float wq[4][4];
#pragma unroll
            for (int d = 0; d < 4; ++d) { const f32x4 a = *(const f32x4*)(p.w_q + (size_t)(n0 + bb) * 16 + 4 * d), k4 = *(const f32x4*)(p.w_k + (size_t)(n0 + bb) * 16 + 4 * d), v4 = *(const f32x4*)(p.w_v + (size_t)(n0 + bb) * 16 + 4 * d);
#pragma unroll
                for (int e = 0; e < 4; ++e) { wq[d][e] = a[e]; wkk[bb][d][e] = k4[e] * 0.03125f; wvv[bb][d][e] = v4[e]; } }
#pragma unroll
            for (int d = 0; d < 4; ++d)
#pragma unroll
                for (int d2 = 0; d2 < 4; ++d2) wqk[bb][d][d2] = wq[d][0] * wkk[bb][d2][0] + wq[d][1] * wkk[bb][d2][1] + wq[d][2] * wkk[bb][d2][2] + wq[d][3] * wkk[bb][d2][3]; }
        const float mxlast = mxl[bh];
        float nacc[8];
#pragma unroll
        for (int i = 0; i < 8; ++i) nacc[i] = 0.f;
        const int tokb = tb * 1024 + tl;
#pragma unroll 1
        for (int sub4 = 0; sub4 < 16; sub4 += 2) {
          u32x4 rxa[2];
#pragma unroll
          for (int u = 0; u < 2; ++u) { const int tk = tokb + (sub4 + u) * 64; rxa[u] = *(const u32x4*)(xa + (size_t)tk * INNER + c); }
          const float rcs0 = cs[bh * 4096 + ((tokb + sub4 * 64) & 4095)], rcs1 = cs[bh * 4096 + ((tokb + sub4 * 64 + 64) & 4095)];
#pragma unroll
          for (int u = 0; u < 2; ++u) {
            const int sub = sub4 + u, tok = tokb + sub * 64;
            const u32x4 cxa = rxa[u]; const float ccs = u ? rcs1 : rcs0;
            float x[8], q[8], kw[8]; unpack8(cxa, x);
            const float w = fexp(ccs - mxlast);
#pragma unroll
            for (int bb = 0; bb < 2; ++bb)
#pragma unroll
                for (int e = 0; e < 4; ++e) {
                    q[4 * bb + e] = x[4 * bb] * wqk[bb][0][e] + x[4 * bb + 1] * wqk[bb][1][e] + x[4 * bb + 2] * wqk[bb][2][e] + x[4 * bb + 3] * wqk[bb][3][e];
                    kw[4 * bb + e] = (x[4 * bb] * wkk[bb][0][e] + x[4 * bb + 1] * wkk[bb][1][e] + x[4 * bb + 2] * wkk[bb][2][e] + x[4 * bb + 3] * wkk[bb][3][e]) * w; }
            *(u32x4*)(qp + (size_t)tok * INNER + c) = pack8(q);
            { u32x2 q8v, x8v; q8v.x = pk_fp8x4(q[0] * FP8_SA_Q, q[1] * FP8_SA_Q, q[2] * FP8_SA_Q, q[3] * FP8_SA_Q); q8v.y = pk_fp8x4(q[4] * FP8_SA_Q, q[5] * FP8_SA_Q, q[6] * FP8_SA_Q, q[7] * FP8_SA_Q);
              *(u32x2*)(q8 + (size_t)tok * INNER + c) = q8v; (void)x8v; }
            LAS bf16_t* bK = tK + (sub & 1) * (64 * 72);
#pragma unroll
            for (int i = 0; i < 8; ++i) { nacc[i] += kw[i]; bK[(8 * i + g) * 72 + tl] = f2bf(kw[i]); }
            LDS_BARRIER();
            { const int row = F.tid >> 3, ch = F.tid & 7, chan = 8 * (row & 7) + (row >> 3); const size_t o = (size_t)(cb * 64 + chan) * TPP + tb * 1024 + sub * 64 + 8 * ch;
              *(u32x4*)(kwT + o) = *(const LAS u32x4*)(bK + row * 72 + 8 * ch); }
          }
        }
        LDS_BARRIER();
#pragma unroll
        for (int i = 0; i < 8; ++i) { float v = nacc[i]; v += __shfl_xor(v, 8); v += __shfl_xor(v, 16); v += __shfl_xor(v, 32);
            if (F.lane < 8 && !F.dry) atomicAdd(p.out + O_PN + (size_t)bh * 1024 + (c & 1023) + i, v); }
    }
}

DI void phase_sample_cell(const Frame& F, const Params& p) {
    unsigned char* ws = p.ws;
    const bf16_t* __restrict__ Sp = (const bf16_t*)(ws + WS_SSP); const bf16_t* __restrict__ qt = (const bf16_t*)(ws + WS_SQT); const bf16_t* __restrict__ wkT = (const bf16_t*)(ws + WS_SWK); const bf16_t* __restrict__ vTs = (const bf16_t*)(ws + WS_SVT);
    const float* scb = (const float*)(ws + WS_MXL + 1024); bf16_t* __restrict__ hs = (bf16_t*)(ws + WS_HS);
    const int r = F.lane & 31, hf = F.lane >> 5, gw = F.vcu * NWAVES + F.wave, NGW = F.G * NWAVES;
    for (int item = gw; item < 128 * 16; item += NGW) {
        const int bh = item >> 4, dvp = item & 15, b = bh >> 3, h = bh & 7;
        const __amdgpu_buffer_rsrc_t rC0 = __builtin_amdgcn_make_buffer_rsrc((void*)(p.st_C + ((size_t)bh << 20)), 0, 1 << 22, 0x00020000);
        const __amdgpu_buffer_rsrc_t rCn = __builtin_amdgcn_make_buffer_rsrc((void*)(p.out + O_SC + ((size_t)bh << 20)), 0, 1 << 22, 0x00020000);
        const unsigned voff = (unsigned)((4 * hf) * 1024 + r) * 4u; const int sbase = dvp * 256;
#define SC_OFF(dkt_, i_, d_) (sbase + ((dkt_) * 32 + ((i_) & 3) + 8 * ((i_) >> 2)) * 4096 + (d_) * 128)
        const float sc = scb[bh];
        bf16x8 vf[2][2], sf[2];
#pragma unroll
        for (int s2 = 0; s2 < 2; ++s2) { sf[s2] = *(const bf16x8*)(Sp + (size_t)(bh * 32 + r) * 32 + 16 * s2 + 8 * hf);
#pragma unroll
            for (int d = 0; d < 2; ++d) vf[d][s2] = *(const bf16x8*)(vTs + (size_t)(bh * 1024 + dvp * 64 + 32 * d + r) * 32 + 16 * s2 + 8 * hf); }
        f32x16 acch[2];
#pragma unroll
        for (int d = 0; d < 2; ++d) {
#pragma unroll
            for (int i = 0; i < 16; ++i) acch[d][i] = 0.f;
            acch[d] = __builtin_amdgcn_mfma_f32_32x32x16_bf16(sf[0], vf[d][0], acch[d], 0, 0, 0); acch[d] = __builtin_amdgcn_mfma_f32_32x32x16_bf16(sf[1], vf[d][1], acch[d], 0, 0, 0); }
        const bf16_t* qrow = qt + (size_t)(bh * 32 + r) * 1024 + 4 * hf; const bf16_t* wkrow = wkT + (size_t)(bh * 1024 + r) * 32 + 8 * hf;
        f32x16 cn[2];
#pragma unroll
        for (int d = 0; d < 2; ++d)
#pragma unroll
            for (int i = 0; i < 16; ++i) cn[d][i] = __uint_as_float(__builtin_amdgcn_raw_buffer_load_b32(rC0, voff, SC_OFF(0, i, d), 2));
        for (int dkt = 0; dkt < 32; ++dkt) {
            f32x16 c[2] = {cn[0], cn[1]};
            if (dkt < 31) {
#pragma unroll
                for (int d = 0; d < 2; ++d)
#pragma unroll
                    for (int i = 0; i < 16; ++i) cn[d][i] = __uint_as_float(__builtin_amdgcn_raw_buffer_load_b32(rC0, voff, SC_OFF(dkt + 1, i, d), 2)); }
            bf16x8 pa[2], wa[2];
#pragma unroll
            for (int s = 0; s < 2; ++s) { const u32x2 lo = *(const u32x2*)(qrow + dkt * 32 + 16 * s), hi = *(const u32x2*)(qrow + dkt * 32 + 16 * s + 8);
                u32x4 t4; t4.x = lo.x; t4.y = lo.y; t4.z = hi.x; t4.w = hi.y; pa[s] = __builtin_bit_cast(bf16x8, t4);
                wa[s] = *(const bf16x8*)(wkrow + (size_t)dkt * 32 * 32 + 16 * s); }
#pragma unroll
            for (int d = 0; d < 2; ++d) {
#pragma unroll
                for (int s = 0; s < 2; ++s) { u32x4 xs; xs.x = pk_bf16(c[d][8 * s], c[d][8 * s + 1]); xs.y = pk_bf16(c[d][8 * s + 2], c[d][8 * s + 3]); xs.z = pk_bf16(c[d][8 * s + 4], c[d][8 * s + 5]); xs.w = pk_bf16(c[d][8 * s + 6], c[d][8 * s + 7]);
                    acch[d] = __builtin_amdgcn_mfma_f32_32x32x16_bf16(pa[s], __builtin_bit_cast(bf16x8, xs), acch[d], 0, 0, 0); }
#pragma unroll
                for (int i = 0; i < 16; ++i) c[d][i] *= sc;
                c[d] = __builtin_amdgcn_mfma_f32_32x32x16_bf16(wa[0], vf[d][0], c[d], 0, 0, 0); c[d] = __builtin_amdgcn_mfma_f32_32x32x16_bf16(wa[1], vf[d][1], c[d], 0, 0, 0);
#pragma unroll
                for (int i = 0; i < 16; ++i) __builtin_amdgcn_raw_buffer_store_b32(__float_as_uint(c[d][i]), rCn, voff, SC_OFF(dkt, i, d), 2); }
        }
#pragma unroll
        for (int d = 0; d < 2; ++d)
#pragma unroll
            for (int i = 0; i < 16; ++i) { const int t = (i & 3) + 8 * (i >> 2) + 4 * hf; hs[(size_t)(b * 32 + t) * INNER + h * 1024 + dvp * 64 + 32 * d + r] = f2bf(acch[d][i]); }
#undef SC_OFF
    }
}

DI void phase_predown(const Frame& F, const Params& p) {
    unsigned char* ws = p.ws;
    const bf16_t* __restrict__ hb = (const bf16_t*)(ws + WS_H); const bf16_t* __restrict__ hs = (const bf16_t*)(ws + WS_HS); const bf16_t* __restrict__ xa = (const bf16_t*)(ws + WS_XA); const bf16_t* __restrict__ sz = (const bf16_t*)(ws + WS_SZ);
    unsigned char* __restrict__ pre = ws + WS_PRE;
    const int gw = F.vcu * NWAVES + F.wave, NGW = F.G * NWAVES;
    if ((NGW & 7) != 0) return;
    const int h = gw & 7, cc0 = h * 1024 + 8 * F.lane;
    f32x4 gk[2][4];
#pragma unroll
    for (int j = 0; j < 2; ++j) { gk[j][0] = *(const f32x4*)(p.mh_gain + cc0 + 512 * j); gk[j][1] = *(const f32x4*)(p.mh_gain + cc0 + 512 * j + 4); gk[j][2] = *(const f32x4*)(p.skip + cc0 + 512 * j); gk[j][3] = *(const f32x4*)(p.skip + cc0 + 512 * j + 4); }
    u32x4 nh[2], na[2], nz[2];
#define PD_LOAD(item_) do { const int tok_ = (item_) >> 3; const bf16_t* hrow_ = tok_ < TP ? hb + (size_t)tok_ * INNER + cc0 : hs + (size_t)(tok_ - TP) * INNER + cc0; \
        _Pragma("unroll") for (int j = 0; j < 2; ++j) { nh[j] = ld_nt((const u32x4*)(hrow_ + 512 * j)); na[j] = ld_nt((const u32x4*)(xa + (size_t)tok_ * INNER + cc0 + 512 * j)); nz[j] = ld_nt((const u32x4*)(sz + (size_t)tok_ * INNER + cc0 + 512 * j)); } } while (0)
    if (gw < TT * NH) PD_LOAD(gw);
    for (int item = gw; item < TT * NH; item += NGW) {
        const int tok = item >> 3;
        u32x4 ch[2] = {nh[0], nh[1]}, ca[2] = {na[0], na[1]}, cz[2] = {nz[0], nz[1]};
        if (item + NGW < TT * NH) PD_LOAD(item + NGW);
        float v[2][8]; float s = 0.f;
#pragma unroll
        for (int j = 0; j < 2; ++j) { unpack8(ch[j], v[j]);
#pragma unroll
            for (int i = 0; i < 8; ++i) s += v[j][i]; }
        const float mean = wave_sum(s) * (1.0f / 1024.0f); float s2 = 0.f;
#pragma unroll
        for (int j = 0; j < 2; ++j)
#pragma unroll
            for (int i = 0; i < 8; ++i) { v[j][i] -= mean; s2 += v[j][i] * v[j][i]; }
        const float rstd = 1.0f / sqrtf(wave_sum(s2) * (1.0f / 1024.0f) + LN_EPS);
#pragma unroll
        for (int j = 0; j < 2; ++j) { float a[8], z[8], o[8]; unpack8(ca[j], a); unpack8(cz[j], z);
#pragma unroll
            for (int i = 0; i < 4; ++i) { o[i] = (v[j][i] * rstd * gk[j][0][i] + gk[j][2][i] * a[i]) * z[i]; o[4 + i] = (v[j][4 + i] * rstd * gk[j][1][i] + gk[j][3][i] * a[4 + i]) * z[4 + i]; }
            u32x2 w8; w8.x = pk_fp8x4(o[0] * FP8_SA_PRE, o[1] * FP8_SA_PRE, o[2] * FP8_SA_PRE, o[3] * FP8_SA_PRE); w8.y = pk_fp8x4(o[4] * FP8_SA_PRE, o[5] * FP8_SA_PRE, o[6] * FP8_SA_PRE, o[7] * FP8_SA_PRE);
            *(u32x2*)(pre + (size_t)tok * INNER + cc0 + 512 * j) = w8; }
    }
#undef PD_LOAD
}

DI void ln_rows(const Frame& F, const bf16_t* src, const float* rstat, const float* part, const float* g, const float* bta, float* dstA, float* dstB, bf16_t* dstb, unsigned char* dstq, float* lnst) {
    const int gw = F.vcu * NWAVES + F.wave, NGW = F.G * NWAVES;
    LAS f32x4* gl = (LAS f32x4*)F.lds; LAS f32x4* bl = gl + DM / 4;
    __syncthreads();
    for (int i = F.tid; i < DM / 4; i += NTHR) { gl[i] = *(const f32x4*)(g + 4 * i); bl[i] = *(const f32x4*)(bta + 4 * i); }
    __syncthreads();
    constexpr int TV = TP + 4 * TS;
    for (int vr = gw + ((TV - 1 - gw) / NGW) * NGW; vr >= 0; vr -= NGW) {
        int row = vr;
        if (vr >= TP) { if ((vr - TP) & 3) continue; row = TP + ((vr - TP) >> 2); }
        f32x4 v[16]; float mean, rstd;
        if (row < TP) { const u32x2* xr = (const u32x2*)(src + (size_t)row * DM) + F.lane;
#pragma unroll
            for (int j = 0; j < 16; ++j) { const u32x2 w = xr[64 * j]; v[j] = (f32x4){bf_lo(w.x), bf_hi(w.x), bf_lo(w.y), bf_hi(w.y)}; }
            mean = rstat[(size_t)row * 2] * (1.0f / DM); rstd = 1.0f / sqrtf(fmaxf(rstat[(size_t)row * 2 + 1] * (1.0f / DM) - mean * mean, 0.f) + LN_EPS);
#pragma unroll
            for (int j = 0; j < 16; ++j) v[j] = v[j] - mean;
        } else {
#pragma unroll
            for (int j = 0; j < 16; ++j) v[j] = (f32x4){0.f, 0.f, 0.f, 0.f};
#pragma unroll 1
            for (int sp = 0; sp < 8; ++sp) { const f32x4* xr = (const f32x4*)(part + ((size_t)sp * TS + (row - TP)) * DM) + F.lane; f32x4 t[16];
#pragma unroll
                for (int j = 0; j < 16; ++j) t[j] = xr[64 * j];
                __builtin_amdgcn_sched_barrier(0);
#pragma unroll
                for (int j = 0; j < 16; ++j) v[j] += t[j]; }
            float s = 0.f;
#pragma unroll
            for (int j = 0; j < 16; ++j) s += (v[j][0] + v[j][1]) + (v[j][2] + v[j][3]);
            mean = wave_sum(s) * (1.0f / DM); float s2 = 0.f;
#pragma unroll
            for (int j = 0; j < 16; ++j) { v[j] = v[j] - mean; s2 += (v[j][0] * v[j][0] + v[j][1] * v[j][1]) + (v[j][2] * v[j][2] + v[j][3] * v[j][3]); }
            rstd = 1.0f / sqrtf(wave_sum(s2) * (1.0f / DM) + LN_EPS); }
        float* drow = row < TP ? (dstA ? dstA + (size_t)row * DM : nullptr) : dstB + (size_t)(row - TP) * DM;
        if (lnst && row < TP && F.lane == 0) { lnst[(size_t)row * 2] = mean; lnst[(size_t)row * 2 + 1] = rstd; }
        const bool wb = dstb && (row >= TP || ((row >> 8) & 15) == 15);
#pragma unroll
        for (int j = 0; j < 16; ++j) { const int cc = 4 * F.lane + 256 * j; const f32x4 gg = gl[F.lane + 64 * j], bb = bl[F.lane + 64 * j]; const f32x4 o = v[j] * rstd * gg + bb;
            if (drow) { if (dstq) *(f32x4*)(drow + cc) = o; else st_nt((f32x4*)(drow + cc), o); }
            if (wb) { u32x2 w; w.x = pk_bf16(o[0], o[1]); w.y = pk_bf16(o[2], o[3]); *(u32x2*)(dstb + (size_t)row * DM + cc) = w; }
            if (dstq) {
                *(unsigned*)(dstq + (size_t)row * DM + cc) = pk_fp8x4(o[0] * FP8_SA_X1, o[1] * FP8_SA_X1, o[2] * FP8_SA_X1, o[3] * FP8_SA_X1); } }
    }
}

DI void phase_conv31(const Frame& F, const Params& p) {
    unsigned char* ws = p.ws;
    const bf16_t* ub = (const bf16_t*)(ws + WS_U); bf16_t* cb = (bf16_t*)(ws + WS_C); float* stats = (float*)(ws + WS_STATS);
    LAS bf16_t* T = (LAS bf16_t*)F.lds;
    float w[31][2]; float2 bv = make_float2(0.f, 0.f); bool wloaded = false; int wcq = -1;
    for (int it = F.vcu; it < (TT / 32) * 4; it += F.G) { const int item = (TT / 32) * 4 - 1 - it;
        const int tt = item >> 2, cq = item & 3, cbase = cq * 1024, ch = cbase + 2 * F.tid, tok0 = tt * 32;
        const bool samp = tok0 >= TP; const int t0 = samp ? 0 : (tok0 & 4095), bsm = samp ? ((tok0 - TP) >> 5) : 0;
        __syncthreads();
#pragma unroll
        for (int k0 = 0; k0 < 16; k0 += 8) { u32x4 v[8];
#pragma unroll
            for (int k = 0; k < 8; ++k) { const int i = F.tid + (k0 + k) * NTHR, row = i >> 7, c8 = (i & 127) * 8; v[k] = (u32x4){0u, 0u, 0u, 0u};
                if (row < 62 && (row >= 30 || t0 > 0)) v[k] = *(const u32x4*)(ub + (size_t)(tok0 - 30 + row) * DM + cbase + c8); }
            __builtin_amdgcn_sched_barrier(0);
#pragma unroll
            for (int k = 0; k < 8; ++k) { const int i = F.tid + (k0 + k) * NTHR, row = i >> 7, c8 = (i & 127) * 8;
                if (row < 62) *(LAS u32x4*)(T + row * 1024 + c8) = v[k]; } }
        if (samp)
            for (int i = F.tid; i < 30 * 128; i += NTHR) { const int row = i >> 7, c8 = (i & 127) * 8; u32x4 v;
                const float* hp = p.st_cconv + (size_t)(bsm * 30 + row) * DM + cbase + c8; const f32x4 h0 = *(const f32x4*)hp, h1 = *(const f32x4*)(hp + 4);
                v.x = pk_bf16(h0[0], h0[1]); v.y = pk_bf16(h0[2], h0[3]); v.z = pk_bf16(h1[0], h1[1]); v.w = pk_bf16(h1[2], h1[3]);
                *(LAS u32x4*)(T + row * 1024 + c8) = v; }
        __syncthreads();
        if (!wloaded || cq != wcq) { wloaded = true; wcq = cq;
#pragma unroll
            for (int j = 0; j < 31; ++j) { const float2 wv = *(const float2*)(p.w_dw + (size_t)j * DM + ch); w[j][0] = wv.x; w[j][1] = wv.y; }
            bv = *(const float2*)(p.b_dw + ch); }
        float sv[64];
#pragma unroll
        for (int tq = 0; tq < 4; ++tq) {
            float x[38][2];
#pragma unroll
            for (int i = 0; i < 38; ++i) { const unsigned raw = *(const LAS unsigned*)(T + (8 * tq + i) * 1024 + 2 * F.tid); x[i][0] = bf_lo(raw); x[i][1] = bf_hi(raw); }
#pragma unroll
            for (int o = 0; o < 8; ++o) { float a0 = bv.x, a1 = bv.y;
#pragma unroll
                for (int j = 0; j < 31; ++j) { a0 += w[j][0] * x[o + j][0]; a1 += w[j][1] * x[o + j][1]; }
                const int tok = tok0 + 8 * tq + o;
                *(unsigned*)(cb + (size_t)tok * DM + ch) = pk_bf16(a0, a1);
                sv[8 * tq + o] = a0 + a1; sv[32 + 8 * tq + o] = a0 * a0 + a1 * a1; }
        }
#pragma unroll
        for (int st = 0; st < 6; ++st) { const int off = 32 >> st, n2 = 32 >> st; const bool up = (F.lane & off) != 0;
#pragma unroll
            for (int i = 0; i < n2; ++i) { const float keep = up ? sv[i + n2] : sv[i], send = up ? sv[i] : sv[i + n2]; sv[i] = keep + __shfl_xor(send, off); } }
        if (!F.dry) atomicAdd(stats + (size_t)(tok0 + (F.lane & 31)) * 2 + (F.lane >> 5), sv[0]);
    }
    __syncthreads();
    const size_t gt = (size_t)F.vcu * NTHR + F.tid, NT = (size_t)F.G * NTHR;
    for (size_t i = gt; i < (size_t)(4 + 16) * 30 * (DM / 8); i += NT) { const int c8 = (int)(i & 511) * 8, ri = (int)(i >> 9), sq = ri / 30, k = ri - sq * 30;
        size_t tok; float* dst;
        if (sq < 4) { tok = (size_t)sq * 4096 + 4066 + k; dst = p.out + O_PCC + (size_t)(sq * 30 + k) * DM + c8; }
        else { const int b = sq - 4; tok = (size_t)TP + b * 32 + 2 + k; dst = p.out + O_SCC + (size_t)(b * 30 + k) * DM + c8; }
        float f[8]; unpack8(*(const u32x4*)(ub + tok * DM + c8), f);
        *(f32x4*)dst = (f32x4){f[0], f[1], f[2], f[3]}; *(f32x4*)(dst + 4) = (f32x4){f[4], f[5], f[6], f[7]}; }
}

DI void phase_norm2(const Frame& F, const Params& p) {
    unsigned char* ws = p.ws;
    const bf16_t* __restrict__ cb = (const bf16_t*)(ws + WS_C); const bf16_t* __restrict__ szg = (const bf16_t*)(ws + WS_SZG); const float* __restrict__ stats = (const float*)(ws + WS_STATS);
    unsigned char* __restrict__ pre2 = ws + WS_PRE2;
    const size_t gt = (size_t)F.vcu * NTHR + F.tid, NT = (size_t)F.G * NTHR, NI = (size_t)TT * (DM / 8);
    if ((NT & 511) != 0) return;
    const int c8 = (int)(gt & 511) * 8;
    const f32x4 g0 = *(const f32x4*)(p.cln_g + c8), g1 = *(const f32x4*)(p.cln_g + c8 + 4), b0 = *(const f32x4*)(p.cln_b + c8), b1 = *(const f32x4*)(p.cln_b + c8 + 4);
    u32x4 ncc[4], ncz[4]; float ns1[4], ns2[4];
#pragma unroll
    for (int u = 0; u < 4; ++u) { ncc[u] = (u32x4){0u, 0u, 0u, 0u}; ncz[u] = (u32x4){0u, 0u, 0u, 0u}; ns1[u] = 0.f; ns2[u] = 0.f; }
#define N2_LOAD(i0_) do { _Pragma("unroll") for (int u = 0; u < 4; ++u) { const size_t i = (i0_) + (size_t)u * NT; if (i < NI) { const size_t tok_ = i >> 9; \
        ncc[u] = *(const u32x4*)(cb + tok_ * DM + c8); ncz[u] = *(const u32x4*)(szg + tok_ * DM + c8); ns1[u] = stats[tok_ * 2]; ns2[u] = stats[tok_ * 2 + 1]; } } } while (0)
    N2_LOAD(gt);
    u32x2 res[4]; size_t pi0 = NI;
#pragma unroll
    for (int u = 0; u < 4; ++u) res[u] = (u32x2){0u, 0u};
    for (size_t i0 = gt; ; i0 += 4 * NT) {
        u32x4 cc[4], cz[4]; float s1[4], s2[4];
#pragma unroll
        for (int u = 0; u < 4; ++u) { cc[u] = ncc[u]; cz[u] = ncz[u]; s1[u] = ns1[u]; s2[u] = ns2[u]; }
        if (pi0 < NI) {
#pragma unroll
            for (int u = 0; u < 4; ++u) { const size_t i = pi0 + (size_t)u * NT; if (i < NI) *(u32x2*)(pre2 + (i >> 9) * DM + c8) = res[u]; } }
        if (i0 >= NI) break;
        N2_LOAD(i0 + 4 * NT);
#pragma unroll
        for (int u = 0; u < 4; ++u) { const size_t i = i0 + (size_t)u * NT; if (i < NI) {
            const float mean = s1[u] * (1.0f / DM), var = fmaxf(s2[u] * (1.0f / DM) - mean * mean, 0.f), rstd = 1.0f / sqrtf(var + LN_EPS);
            float c[8], z[8], o[8]; unpack8(cc[u], c); unpack8(cz[u], z);
#pragma unroll
            for (int k = 0; k < 4; ++k) { o[k] = fsilu((c[k] - mean) * rstd * g0[k] + b0[k]) * z[k]; o[4 + k] = fsilu((c[4 + k] - mean) * rstd * g1[k] + b1[k]) * z[4 + k]; }
            u32x2 w8; w8.x = pk_fp8x4(o[0] * FP8_SA_PRE2, o[1] * FP8_SA_PRE2, o[2] * FP8_SA_PRE2, o[3] * FP8_SA_PRE2); w8.y = pk_fp8x4(o[4] * FP8_SA_PRE2, o[5] * FP8_SA_PRE2, o[6] * FP8_SA_PRE2, o[7] * FP8_SA_PRE2);
            res[u] = w8; } }
        pi0 = i0;
    }
#undef N2_LOAD
}

constexpr int N_PHASES = 16;
constexpr int LDS_BYTES = 147456;
constexpr int MISC_OFF = 131072;

__global__ void __launch_bounds__(NTHR, 2) mlstm_conformer_fwd(Params p) {
    extern __shared__ __attribute__((aligned(16))) unsigned char lds_raw[];
    Frame F; F.lds = (LAS unsigned char*)lds_raw; F.wave = __builtin_amdgcn_readfirstlane((int)threadIdx.x >> 6); F.lane = lane_id(); F.tid = F.wave * 64 + F.lane;
    F.G = gridDim.x; F.bx = blockIdx.x; F.vcu = (F.G % 8 == 0) ? (F.bx % 8) * (F.G / 8) + F.bx / 8 : F.bx;
    volatile LAS unsigned* MISC = (volatile LAS unsigned*)(F.lds + MISC_OFF);
    if (F.tid < 64) MISC[F.tid] = 0u;
    __syncthreads();
    unsigned char* ws = p.ws;
#if MK_LAUNCHES == 1
    XcdBarrier bar = xcd_barrier_post((unsigned*)(ws + WS_BAR), MISC + 8, F.wave);
#define GRID_BAR() xcd_barrier(bar)
#else
#define GRID_BAR() do { } while (0)
#endif
    const int lo = p.ph_lo, hi = p.ph_hi;
#ifndef PHMASK
#define PHMASK 0xFFFF
#endif
#define IN(k) (((PHMASK >> (k)) & 1) && lo <= (k) && (k) < hi)
#define SEAM(k) do { if (IN(k) && IN((k) + 1)) GRID_BAR(); } while (0)
    LAS unsigned char* ring = F.lds;

#ifndef P5PARTS
#define P5PARTS 7
#endif
#ifndef REPMASK
#define REPMASK 0
#endif
#define NREP(k) ((((REPMASK) >> (k)) & 1) + 1)
#define RUN(k, ...) do { if (IN(k)) { _Pragma("unroll") for (int rep = 0; rep < NREP(k); ++rep) { F.dry = rep; { int t_ = F.wave * 64 + lane_id(); asm volatile("" : "+v"(t_)); F.tid = t_; F.lane = t_ & 63; } __VA_ARGS__; if (rep + 1 < NREP(k)) GRID_BAR(); } } SEAM(k); } while (0)
    F.dry = 0;
    RUN(0, phase_prologue(F, p));
    RUN(1, {
        const bool side_first = ((F.bx & 7) & 1) != 0;
        if (side_first) { transpose_weight_fp8(F, p.w_down, INNER, DM, ws + WS_WDOWN, FP8_SB_W); __syncthreads(); }
        { g8::DenseSched S; S.init(ws + WS_XQ, ws + WS_WZQ, TT, INNER, DM, F.G, (F.G == 256) ? ((F.bx + 192) & 255) : F.bx); S.wave = F.wave;
          if (F.G == 256) { S.rag_r0 = 7; S.rag_w1 = 192; S.rag_w2 = 128; }
          EpiUp E{(bf16_t*)(ws + WS_SZ), 1, 1.0f / (FP8_SA_X * FP8_SB_WZ)};
          g8::gemm_phase<EpiUp, g8::DenseSched, false, true>(ring, DM, DM, S, E); }
        { g8::DenseSched S; S.init(ws + WS_XB, ws + WS_WUP, TT, INNER, DM * 2, F.G, F.bx); S.wave = F.wave;
          EpiUp E{(bf16_t*)(ws + WS_XM), 0, 1.0f};
          g8::gemm_phase<EpiUp, g8::DenseSched, false, false>(ring, DM * 2, DM * 2, S, E); }
        if (!side_first) transpose_weight_fp8(F, p.w_down, INNER, DM, ws + WS_WDOWN, FP8_SB_W); });
    RUN(2, phase_passA(F, p));
    RUN(3, { for (int it = F.vcu; it < 32; it += F.G) scan_prompt(F, p, it); });
    RUN(4, { for (int it = F.G - 1 - F.vcu; it < 128; it += F.G) sample_prep(F, p, it);
             phase_passB(F, p); });
    RUN(5, {
        const bool cell_first = ((F.bx & 7) & 1) != 0;
        if ((P5PARTS & 4) && cell_first) _Pragma("unroll") for (int r2 = 0; r2 < NREP(18); ++r2) phase_sample_cell(F, p);
        if (P5PARTS & 1) _Pragma("unroll") for (int r2 = 0; r2 < NREP(16); ++r2) {
          { SchedS S{(const char*)(ws + WS_QP), (const char*)(ws + WS_XA), F.G, F.vcu, 0, F.wave};
            EpiS E{(bf16_t*)(ws + WS_S), (const float*)(ws + WS_CS), (const float*)(ws + WS_MX), (float*)(ws + WS_DEN), F.dry | r2, 1.0f, 0};
            g8::gemm_phase<EpiS, SchedS, false, false>(ring, INNER * 2, INNER * 2, S, E); }
          { SchedS S{(const char*)p.out + O8_Q8, (const char*)p.out + O8_XA8, F.G, (F.G == 256) ? ((F.vcu + 32) & 255) : F.vcu, 1, F.wave};
            EpiS E{(bf16_t*)(ws + WS_S), (const float*)(ws + WS_CS), (const float*)(ws + WS_MX), (float*)(ws + WS_DEN), F.dry | r2, 1.0f, 1};
            g8::gemm_phase<EpiS, SchedS, false, true>(ring, INNER, INNER, S, E, 0x75757575  , 0x7b7b7b7b  ); } }
        if (P5PARTS & 2) _Pragma("unroll") for (int r2 = 0; r2 < NREP(17); ++r2) { SchedState S{(const char*)(ws + WS_KWT), (const char*)(ws + WS_VT), F.G, F.vcu, F.wave};
          EpiState E{p.out + O_PC};
          g8::gemm_phase<EpiState, SchedState, false>(ring, TPP * 2, TPP * 2, S, E); }
        if ((P5PARTS & 4) && !cell_first) _Pragma("unroll") for (int r2 = 0; r2 < NREP(18); ++r2) phase_sample_cell(F, p); });
    RUN(6, {
        SchedSV S{(const char*)(ws + WS_S8), (const char*)(ws + WS_S16), (const char*)(ws + WS_VT8), (const char*)(ws + WS_VT), F.G, F.vcu, F.wave};
        EpiSV E{(bf16_t*)(ws + WS_H), (const float*)(ws + WS_DEN), (const float*)(ws + WS_EM)};
        g8::gemm_phase_mixed<EpiSV, SchedSV>(ring, P8, TPP * 2, S, E, 0x7b7b7b7b  , 0x79797979  ); });
    RUN(7, phase_predown(F, p));
    RUN(8, {
        const bool side_first = ((F.bx & 7) & 1) != 0;
        if (side_first) { transpose_weight(F, p.w_cin, DM, 3 * DM, (bf16_t*)(ws + WS_WCIN), true, ws + WS_WCINQ, FP8_SB_WCIN); transpose_weight_fp8(F, p.w_cout, DM, DM, ws + WS_WCOUT, FP8_SB_W); __syncthreads(); }
        g8::DenseSched S; S.init(ws + WS_PRE, ws + WS_WDOWN, TT, DM, INNER, F.G, F.bx, TP / 256, 8); S.wave = F.wave;
        EpiRes E{p.x_prompt, p.x_sample, nullptr, (bf16_t*)(ws + WS_R), (float*)(ws + WS_PART), 1.0f / (FP8_SA_PRE * FP8_SB_W), (float*)(ws + WS_RST0), nullptr, nullptr, nullptr, nullptr};
        g8::gemm_phase<EpiRes, g8::DenseSched, false, true>(ring, INNER, INNER, S, E);
        if (!side_first) { transpose_weight(F, p.w_cin, DM, 3 * DM, (bf16_t*)(ws + WS_WCIN), true, ws + WS_WCINQ, FP8_SB_WCIN); transpose_weight_fp8(F, p.w_cout, DM, DM, ws + WS_WCOUT, FP8_SB_W); } });
    RUN(9, {
        ln_rows(F, (const bf16_t*)(ws + WS_R), (const float*)(ws + WS_RST0), (const float*)(ws + WS_PART), p.pln_g, p.pln_b, nullptr, (float*)(ws + WS_X1F), (bf16_t*)(ws + WS_X1B), ws + WS_X1Q, (float*)(ws + WS_LNST));
        });
    RUN(10, {
        { g8::DenseSched S; if (F.G == 256) S.init(ws + WS_X1B, ws + WS_WCIN, 6 * 256, 3 * DM, DM * 2, 144, F.bx < 144 ? F.bx : 100000); else S.init(ws + WS_X1B, ws + WS_WCIN, 6 * 256, 3 * DM, DM * 2, F.G, F.bx);
          S.wave = F.wave; S.pmode = 2;
          EpiCin E{(bf16_t*)(ws + WS_U), (bf16_t*)(ws + WS_SZG), p.b_cin, 1.0f};
          g8::gemm_phase<EpiCin, g8::DenseSched, false, false>(ring, DM * 2, DM * 2, S, E); }
        { g8::DenseSched S; S.init(ws + WS_X1Q, ws + WS_WCINQ, 60 * 256, 3 * DM, DM, F.G, (F.G == 256) ? ((F.bx + 112) & 255) : F.bx); S.wave = F.wave; S.pmode = 1;
          if (F.G == 256) { S.rag_r0 = 10; S.rag_w1 = 112; S.rag_w2 = 112; S.rag_w3 = 96; }
          EpiCin E{(bf16_t*)(ws + WS_U), (bf16_t*)(ws + WS_SZG), p.b_cin, 1.0f / (FP8_SA_X1 * FP8_SB_WCIN)};
          g8::gemm_phase<EpiCin, g8::DenseSched, false, true>(ring, DM, DM, S, E); } });
    RUN(11, phase_conv31(F, p));
    RUN(12, phase_norm2(F, p));
    RUN(13, {
        g8::DenseSched S; S.init(ws + WS_PRE2, ws + WS_WCOUT, TT, DM, DM, F.G, F.bx, TP / 256, 8); S.wave = F.wave;
        EpiRes E{nullptr, (const float*)(ws + WS_X1F), p.b_cout, (bf16_t*)(ws + WS_R2), (float*)(ws + WS_PART), 1.0f / (FP8_SA_PRE2 * FP8_SB_W), (float*)(ws + WS_RST1), (const bf16_t*)(ws + WS_R), (const float*)(ws + WS_LNST), p.pln_g, p.pln_b};
        g8::gemm_phase<EpiRes, g8::DenseSched, false, true>(ring, DM, DM, S, E); });
    RUN(14, ln_rows(F, (const bf16_t*)(ws + WS_R2), (const float*)(ws + WS_RST1), (const float*)(ws + WS_PART), p.pln_g + DM, p.pln_b + DM, p.out + O_YP, p.out + O_YS, nullptr, nullptr, nullptr));
#undef RUN
#undef NREP
#undef IN
#undef SEAM
}

extern "C" void kernel_launch(void* const* d_in, const int* in_sizes, int n_in, void* d_out, int out_size, void* d_ws, size_t ws_size, hipStream_t stream) {
    static int grid = 0;
    if (grid == 0) {
        if (n_in != 28 || (size_t)out_size != O_END || ws_size < WS_END) { fprintf(stderr, "kernel_launch: unexpected shapes (n_in %d, out %d, ws %zu); nothing launched\n", n_in, out_size, ws_size); grid = -1; return; }
        int dev = 0, cus = 0;
        if (hipGetDevice(&dev) != hipSuccess || hipDeviceGetAttribute(&cus, hipDeviceAttributeMultiprocessorCount, dev) != hipSuccess) { grid = -1; return; }
        if (hipFuncSetAttribute((const void*)mlstm_conformer_fwd, hipFuncAttributeMaxDynamicSharedMemorySize, LDS_BYTES) != hipSuccess) { fprintf(stderr, "kernel_launch: hipFuncSetAttribute failed\n"); grid = -1; return; }
        int per_cu = 0;
        if (hipOccupancyMaxActiveBlocksPerMultiprocessor(&per_cu, (const void*)mlstm_conformer_fwd, NTHR, LDS_BYTES) != hipSuccess || per_cu < 1) { fprintf(stderr, "kernel_launch: occupancy query says %d\n", per_cu); }
        (void)hipGetLastError();
        grid = cus;
    }
    if (grid < 0) return;
    (void)hipMemsetAsync((char*)d_ws, 0, WS_GATES, stream);
    Params p{};
    const float** pf = (const float**)&p;
    for (int i = 0; i < 28; ++i) pf[i] = (const float*)d_in[i];
    p.out = (float*)d_out; p.ws = (unsigned char*)d_ws;
#if MK_LAUNCHES == 1
    p.ph_lo = 0; p.ph_hi = N_PHASES;
    hipLaunchKernelGGL(mlstm_conformer_fwd, dim3(grid), dim3(NTHR), LDS_BYTES, stream, p);
#else
    for (int k = 0; k < 15; ++k) { p.ph_lo = k; p.ph_hi = k + 1; hipLaunchKernelGGL(mlstm_conformer_fwd, dim3(grid), dim3(NTHR), LDS_BYTES, stream, p); }
#endif
}
```

```cpp
#include <hip/hip_runtime.h>
#include <cstdio>
#include <cstdint>

#ifndef MK_LAUNCHES
#define MK_LAUNCHES 1
#endif

#define LAS __attribute__((address_space(3)))
typedef unsigned short bf16_t;
typedef short bf16x8 __attribute__((ext_vector_type(8)));
typedef float f32x4 __attribute__((ext_vector_type(4)));
typedef float f32x16 __attribute__((ext_vector_type(16)));
typedef unsigned u32x4 __attribute__((ext_vector_type(4)));
typedef unsigned u32x2 __attribute__((ext_vector_type(2)));
#define DI __device__ __forceinline__

constexpr int DM = 4096, INNER = 8192, NH = 8, DKV = 1024;
constexpr int TPP = 16384 + 64;
constexpr int TP = 16384, TS = 512, TT = TP + TS;
constexpr float ALPHA = 1.41421356237309515f, LN_EPS = 1e-5f;
constexpr int NWAVES = 8, NTHR = 512;

constexpr size_t O_YP = 0, O_YS = 67108864, O_PC = 69206016, O_PN = 102760448, O_PM = 102793216, O_PMC = 102793248, O_PCC = 102891552,
                 O_SC = 103383072, O_SN = 237600800, O_SM = 237731872, O_SMC = 237732000, O_SCC = 238125216, O_END = 240091296;

constexpr size_t MiB = 1u << 20;
constexpr size_t O8_Q8 = 0, O8_XA8 = (size_t)TP * INNER;
constexpr size_t WS_BAR = 0;
constexpr size_t WS_GATES = 64 * 1024;
constexpr size_t WS_DEN = WS_GATES + (size_t)TT * 16 * 4;
constexpr size_t WS_STATS = WS_DEN + (size_t)TP * 8 * 4;
constexpr size_t WS_RST0 = WS_STATS + (size_t)TT * 2 * 4, WS_RST1 = WS_RST0 + (size_t)TP * 2 * 4;
constexpr size_t WS_ZERO_BYTES = 3 * MiB;
static_assert(WS_RST1 + (size_t)TP * 2 * 4 <= WS_ZERO_BYTES, "zero region");
constexpr size_t WS_CS = 3 * MiB, WS_MX = WS_CS + 512 * 1024, WS_EM = WS_MX + 512 * 1024;
constexpr size_t WS_MXL = WS_EM + 512 * 1024;
constexpr size_t WS_GT = 5 * MiB;
constexpr size_t WS_WDOWN = 8 * MiB;
constexpr size_t WS_SZ = 72 * MiB;
constexpr size_t WS_XA = 336 * MiB;
constexpr size_t WS_QP = 600 * MiB;
constexpr size_t WS_KWT = 856 * MiB;
constexpr size_t WS_VT = 1113 * MiB;
constexpr size_t WS_XM = 1370 * MiB;
constexpr size_t WS_XB = 600 * MiB, WS_WUP = 732 * MiB, WS_H = 600 * MiB, WS_PRE = 864 * MiB, WS_S = 1370 * MiB, WS_R = 1392 * MiB;
constexpr size_t WS_WCIN = 1656 * MiB, WS_WCOUT = 1752 * MiB, WS_X1F = 72 * MiB, WS_X1B = 336 * MiB, WS_U = 468 * MiB, WS_SZG = 600 * MiB, WS_C = 732 * MiB,
                 WS_PRE2 = 864 * MiB, WS_R2 = 1128 * MiB;
constexpr size_t WS_XQ = 864 * MiB, WS_WZQ = 930 * MiB;
constexpr size_t WS_X1Q = 996 * MiB, WS_WCINQ = 1062 * MiB;
constexpr size_t WS_LNST = 88 * MiB;
constexpr size_t WS_PART = 1784 * MiB;
constexpr size_t WS_S8 = 1370 * MiB, WS_S16 = 1580 * MiB, WS_VT8 = 1704 * MiB;
constexpr size_t S8_BH = (size_t)105 * 65536, S16_BH = (size_t)31 * 131072;
constexpr int P8 = 16384 + 128;
constexpr size_t WS_SMALL = 1914 * MiB;
constexpr size_t WS_SSP = WS_SMALL;
constexpr size_t WS_SQT = WS_SMALL + 1 * MiB;
constexpr size_t WS_SWK = WS_SMALL + 9 * MiB;
constexpr size_t WS_SVT = WS_SMALL + 17 * MiB;
constexpr size_t WS_HS = WS_SMALL + 25 * MiB;
constexpr size_t WS_END = WS_SMALL + 33 * MiB;
static_assert(WS_S + 544 * MiB <= WS_SMALL && WS_END <= 2048 * MiB, "ws map");

typedef __bf16 bf16v2_t __attribute__((ext_vector_type(2)));
typedef float f32v2_t __attribute__((ext_vector_type(2)));
DI unsigned pk_bf16(float lo, float hi) { const f32v2_t f = {lo, hi}; const bf16v2_t t = __builtin_convertvector(f, bf16v2_t); return __builtin_bit_cast(unsigned, t); }
DI float bf_lo(unsigned u) { return __uint_as_float(u << 16); }
DI float bf_hi(unsigned u) { return __uint_as_float(u & 0xffff0000u); }
DI float bf1(bf16_t b) { return __uint_as_float((unsigned)b << 16); }
DI bf16_t f2bf(float f) { return (bf16_t)(pk_bf16(f, 0.f) & 0xffffu); }
DI void unpack8(const u32x4 v, float (&f)[8]) { f[0] = bf_lo(v.x); f[1] = bf_hi(v.x); f[2] = bf_lo(v.y); f[3] = bf_hi(v.y); f[4] = bf_lo(v.z); f[5] = bf_hi(v.z); f[6] = bf_lo(v.w); f[7] = bf_hi(v.w); }
DI u32x4 pack8(const float (&f)[8]) { u32x4 v; v.x = pk_bf16(f[0], f[1]); v.y = pk_bf16(f[2], f[3]); v.z = pk_bf16(f[4], f[5]); v.w = pk_bf16(f[6], f[7]); return v; }
constexpr float FP8_SA_PRE = 8.0f, FP8_SA_PRE2 = 16.0f, FP8_SB_W = 4096.0f, FP8_SA_X1 = 16.0f, FP8_SB_WCIN = 1024.0f, FP8_SA_X = 16.0f, FP8_SB_WZ = 1024.0f, FP8_SA_Q = 1024.0f, FP8_SA_XA = 16.0f, FP8_SA_S = 64.0f, FP8_SA_V = 16.0f;
DI unsigned pk_fp8x4(float a, float b, float c, float d) {
    a = fminf(fmaxf(a, -448.f), 448.f); b = fminf(fmaxf(b, -448.f), 448.f); c = fminf(fmaxf(c, -448.f), 448.f); d = fminf(fmaxf(d, -448.f), 448.f);
    int r = 0; r = __builtin_amdgcn_cvt_pk_fp8_f32(a, b, r, false); r = __builtin_amdgcn_cvt_pk_fp8_f32(c, d, r, true); return (unsigned)r; }
DI float fexp(float x) { return __builtin_amdgcn_exp2f(x * 1.44269504088896341f); }
DI float frcp(float x) { return __builtin_amdgcn_rcpf(x); }
DI float fsilu(float x) { return x * frcp(1.0f + fexp(-x)); }
DI float fsigm(float x) { return frcp(1.0f + fexp(-x)); }
DI float logsig(float x) { return fminf(x, 0.f) - log1pf(expf(-fabsf(x))); }
#define LDS_BARRIER() do { asm volatile("s_waitcnt lgkmcnt(0)" ::: "memory"); __builtin_amdgcn_s_barrier(); asm volatile("" ::: "memory"); } while (0)
DI int lane_id() { int l; asm volatile("v_mbcnt_lo_u32_b32 %0, -1, 0\n\tv_mbcnt_hi_u32_b32 %0, -1, %0" : "=v"(l)); return l; }
template <class T> DI T ld_nt(const T* p) { return __builtin_nontemporal_load(p); }
template <class T> DI void st_nt(T* p, const T v) { __builtin_nontemporal_store(v, p); }
DI float wave_sum(float v) {
#pragma unroll
    for (int o = 1; o < 64; o <<= 1) v += __shfl_xor(v, o);
    return v;
}

#define XB_TMO      128
#define XB_XCNT(j)  (256  + 64 * (j))
#define XB_XSUB(j)  (1280 + 64 * (j))
#define XB_XGEN(j)  (2304 + 64 * (j))
#define XB_TOP      3328
#define XB_TOPGEN   3392
#define XCD_BAR_WORDS 3456
#define XB_SPIN_CAP (1u << 22)
__device__ __forceinline__ unsigned xb_ld(unsigned* p)              { return __hip_atomic_load(p, __ATOMIC_RELAXED, __HIP_MEMORY_SCOPE_AGENT); }
__device__ __forceinline__ unsigned xb_add(unsigned* p, unsigned v) { return __hip_atomic_fetch_add(p, v, __ATOMIC_RELAXED, __HIP_MEMORY_SCOPE_AGENT); }
__device__ __forceinline__ unsigned xb_xcc_id() { return (unsigned)__builtin_amdgcn_s_getreg((3 << 11) | 20) & 0xFu; }
#define XB_SPIN(cond, bar) do { unsigned _sp = 0; while (cond) { __builtin_amdgcn_s_sleep(1); \
    if ((++_sp & 255u) == 0u) { if (xb_ld(&(bar)[XB_TMO])) break; if (_sp > XB_SPIN_CAP) { atomicAdd(&(bar)[XB_TMO], 1u); break; } } } } while (0)
struct XcdBarrier { unsigned* bar; unsigned x; volatile LAS unsigned* st; int wave; };
__device__ __forceinline__ XcdBarrier xcd_barrier_post(unsigned* bar, volatile LAS unsigned* st, int wave) {
    XcdBarrier b; b.bar = bar; b.x = xb_xcc_id(); b.st = st; b.wave = wave;
    if (wave == 0 && lane_id() == 0) (void)xb_add(&bar[XB_XCNT(b.x)], 1u);
    return b;
}
__device__ __forceinline__ void xcd_barrier_complete(unsigned* bar, unsigned x, unsigned& nloc, unsigned& nx) {
    const unsigned G = gridDim.x * gridDim.y * gridDim.z;
    unsigned sum, cnt, mine, sp = 0u;
    for (;;) {
        sum = 0u; cnt = 0u; mine = 0u;
#pragma unroll
        for (unsigned j = 0; j < 16; ++j) { const unsigned c = xb_ld(&bar[XB_XCNT(j)]); sum += c; cnt += (c > 0u) ? 1u : 0u; mine = (j == x) ? c : mine; }
        if (sum == G) break;
        __builtin_amdgcn_s_sleep(1);
        if ((++sp & 255u) == 0u) { if (xb_ld(&bar[XB_TMO])) break; if (sp > XB_SPIN_CAP) { atomicAdd(&bar[XB_TMO], 1u); break; } }
    }
    nloc = mine > 0u ? mine : 1u; nx = cnt > 0u ? cnt : 1u;
}
__device__ __forceinline__ void xcd_barrier(const XcdBarrier& b) {
    asm volatile("s_waitcnt vmcnt(0)" ::: "memory");
    __syncthreads();
    if (b.wave == 0 && lane_id() == 0) {
        unsigned* bar = b.bar;
        __builtin_amdgcn_s_waitcnt(0);
        unsigned nloc = b.st[0], nx = b.st[1];
        if (nloc == 0u) { xcd_barrier_complete(bar, b.x, nloc, nx); b.st[0] = nloc; b.st[1] = nx; }
        const unsigned old = xb_add(&bar[XB_XSUB(b.x)], 1u);
        const unsigned gen = old / nloc;
        if (old + 1u == (gen + 1u) * nloc) {
            __builtin_amdgcn_fence(__ATOMIC_RELEASE, "agent");
            asm volatile("s_waitcnt vmcnt(0)" ::: "memory");
            const unsigned og = xb_add(&bar[XB_TOP], 1u);
            const unsigned tg = og / nx;
            if (og + 1u == (tg + 1u) * nx) xb_add(&bar[XB_TOPGEN], 1u);
            else XB_SPIN(xb_ld(&bar[XB_TOPGEN]) == tg, bar);
            __builtin_amdgcn_fence(__ATOMIC_ACQUIRE, "agent");
            xb_add(&bar[XB_XGEN(b.x)], 1u);
            asm volatile("s_waitcnt vmcnt(0)" ::: "memory");
        } else {
            XB_SPIN(xb_ld(&bar[XB_XGEN(b.x)]) == gen, bar);
            __builtin_amdgcn_fence(__ATOMIC_ACQUIRE, "agent");
            asm volatile("s_waitcnt vmcnt(0)" ::: "memory");
        }
    }
    __syncthreads();
}

namespace g8 {
constexpr int BM = 256, BK = 64, HALF = 128, HTB = HALF * BK * 2, STAGE_BYTES = 8 * HTB, NXCD = 8, WGM = 8;
__host__ __device__ __forceinline__ int lds_byte(int r, int c) { const int st = (r >> 4) * 2 + (c >> 5), rr = r & 15, cc = c & 31, ob = rr * 64 + cc * 2; return st * 1024 + (ob ^ (((ob >> 9) & 1) << 5)); }
__host__ __device__ __forceinline__ void stage_rc(int b, int& R, int& C) { const int st = b / 1024, sb = b % 1024, swz = sb ^ (((sb >> 9) & 1) << 5); R = (st >> 1) * 16 + swz / 64; C = (st & 1) * 32 + (swz % 64) / 2; }
__host__ __device__ __forceinline__ int perm32(int rho) { const int n = rho >> 4, i = rho & 15; return 8 * (i >> 2) + 4 * n + (i & 3); }

typedef int i32x8 __attribute__((ext_vector_type(8)));
DI i32x8 cat8(const bf16x8 lo, const bf16x8 hi) { const u32x4 a = __builtin_bit_cast(u32x4, lo), b = __builtin_bit_cast(u32x4, hi); i32x8 r; r[0] = (int)a.x; r[1] = (int)a.y; r[2] = (int)a.z; r[3] = (int)a.w; r[4] = (int)b.x; r[5] = (int)b.y; r[6] = (int)b.z; r[7] = (int)b.w; return r; }
struct GUnit { const char* A; const char* B; int nt; int i0, i1, i2; };

struct DenseSched {
    int wave;
    const char* A; const char* B; size_t tstepA, tstepB; int nM, nN, nMf, ksp, G, c, nt, pmode;
    DI void init(const void* A_, const void* B_, int M, int N, int Kbytes, int G_, int c_, int nMfull = -1, int ksp_ = 0) { A = (const char*)A_; B = (const char*)B_; tstepA = (size_t)BM * Kbytes; tstepB = (size_t)BM * Kbytes; nM = M / BM; nN = N / BM;
        nMf = nMfull < 0 ? nM : nMfull; ksp = ksp_; G = G_; c = c_; nt = Kbytes / 128; pmode = 0; }
    int rag_r0 = -1, rag_w1 = 0, rag_w2 = 0, rag_w3 = 0;
    DI bool next(int i, GUnit& u) const {
        long L = (long)i * G + c; const int nwg = nMf * nN;
        if (rag_r0 >= 0 && i >= rag_r0) { if (i == rag_r0) { if (c >= rag_w1) return false; } else if (i == rag_r0 + 1) { if (c >= rag_w2) return false; L = (long)rag_r0 * G + rag_w1 + c; }
            else if (i == rag_r0 + 2) { if (c >= rag_w3) return false; L = (long)rag_r0 * G + rag_w1 + rag_w2 + c; } else return false; }
        if (L >= nwg) {
            if (!ksp) return false;
            const int L2 = (int)(L - nwg); if (L2 >= (nM - nMf) * nN * ksp) return false;
            const int sp = L2 % ksp, uu = L2 / ksp, pm = nMf + uu / nN, pn = uu % nN, ntu = nt / ksp;
            u.A = A + (size_t)pm * tstepA + (size_t)sp * ntu * 128; u.B = B + (size_t)pn * tstepB + (size_t)sp * ntu * 128; u.nt = ntu; u.i0 = 1 + sp; u.i1 = pm; u.i2 = pn; return true; }
        int wgid = (int)L; { const int q = nwg / NXCD, r = nwg % NXCD, xcd = wgid % NXCD, off = wgid / NXCD; wgid = (xcd < r ? xcd * (q + 1) : r * (q + 1) + (xcd - r) * q) + off; }
        const int nig = WGM * nN, gid = wgid / nig, fm = gid * WGM, gsz = (nMf - fm) < WGM ? (nMf - fm) : WGM;
        int pm = fm + ((wgid % nig) % gsz); const int pn = (wgid % nig) / gsz;
        if (pmode == 1) pm += pm / 15; else if (pmode == 2) pm = pm < 4 ? 16 * pm + 15 : 60 + pm;
        u.A = A + (size_t)pm * tstepA; u.B = B + (size_t)pn * tstepB; u.nt = nt; u.i0 = 0; u.i1 = pm; u.i2 = pn; return true;
    }
};

template <class Epi, class Sched, bool ATILED, bool FP8 = false>
__device__ __forceinline__ void gemm_phase(LAS unsigned char* lds, const unsigned ldaB, const unsigned ldbB, const Sched& S, const Epi& E, const int fp8_scale_a = 0x7f7f7f7f, const int fp8_scale_b = 0x7f7f7f7f) {
    const int wid = __builtin_amdgcn_readfirstlane(S.wave);
    int tid = wid * 64 + lane_id(); asm volatile("" : "+v"(tid));
    const int lane = tid & 63, wr = wid >> 2, wc = wid & 3, fr = lane & 15, fq = lane >> 4;
    unsigned voffA[2], voffB[2];
#pragma unroll
    for (int i = 0; i < 2; ++i) { int R, C; stage_rc(tid * 16 + i * 8192, R, C); const int Rb = Epi::PERM ? ((R & ~31) + perm32(R & 31)) : R;
        voffA[i] = (unsigned)R * ldaB + (unsigned)C * 2u; voffB[i] = (unsigned)Rb * ldbB + (unsigned)C * 2u; }
    const size_t kstep = (size_t)(BK * 2);
    const size_t hstepA = (size_t)HALF * ldaB, hstepB = (size_t)HALF * ldbB;
    const unsigned ldsw = (unsigned)wid * 1024u;
    const int aoff = lds_byte(wr * 64 + fr, fq * 8), boff = lds_byte(wc * 32 + fr, fq * 8);
#define G8_KA(p, kt) (ATILED ? ((p) + (size_t)((kt) >> 2) * 131072u + (size_t)((kt) & 3) * 128u) : ((p) + (size_t)(kt) * 128u))
#define G8_SA(b, h) (((b) * 2 + (h)) * HTB)
#define G8_SB(b, h) ((4 + (b) * 2 + (h)) * HTB)
#define G8_STAGE(bufoff, gbase, voff) do { _Pragma("unroll") for (int _i = 0; _i < 2; ++_i) \
        __builtin_amdgcn_global_load_lds((const unsigned*)((const char*)(gbase) + (voff)[_i]), (LAS unsigned*)(lds + (bufoff) + ldsw + _i * 8192), 16, 0, 0); } while (0)
#define G8_RDA(b, h, m, k) (*(const LAS bf16x8*)(lds + G8_SA(b, h) + aoff + (m) * 2048 + (k) * 1024))
#define G8_RDB(b, h, n, k) (*(const LAS bf16x8*)(lds + G8_SB(b, h) + boff + (n) * 2048 + (k) * 1024))
#define G8_LDA(dst, b, h) do { _Pragma("unroll") for (int m = 0; m < 4; ++m) { if constexpr (FP8) dst##8[m] = cat8(G8_RDA(b, h, m, 0), G8_RDA(b, h, m, 1)); else { dst[m][0] = G8_RDA(b, h, m, 0); dst[m][1] = G8_RDA(b, h, m, 1); } } } while (0)
#define G8_LDB(dst, b, h) do { _Pragma("unroll") for (int n = 0; n < 2; ++n) { if constexpr (FP8) dst##8[n] = cat8(G8_RDB(b, h, n, 0), G8_RDB(b, h, n, 1)); else { dst[n][0] = G8_RDB(b, h, n, 0); dst[n][1] = G8_RDB(b, h, n, 1); } } } while (0)
#define G8_MMA(ai, bj, At, Bt) do { __builtin_amdgcn_s_setprio(1); _Pragma("unroll") for (int m = 0; m < 4; ++m) _Pragma("unroll") for (int n = 0; n < 2; ++n) { \
        if constexpr (FP8) { asm volatile("v_mfma_scale_f32_16x16x128_f8f6f4 %0, %1, %2, %0, %3, %4 op_sel_hi:[0,0,0]" : "+v"(acc[ai][bj][m][n]) : "v"(Bt##8[n]), "v"(At##8[m]), "v"(fp8_sb_v), "v"(fp8_sa_v)); } \
        else { _Pragma("unroll") for (int k = 0; k < 2; ++k) acc[ai][bj][m][n] = __builtin_amdgcn_mfma_f32_16x16x32_bf16(Bt[n][k], At[m][k], acc[ai][bj][m][n], 0, 0, 0); } } \
        __builtin_amdgcn_s_setprio(0); } while (0)
#define G8_WAIT_V(n) asm volatile("s_waitcnt vmcnt(" #n ")" ::: "memory")
#define G8_WAIT_L(n) asm volatile("s_waitcnt lgkmcnt(" #n ")" ::: "memory")
#define G8_BAR __builtin_amdgcn_s_barrier()
#define G8_SCHED __builtin_amdgcn_sched_barrier(0)
    GUnit cur, nxt; int ui = 0;
    if (!S.next(0, cur)) return;
    f32x4 acc[2][2][4][2];
#pragma unroll
    for (int a = 0; a < 2; ++a)
#pragma unroll
        for (int b = 0; b < 2; ++b)
#pragma unroll
            for (int m = 0; m < 4; ++m)
#pragma unroll
                for (int n = 0; n < 2; ++n) acc[a][b][m][n] = (f32x4){0.f, 0.f, 0.f, 0.f};
    const int fp8_sb_v = fp8_scale_b, fp8_sa_v = fp8_scale_a;
    bf16x8 At[4][2], B0[2][2], B1[2][2]; i32x8 At8[4], B08[2], B18[2];
    const char* cA = cur.A; const char* cB = cur.B;
    G8_STAGE(G8_SB(0, 0), cB, voffB); G8_STAGE(G8_SB(0, 1), cB + hstepB, voffB); G8_STAGE(G8_SA(0, 0), cA, voffA); G8_STAGE(G8_SA(0, 1), cA + hstepA, voffA);
    if (wr == 1) G8_BAR;
    G8_WAIT_V(2); G8_BAR;
    G8_STAGE(G8_SB(1, 0), cB + kstep, voffB); G8_STAGE(G8_SA(1, 0), G8_KA(cA, 1), voffA); G8_STAGE(G8_SB(1, 1), cB + hstepB + kstep, voffB);
    G8_WAIT_V(6); G8_BAR;
    for (;;) {
        const bool has_next = S.next(ui + 1, nxt);
        const char* nA = has_next ? nxt.A : cA; const char* nB = has_next ? nxt.B : cB;
        const int nt = cur.nt;
        for (int t = 0; t < nt; t += 2) {
            const bool last = (t == nt - 2);
            const char* a1 = G8_KA(cA, t + 1);
            const char* a2 = last ? nA : G8_KA(cA, t + 2); const char* b2 = last ? nB : cB + (size_t)(t + 2) * kstep;
            const char* a3 = a2 + kstep; const char* b3 = b2 + kstep;
            G8_LDB(B0, 0, 0); G8_LDB(B1, 0, 1); G8_SCHED; G8_LDA(At, 0, 0); G8_STAGE(G8_SA(1, 1), a1 + hstepA, voffA);
            G8_WAIT_V(8); G8_WAIT_L(0); G8_BAR; G8_MMA(0, 0, At, B0); G8_MMA(0, 1, At, B1); G8_BAR; G8_SCHED;
            G8_LDA(At, 0, 1); G8_STAGE(G8_SB(0, 0), b2, voffB); G8_STAGE(G8_SB(0, 1), b2 + hstepB, voffB); G8_STAGE(G8_SA(0, 0), a2, voffA);
            G8_WAIT_V(8); G8_WAIT_L(0); G8_BAR; G8_MMA(1, 0, At, B0); G8_MMA(1, 1, At, B1); G8_BAR; G8_SCHED;
            G8_LDB(B0, 1, 0); G8_LDB(B1, 1, 1); G8_SCHED; G8_LDA(At, 1, 0); G8_STAGE(G8_SA(0, 1), a2 + hstepA, voffA);
            G8_WAIT_V(8); G8_WAIT_L(0); G8_BAR; G8_MMA(0, 0, At, B0); G8_MMA(0, 1, At, B1); G8_BAR; G8_SCHED;
            G8_LDA(At, 1, 1); G8_STAGE(G8_SB(1, 0), b3, voffB); G8_STAGE(G8_SB(1, 1), b3 + hstepB, voffB); G8_STAGE(G8_SA(1, 0), a3, voffA);
            G8_WAIT_V(8); G8_WAIT_L(0); G8_BAR; G8_MMA(1, 0, At, B0); G8_MMA(1, 1, At, B1); G8_BAR; G8_SCHED;
        }
        if constexpr (FP8) asm volatile("s_nop 15\n\ts_nop 15\n\ts_nop 15" ::: "memory");
        if (wr == 0) G8_BAR;
        E(acc, cur, wr, wc, fr, fq);
        if (!has_next) break;
#pragma unroll
        for (int a = 0; a < 2; ++a)
#pragma unroll
            for (int b = 0; b < 2; ++b)
#pragma unroll
                for (int m = 0; m < 4; ++m)
#pragma unroll
                    for (int n = 0; n < 2; ++n) acc[a][b][m][n] = (f32x4){0.f, 0.f, 0.f, 0.f};
        cur = nxt; cA = nA; cB = nB; ++ui;
        if (wr == 1) G8_BAR;
    }
    G8_WAIT_V(0);
    G8_BAR;
#undef G8_KA
#undef G8_SA
#undef G8_SB
#undef G8_STAGE
#undef G8_LDA
#undef G8_RDA
#undef G8_RDB
#undef G8_LDB
#undef G8_MMA
#undef G8_WAIT_V
#undef G8_WAIT_L
#undef G8_BAR
#undef G8_SCHED
}

struct GUnitM { const char* A8; const char* B8; const char* A16; const char* B16; int nt8, nt; int i0, i1, i2; };
typedef int i32x4 __attribute__((ext_vector_type(4)));
template <class Epi, class Sched>
__device__ __forceinline__ void gemm_phase_mixed(LAS unsigned char* lds, const unsigned ldb8, const unsigned ldb16, const Sched& S, const Epi& E, const int scale_b8, const int scale_a8) {
    const int wid = __builtin_amdgcn_readfirstlane(S.wave);
    int tid = wid * 64 + lane_id(); asm volatile("" : "+v"(tid));
    const int lane = tid & 63, wr = wid >> 2, wc = wid & 3, fr = lane & 15, fq = lane >> 4;
    unsigned voffA8[2], rowB[2];
#pragma unroll
    for (int i = 0; i < 2; ++i) { int R, C; stage_rc(tid * 16 + i * 8192, R, C); const int Rb = Epi::PERM ? ((R & ~31) + perm32(R & 31)) : R;
        voffA8[i] = (unsigned)R * 256u + (unsigned)C * 2u; rowB[i] = (unsigned)Rb; }
#define GM_VA(is8, i) ((is8) ? voffA8[i] : voffA8[i] + (voffA8[i] & ~255u))
#define GM_VB(is8, i) (rowB[i] * ((is8) ? ldb8 : ldb16) + (voffA8[i] & 255u))
    const unsigned ldsw = (unsigned)wid * 1024u;
    const int aoff = lds_byte(wr * 64 + fr, fq * 8), boff = lds_byte(wc * 32 + fr, fq * 8);
#define GM_SA(b, h) (((b) * 2 + (h)) * HTB)
#define GM_SB(b, h) ((4 + (b) * 2 + (h)) * HTB)
#define GM_PA(u, kt) ((kt) < (u).nt8 ? (u).A8 + (size_t)((kt) >> 1) * 65536u + (size_t)((kt) & 1) * 128u : (u).A16 + (size_t)(((kt) - (u).nt8) >> 2) * 131072u + (size_t)(((kt) - (u).nt8) & 3) * 128u)
#define GM_PB(u, kt) ((kt) < (u).nt8 ? (u).B8 + (size_t)(kt) * 128u : (u).B16 + (size_t)((kt) - (u).nt8) * 128u)
#define GM_STAGE_A(bufoff, gbase, is8, half) do { const char* _g = (gbase) + ((half) ? ((is8) ? 32768u : 65536u) : 0u); _Pragma("unroll") for (int _i = 0; _i < 2; ++_i) \
        __builtin_amdgcn_global_load_lds((const unsigned*)(_g + GM_VA(is8, _i)), (LAS unsigned*)(lds + (bufoff) + ldsw + _i * 8192), 16, 0, 0); } while (0)
#define GM_STAGE_B(bufoff, gbase, is8, half) do { const char* _g = (gbase) + ((half) ? (size_t)HALF * ((is8) ? ldb8 : ldb16) : (size_t)0); _Pragma("unroll") for (int _i = 0; _i < 2; ++_i) \
        __builtin_amdgcn_global_load_lds((const unsigned*)(_g + GM_VB(is8, _i)), (LAS unsigned*)(lds + (bufoff) + ldsw + _i * 8192), 16, 0, 0); } while (0)
#define GM_RDA(b, h, m, k) (*(const LAS bf16x8*)(lds + GM_SA(b, h) + aoff + (m) * 2048 + (k) * 1024))
#define GM_RDB(b, h, n, k) (*(const LAS bf16x8*)(lds + GM_SB(b, h) + boff + (n) * 2048 + (k) * 1024))
#define GM_LDA8(b, h) do { _Pragma("unroll") for (int m = 0; m < 4; ++m) At8[m] = cat8(GM_RDA(b, h, m, 0), GM_RDA(b, h, m, 1)); } while (0)
#define GM_LDB8(dst, b, h) do { _Pragma("unroll") for (int n = 0; n < 2; ++n) dst##8[n] = cat8(GM_RDB(b, h, n, 0), GM_RDB(b, h, n, 1)); } while (0)
#define GM_LDA16(b, h) do { _Pragma("unroll") for (int m = 0; m < 4; ++m) { At[m][0] = GM_RDA(b, h, m, 0); At[m][1] = GM_RDA(b, h, m, 1); } } while (0)
#define GM_LDB16(dst, b, h) do { _Pragma("unroll") for (int n = 0; n < 2; ++n) { dst[n][0] = GM_RDB(b, h, n, 0); dst[n][1] = GM_RDB(b, h, n, 1); } } while (0)
#define GM_MMA8(ai, bj, Bt) do { __builtin_amdgcn_s_setprio(1); _Pragma("unroll") for (int m = 0; m < 4; ++m) _Pragma("unroll") for (int n = 0; n < 2; ++n) \
        asm volatile("v_mfma_scale_f32_16x16x128_f8f6f4 %0, %1, %2, %0, %3, %4 op_sel_hi:[0,0,0]" : "+v"(acc[ai][bj][m][n]) : "v"(Bt##8[n]), "v"(At8[m]), "v"(sb8_v), "v"(sa8_v)); \
        __builtin_amdgcn_s_setprio(0); } while (0)
#define GM_MMA16(ai, bj, Bt) do { __builtin_amdgcn_s_setprio(1); _Pragma("unroll") for (int m = 0; m < 4; ++m) _Pragma("unroll") for (int n = 0; n < 2; ++n) _Pragma("unroll") for (int k = 0; k < 2; ++k) \
        acc[ai][bj][m][n] = __builtin_amdgcn_mfma_f32_16x16x32_bf16(Bt[n][k], At[m][k], acc[ai][bj][m][n], 0, 0, 0); __builtin_amdgcn_s_setprio(0); } while (0)
#define GM_TRIP(LDA_, LDB_, MMA_, c8_) do { \
            const bool last = (t == nt - 2); \
            const char* a1 = GM_PA(cur, t) + 128; \
            bool n8; const char* a2; const char* b2; \
            if (!last) { n8 = (t + 2) < cur.nt8; a2 = GM_PA(cur, t + 2); b2 = GM_PB(cur, t + 2); } \
            else if (has_next) { n8 = 0 < nxt.nt8; a2 = GM_PA(nxt, 0); b2 = GM_PB(nxt, 0); } \
            else { n8 = 0 < cur.nt8; a2 = GM_PA(cur, 0); b2 = GM_PB(cur, 0); } \
            const char* a3 = a2 + 128; const char* b3 = b2 + 128; \
            LDB_(B0, 0, 0); LDB_(B1, 0, 1); GM_SCHED; LDA_(0, 0); GM_STAGE_A(GM_SA(1, 1), a1, c8_, 1); \
            GM_WAIT_V(8); GM_WAIT_L(0); GM_BAR; MMA_(0, 0, B0); MMA_(0, 1, B1); GM_BAR; GM_SCHED; \
            LDA_(0, 1); GM_STAGE_B(GM_SB(0, 0), b2, n8, 0); GM_STAGE_B(GM_SB(0, 1), b2, n8, 1); GM_STAGE_A(GM_SA(0, 0), a2, n8, 0); \
            GM_WAIT_V(8); GM_WAIT_L(0); GM_BAR; MMA_(1, 0, B0); MMA_(1, 1, B1); GM_BAR; GM_SCHED; \
            LDB_(B0, 1, 0); LDB_(B1, 1, 1); GM_SCHED; LDA_(1, 0); GM_STAGE_A(GM_SA(0, 1), a2, n8, 1); \
            GM_WAIT_V(8); GM_WAIT_L(0); GM_BAR; MMA_(0, 0, B0); MMA_(0, 1, B1); GM_BAR; GM_SCHED; \
            LDA_(1, 1); GM_STAGE_B(GM_SB(1, 0), b3, n8, 0); GM_STAGE_B(GM_SB(1, 1), b3, n8, 1); GM_STAGE_A(GM_SA(1, 0), a3, n8, 0); \
            GM_WAIT_V(8); GM_WAIT_L(0); GM_BAR; MMA_(1, 0, B0); MMA_(1, 1, B1); GM_BAR; GM_SCHED; } while (0)
#define GM_WAIT_V(n) asm volatile("s_waitcnt vmcnt(" #n ")" ::: "memory")
#define GM_WAIT_L(n) asm volatile("s_waitcnt lgkmcnt(" #n ")" ::: "memory")
#define GM_BAR __builtin_amdgcn_s_barrier()
#define GM_SCHED __builtin_amdgcn_sched_barrier(0)
    GUnitM cur, nxt; int ui = 0;
    if (!S.next(0, cur)) return;
    f32x4 acc[2][2][4][2];
#pragma unroll
    for (int a = 0; a < 2; ++a)
#pragma unroll
        for (int b = 0; b < 2; ++b)
#pragma unroll
            for (int m = 0; m < 4; ++m)
#pragma unroll
                for (int n = 0; n < 2; ++n) acc[a][b][m][n] = (f32x4){0.f, 0.f, 0.f, 0.f};
    const int sb8_v = scale_b8, sa8_v = scale_a8;
    i32x8 At8[4], B08[2], B18[2]; bf16x8 At[4][2], B0[2][2], B1[2][2];
    { const bool p8 = 0 < cur.nt8; const char* a0 = GM_PA(cur, 0); const char* b0 = GM_PB(cur, 0);
      GM_STAGE_B(GM_SB(0, 0), b0, p8, 0); GM_STAGE_B(GM_SB(0, 1), b0, p8, 1); GM_STAGE_A(GM_SA(0, 0), a0, p8, 0); GM_STAGE_A(GM_SA(0, 1), a0, p8, 1);
      if (wr == 1) GM_BAR;
      GM_WAIT_V(2); GM_BAR;
      GM_STAGE_B(GM_SB(1, 0), b0 + 128, p8, 0); GM_STAGE_A(GM_SA(1, 0), a0 + 128, p8, 0); GM_STAGE_B(GM_SB(1, 1), b0 + 128, p8, 1);
      GM_WAIT_V(6); GM_BAR; }
    for (;;) {
        const bool has_next = S.next(ui + 1, nxt);
        const int nt = cur.nt, nt8 = cur.nt8;
        for (int t = 0; t < nt8; t += 2) GM_TRIP(GM_LDA8, GM_LDB8, GM_MMA8, true);
        for (int t = nt8; t < nt; t += 2) GM_TRIP(GM_LDA16, GM_LDB16, GM_MMA16, false);
        asm volatile("s_nop 15\n\ts_nop 15\n\ts_nop 15" ::: "memory");
        if (wr == 0) GM_BAR;
        { int tz = lane_id(); asm volatile("" : "+v"(tz));
          const int ln = tz & 63; E(acc, cur, wr, wc, ln & 15, ln >> 4); }
        if (!has_next) break;
#pragma unroll
        for (int a = 0; a < 2; ++a)
#pragma unroll
            for (int b = 0; b < 2; ++b)
#pragma unroll
                for (int m = 0; m < 4; ++m)
#pragma unroll
                    for (int n = 0; n < 2; ++n) acc[a][b][m][n] = (f32x4){0.f, 0.f, 0.f, 0.f};
        cur = nxt; ++ui;
        if (wr == 1) GM_BAR;
    }
    GM_WAIT_V(0);
    GM_BAR;
#undef GM_VA
#undef GM_VB
#undef GM_SA
#undef GM_SB
#undef GM_PA
#undef GM_PB
#undef GM_STAGE_A
#undef GM_STAGE_B
#undef GM_RDA
#undef GM_RDB
#undef GM_LDA8
#undef GM_LDB8
#undef GM_LDA16
#undef GM_LDB16
#undef GM_MMA8
#undef GM_MMA16
#undef GM_TRIP
#undef GM_WAIT_V
#undef GM_WAIT_L
#undef GM_BAR
#undef GM_SCHED
}
}
using g8::GUnit;
using g8::GUnitM;
using g8::HALF;

struct Params {
    const float *x_prompt, *x_sample, *st_C, *st_n, *st_m, *st_mconv, *st_cconv;
    const float *w_up, *w_mconv, *b_mconv, *w_q, *w_k, *w_v, *w_gate, *b_gate, *mh_gain, *skip, *w_down;
    const float *w_cin, *b_cin, *w_dw, *b_dw, *cln_g, *cln_b, *w_cout, *b_cout, *pln_g, *pln_b;
    float* out; unsigned char* ws; int ph_lo, ph_hi;
};
struct Frame { LAS unsigned char* lds; int tid, lane, wave, G, bx, vcu, dry; };

struct EpiUp {
    static constexpr bool PERM = true;
    bf16_t* base; int act; float sc;
    DI void operator()(const f32x4 (&acc)[2][2][4][2], const GUnit& u, int wr, int wc, int fr, int fq) const {
        const int row0 = u.i1 * 256 + wr * 64 + fr, col0 = u.i2 * 256 + wc * 32 + 8 * fq;
#pragma unroll
        for (int ai = 0; ai < 2; ++ai)
#pragma unroll
            for (int m = 0; m < 4; ++m) { bf16_t* rowp = base + (size_t)(row0 + ai * HALF + m * 16) * INNER + col0;
#pragma unroll
                for (int bj = 0; bj < 2; ++bj) { f32x4 v0 = acc[ai][bj][m][0], v1 = acc[ai][bj][m][1];
                    if (act) {
#pragma unroll
                        for (int j = 0; j < 4; ++j) { v0[j] = fsilu(v0[j] * sc); v1[j] = fsilu(v1[j] * sc); } }
                    u32x4 w; w.x = pk_bf16(v0[0], v0[1]); w.y = pk_bf16(v0[2], v0[3]); w.z = pk_bf16(v1[0], v1[1]); w.w = pk_bf16(v1[2], v1[3]);
                    *(u32x4*)(rowp + bj * HALF) = w; } }
    }
};
struct EpiS {
    static constexpr bool PERM = true;
    bf16_t* Sb; const float* cs; const float* mx; float* den; int dry; float sc; int far;
    DI void operator()(const f32x4 (&acc)[2][2][4][2], const GUnit& u, int wr, int wc, int fr, int fq) const {
        const int bh = u.i0, pm = u.i1, pn = u.i2;
        bf16_t* tile = (bf16_t*)((unsigned char*)Sb + WS_S16 - WS_S + (size_t)bh * S16_BH + (size_t)(pm + pn) * 131072);
        unsigned char* tile8 = (unsigned char*)Sb + (size_t)bh * S8_BH + (size_t)((pm - 2) * (pm - 1) / 2 + pn) * 65536;
        const float* csb = cs + bh * 4096 + pn * 256; const float* mxb = mx + bh * 4096 + pm * 256; float* denb = den + bh * 4096 + pm * 256;
        const bool diag = (pm == pn);
        f32x4 cv[2][2];
#pragma unroll
        for (int bj = 0; bj < 2; ++bj)
#pragma unroll
            for (int n = 0; n < 2; ++n) cv[bj][n] = *(const f32x4*)(csb + bj * HALF + wc * 32 + 8 * fq + 4 * n);
#pragma unroll
        for (int ai = 0; ai < 2; ++ai)
#pragma unroll
            for (int m = 0; m < 4; ++m) { const int rloc = ai * HALF + wr * 64 + m * 16 + fr; const float mxt = mxb[rloc]; float rs = 0.f;
                const int rowlim = diag ? rloc - (wc * 32 + 8 * fq) : 0x10000;
#pragma unroll
                for (int bj = 0; bj < 2; ++bj) { f32x4 v[2];
#pragma unroll
                    for (int n = 0; n < 2; ++n) { v[n] = acc[ai][bj][m][n];
#pragma unroll
                        for (int j = 0; j < 4; ++j) { const bool masked = (bj * HALF + 4 * n + j) > rowlim;
                            const float d = masked ? 0.f : fexp(cv[bj][n][j] - mxt) * sc; v[n][j] *= d; rs += v[n][j]; } }
                    if (far) { u32x2 w8; w8.x = pk_fp8x4(v[0][0] * FP8_SA_S, v[0][1] * FP8_SA_S, v[0][2] * FP8_SA_S, v[0][3] * FP8_SA_S); w8.y = pk_fp8x4(v[1][0] * FP8_SA_S, v[1][1] * FP8_SA_S, v[1][2] * FP8_SA_S, v[1][3] * FP8_SA_S);
                        *(u32x2*)(tile8 + (size_t)rloc * 256 + bj * HALF + wc * 32 + 8 * fq) = w8; }
                    else { u32x4 w; w.x = pk_bf16(v[0][0], v[0][1]); w.y = pk_bf16(v[0][2], v[0][3]); w.z = pk_bf16(v[1][0], v[1][1]); w.w = pk_bf16(v[1][2], v[1][3]);
                        *(u32x4*)(tile + (size_t)rloc * 256 + bj * HALF + wc * 32 + 8 * fq) = w; } }
                rs += __shfl_xor(rs, 16); rs += __shfl_xor(rs, 32);
                if (fq == 0 && !dry) atomicAdd(denb + rloc, rs); }
    }
};
struct EpiState {
    static constexpr bool PERM = false;
    float* C;
    DI void operator()(const f32x4 (&acc)[2][2][4][2], const GUnit& u, int wr, int wc, int fr, int fq) const {
        float* base = C + ((size_t)u.i0 << 20);
        const int row0 = u.i1 * 256 + wr * 64 + fr, col0 = u.i2 * 256 + wc * 32 + 4 * fq;
#pragma unroll
        for (int ai = 0; ai < 2; ++ai)
#pragma unroll
            for (int m = 0; m < 4; ++m) { float* rowp = base + (size_t)(row0 + ai * HALF + m * 16) * 1024 + col0;
#pragma unroll
                for (int bj = 0; bj < 2; ++bj)
#pragma unroll
                    for (int n = 0; n < 2; ++n) st_nt((f32x4*)(rowp + bj * HALF + n * 16), acc[ai][bj][m][n]); }
    }
};
struct EpiSV {
    static constexpr bool PERM = true;
    bf16_t* hb; const float* den; const float* em;
    template <class U> DI void operator()(const f32x4 (&acc)[2][2][4][2], const U& u, int wr, int wc, int fr, int fq) const {
        const int bh = u.i0, pm = u.i1, pn = u.i2, b = bh >> 3, h = bh & 7;
        const float* denb = den + bh * 4096 + pm * 256; const float* emb = em + bh * 4096 + pm * 256;
        bf16_t* base = hb + (size_t)(b * 4096 + pm * 256) * INNER + h * 1024 + pn * 256 + wc * 32 + 8 * fq;
        float dn[2][4], ee[2][4];
#pragma unroll
        for (int ai = 0; ai < 2; ++ai)
#pragma unroll
            for (int m = 0; m < 4; ++m) { const int rloc = ai * HALF + wr * 64 + m * 16 + fr; dn[ai][m] = denb[rloc]; ee[ai][m] = emb[rloc]; }
        __builtin_amdgcn_sched_barrier(0);
#pragma unroll
        for (int ai = 0; ai < 2; ++ai)
#pragma unroll
            for (int m = 0; m < 4; ++m) { const int rloc = ai * HALF + wr * 64 + m * 16 + fr; const float g = 1.0f / fmaxf(fabsf(dn[ai][m]), ee[ai][m]);
#pragma unroll
                for (int bj = 0; bj < 2; ++bj) { const f32x4 v0 = acc[ai][bj][m][0] * g, v1 = acc[ai][bj][m][1] * g;
                    u32x4 w; w.x = pk_bf16(v0[0], v0[1]); w.y = pk_bf16(v0[2], v0[3]); w.z = pk_bf16(v1[0], v1[1]); w.w = pk_bf16(v1[2], v1[3]);
                    *(u32x4*)(base + (size_t)rloc * INNER + bj * HALF) = w; } }
    }
};
struct EpiRes {
    static constexpr bool PERM = true;
    const float* resA; const float* resB; const float* bias; bf16_t* r; float* part; float sc;
    float* rstat;
    const bf16_t* resLn; const float* lnst; const float* lng; const float* lnb;
    DI void operator()(const f32x4 (&acc)[2][2][4][2], const GUnit& u, int wr, int wc, int fr, int fq) const {
        const int pm = u.i1, row0 = pm * 256 + wr * 64 + fr, col0 = u.i2 * 256 + wc * 32 + 8 * fq;
        f32x4 bv[2][2];
#pragma unroll
        for (int bj = 0; bj < 2; ++bj)
#pragma unroll
            for (int n = 0; n < 2; ++n) bv[bj][n] = bias ? *(const f32x4*)(bias + col0 + bj * HALF + n * 4) : (f32x4){0.f, 0.f, 0.f, 0.f};
        if (u.i0 == 0) {
            f32x4 lg[2][2], lb[2][2];
            if (resLn) {
#pragma unroll
                for (int bj = 0; bj < 2; ++bj)
#pragma unroll
                    for (int n = 0; n < 2; ++n) { lg[bj][n] = *(const f32x4*)(lng + col0 + bj * HALF + n * 4); lb[bj][n] = *(const f32x4*)(lnb + col0 + bj * HALF + n * 4); }
                __builtin_amdgcn_sched_barrier(0);
#pragma unroll
                for (int bj = 0; bj < 2; ++bj)
#pragma unroll
                    for (int n = 0; n < 2; ++n) { lg[bj][n] = lg[bj][n] * ALPHA; lb[bj][n] = lb[bj][n] * ALPHA + bv[bj][n]; } }
#define ER_FINISH(xr_) do { f32x4 v[2]; \
                    _Pragma("unroll") for (int n = 0; n < 2; ++n) { v[n] = (xr_)[n] + acc[ai][bj][m][n] * sc; \
                        s1 += (v[n][0] + v[n][1]) + (v[n][2] + v[n][3]); s2 += (v[n][0] * v[n][0] + v[n][1] * v[n][1]) + (v[n][2] * v[n][2] + v[n][3] * v[n][3]); } \
                    u32x4 w; w.x = pk_bf16(v[0][0], v[0][1]); w.y = pk_bf16(v[0][2], v[0][3]); w.z = pk_bf16(v[1][0], v[1][1]); w.w = pk_bf16(v[1][2], v[1][3]); \
                    *(u32x4*)(r + ro + bj * HALF) = w; } while (0)
#define ER_STATS() do { s1 += __shfl_xor(s1, 16); s1 += __shfl_xor(s1, 32); s2 += __shfl_xor(s2, 16); s2 += __shfl_xor(s2, 32); \
                    if (fq == 0) { atomicAdd(rstat + (size_t)row * 2, s1); atomicAdd(rstat + (size_t)row * 2 + 1, s2); } } while (0)
#pragma unroll
        for (int ai = 0; ai < 2; ++ai) {
            if (resLn) {
                u32x4 rw[4][2]; float mn[4], rs[4];
#pragma unroll
                for (int m = 0; m < 4; ++m) { const int row = row0 + ai * HALF + m * 16; const size_t ro = (size_t)row * DM + col0;
                    mn[m] = lnst[(size_t)row * 2]; rs[m] = lnst[(size_t)row * 2 + 1];
#pragma unroll
                    for (int bj = 0; bj < 2; ++bj) rw[m][bj] = ld_nt((const u32x4*)(resLn + ro + bj * HALF)); }
                __builtin_amdgcn_sched_barrier(0);
#pragma unroll
                for (int m = 0; m < 4; ++m) { const int row = row0 + ai * HALF + m * 16; const size_t ro = (size_t)row * DM + col0; const float mean = mn[m], rstd = rs[m];
                    float s1 = 0.f, s2 = 0.f;
#pragma unroll
                    for (int bj = 0; bj < 2; ++bj) { const u32x4 q = rw[m][bj]; f32x4 xr[2];
                        xr[0] = ((f32x4){bf_lo(q.x), bf_hi(q.x), bf_lo(q.y), bf_hi(q.y)} - mean) * rstd * lg[bj][0] + lb[bj][0]; xr[1] = ((f32x4){bf_lo(q.z), bf_hi(q.z), bf_lo(q.w), bf_hi(q.w)} - mean) * rstd * lg[bj][1] + lb[bj][1];
                        ER_FINISH(xr); }
                    ER_STATS(); }
            } else {
#pragma unroll
              for (int mh = 0; mh < 4; mh += 2) {
                f32x4 xq[2][2][2];
#pragma unroll
                for (int m = mh; m < mh + 2; ++m) { const size_t ro = (size_t)(row0 + ai * HALF + m * 16) * DM + col0;
#pragma unroll
                    for (int bj = 0; bj < 2; ++bj) { xq[m - mh][bj][0] = ld_nt((const f32x4*)(resA + ro + bj * HALF)); xq[m - mh][bj][1] = ld_nt((const f32x4*)(resA + ro + bj * HALF + 4)); } }
                __builtin_amdgcn_sched_barrier(0);
#pragma unroll
                for (int m = mh; m < mh + 2; ++m) { const int row = row0 + ai * HALF + m * 16; const size_t ro = (size_t)row * DM + col0;
                    float s1 = 0.f, s2 = 0.f;
#pragma unroll
                    for (int bj = 0; bj < 2; ++bj) { f32x4 xr[2]; xr[0] = xq[m - mh][bj][0] * ALPHA + bv[bj][0]; xr[1] = xq[m - mh][bj][1] * ALPHA + bv[bj][1]; ER_FINISH(xr); }
                    ER_STATS(); }
              }
            }
        }
#undef ER_FINISH
#undef ER_STATS
        } else {
            const bool first = (u.i0 == 1); float* pr = part + (size_t)(u.i0 - 1) * TS * DM - (size_t)TP * DM; const float* res = resB + (size_t)(row0 - TP) * DM;
#pragma unroll
        for (int ai = 0; ai < 2; ++ai)
#pragma unroll
          for (int mh = 0; mh < 4; mh += 2) { f32x4 xq[2][2][2];
            if (first) {
#pragma unroll
                for (int m = mh; m < mh + 2; ++m) { const size_t ro = (size_t)(ai * HALF + m * 16) * DM + col0;
#pragma unroll
                    for (int bj = 0; bj < 2; ++bj)
#pragma unroll
                        for (int n = 0; n < 2; ++n) xq[m - mh][bj][n] = *(const f32x4*)(res + ro + bj * HALF + n * 4); }
                __builtin_amdgcn_sched_barrier(0); }
#pragma unroll
            for (int m = mh; m < mh + 2; ++m) { const size_t ro = (size_t)(ai * HALF + m * 16) * DM + col0; float* rowp = pr + (size_t)row0 * DM + ro;
#pragma unroll
                for (int bj = 0; bj < 2; ++bj)
#pragma unroll
                    for (int n = 0; n < 2; ++n) { f32x4 v = acc[ai][bj][m][n] * sc;
                        if (first) v += xq[m - mh][bj][n] * ALPHA + bv[bj][n];
                        *(f32x4*)(rowp + bj * HALF + n * 4) = v; } } }
        }
    }
};
struct EpiCin {
    static constexpr bool PERM = true;
    bf16_t* ub; bf16_t* szg; const float* bias; float sc;
    DI void operator()(const f32x4 (&acc)[2][2][4][2], const GUnit& u, int wr, int wc, int fr, int fq) const {
        const int pm = u.i1, pn = u.i2, row0 = pm * 256 + wr * 64 + fr;
        if (pn < 32) {
            const int ch0 = pn * 128 + wc * 32 + 8 * fq;
            f32x4 ba[2], bg[2];
#pragma unroll
            for (int n = 0; n < 2; ++n) { ba[n] = *(const f32x4*)(bias + ch0 + 4 * n); bg[n] = *(const f32x4*)(bias + 4096 + ch0 + 4 * n); }
#pragma unroll
            for (int ai = 0; ai < 2; ++ai)
#pragma unroll
                for (int m = 0; m < 4; ++m) { f32x4 o[2];
#pragma unroll
                    for (int n = 0; n < 2; ++n) { const f32x4 a = acc[ai][0][m][n] * sc + ba[n], g = acc[ai][1][m][n] * sc + bg[n];
#pragma unroll
                        for (int j = 0; j < 4; ++j) o[n][j] = a[j] * fsigm(g[j]); }
                    u32x4 w; w.x = pk_bf16(o[0][0], o[0][1]); w.y = pk_bf16(o[0][2], o[0][3]); w.z = pk_bf16(o[1][0], o[1][1]); w.w = pk_bf16(o[1][2], o[1][3]);
                    *(u32x4*)(ub + (size_t)(row0 + ai * HALF + m * 16) * DM + ch0) = w; }
        } else {
            const int ch0 = (pn - 32) * 256 + wc * 32 + 8 * fq;
            f32x4 bzz[2][2];
#pragma unroll
            for (int bj = 0; bj < 2; ++bj)
#pragma unroll
                for (int n = 0; n < 2; ++n) bzz[bj][n] = *(const f32x4*)(bias + 8192 + ch0 + bj * HALF + 4 * n);
            __builtin_amdgcn_sched_barrier(0);
#pragma unroll
            for (int bj = 0; bj < 2; ++bj) {
#pragma unroll
                for (int ai = 0; ai < 2; ++ai)
#pragma unroll
                    for (int m = 0; m < 4; ++m) { f32x4 o[2];
#pragma unroll
                        for (int n = 0; n < 2; ++n) { const f32x4 z = acc[ai][bj][m][n] * sc + bzz[bj][n];
#pragma unroll
                            for (int j = 0; j < 4; ++j) o[n][j] = fsilu(z[j]); }
                        u32x4 w; w.x = pk_bf16(o[0][0], o[0][1]); w.y = pk_bf16(o[0][2], o[0][3]); w.z = pk_bf16(o[1][0], o[1][1]); w.w = pk_bf16(o[1][2], o[1][3]);
                        *(u32x4*)(szg + (size_t)(row0 + ai * HALF + m * 16) * DM + ch0 + bj * HALF) = w; } }
        }
    }
};

struct SchedS {
    const char* qp; const char* xa; int G, c, far, wave;
    DI bool next(int i, GUnit& u) const {
        const int per = far ? 105 : 31, L = i * G + c; if (L >= 32 * per) return false;
        const int bh = L / per, rr = L - bh * per; int pm, pn;
        if (far) { int q = 0; while ((q + 1) * (q + 2) / 2 <= rr) ++q; pn = rr - q * (q + 1) / 2; pm = q + 2; }
        else if (rr < 16) { pm = rr; pn = rr; } else { pm = rr - 15; pn = rr - 16; }
        const int b = bh >> 3, h = bh & 7; const size_t es = far ? 1 : 2;
        u.A = qp + ((size_t)(b * 4096 + pm * 256) * INNER + h * 1024) * es; u.B = xa + ((size_t)(b * 4096 + pn * 256) * INNER + h * 1024) * es;
        u.nt = far ? 8 : 16; u.i0 = bh; u.i1 = pm; u.i2 = pn; return true;
    }
};
struct SchedState {
    const char* kwT; const char* vT; int G, c, wave;
    DI bool next(int i, GUnit& u) const {
        const int L = i * G + c; if (L >= 512) return false;
        const int bh = L >> 4, pm = (L >> 2) & 3, pn = L & 3, b = bh >> 3, h = bh & 7;
        u.A = kwT + ((size_t)(h * 1024 + pm * 256) * TPP + b * 4096) * 2; u.B = vT + ((size_t)(h * 1024 + pn * 256) * TPP + b * 4096) * 2;
        u.nt = 64; u.i0 = bh; u.i1 = pm; u.i2 = pn; return true;
    }
};
struct SchedSV {
    const char* S8; const char* S16; const char* vT8; const char* vT; int G, c, wave;
    DI bool next(int i, GUnitM& u) const {
        const int slot = c + G * (i >> 3); if (slot >= 256) return false;
        const int sub = i & 7, bh = slot >> 3, j = slot & 7, pn = j & 3, set = j >> 2, p = 4 * set + (sub >> 1), pm = (sub & 1) ? 15 - p : p, b = bh >> 3, h = bh & 7;
        const int pn0 = pm >= 1 ? pm - 1 : 0;
        u.nt8 = pm >= 2 ? 2 * (pm - 1) : 0; u.nt = u.nt8 + (pm >= 1 ? 8 : 4);
        u.A8 = S8 + (size_t)bh * S8_BH + (size_t)((pm - 2) * (pm - 1) / 2) * 65536; u.A16 = S16 + (size_t)bh * S16_BH + (size_t)(pm + pn0) * 131072;
        u.B8 = vT8 + (size_t)(h * 1024 + pn * 256) * P8 + b * 4096; u.B16 = vT + ((size_t)(h * 1024 + pn * 256) * TPP + b * 4096 + pn0 * 256) * 2;
        u.i0 = bh; u.i1 = pm; u.i2 = pn; return true;
    }
};

template <bool ALSO_FP8>
DI void transpose_item(const float* W, int K, int N, bf16_t* WT, int k0, int n0, int orow0, LAS float* scr, int lane, unsigned char* WQ = nullptr, float qscale = 1.f) {
    float ldv[32];
#pragma unroll
    for (int i = 0; i < 32; ++i) { const int kk = 2 * i + (lane >> 5); ldv[i] = ld_nt(W + (size_t)(k0 + kk) * N + n0 + (lane & 31)); }
    __builtin_amdgcn_sched_barrier(0);
#pragma unroll
    for (int i = 0; i < 32; ++i) { const int kk = 2 * i + (lane >> 5); scr[kk * 33 + (lane & 31)] = ldv[i]; }
    asm volatile("s_waitcnt lgkmcnt(0)" ::: "memory");
    const int c = lane & 7;
#pragma unroll
    for (int j = 0; j < 4; ++j) { const int n = (lane >> 3) + 8 * j; const LAS float* s = scr + (8 * c) * 33 + n;
        u32x4 o; o.x = pk_bf16(s[0 * 33], s[1 * 33]); o.y = pk_bf16(s[2 * 33], s[3 * 33]); o.z = pk_bf16(s[4 * 33], s[5 * 33]); o.w = pk_bf16(s[6 * 33], s[7 * 33]);
        *(u32x4*)(WT + (size_t)(orow0 + n) * K + k0 + 8 * c) = o;
        if constexpr (ALSO_FP8) { u32x2 q; q.x = pk_fp8x4(s[0 * 33] * qscale, s[1 * 33] * qscale, s[2 * 33] * qscale, s[3 * 33] * qscale); q.y = pk_fp8x4(s[4 * 33] * qscale, s[5 * 33] * qscale, s[6 * 33] * qscale, s[7 * 33] * qscale);
            *(u32x2*)(WQ + (size_t)(orow0 + n) * K + k0 + 8 * c) = q; } }
    asm volatile("s_waitcnt lgkmcnt(0)" ::: "memory");
}
DI void transpose_item_fp8(const float* W, int K, int N, unsigned char* WT, int k0, int n0, float scale, LAS float* scr, int lane) {
    float ldv[32];
#pragma unroll
    for (int i = 0; i < 32; ++i) { const int kk = 2 * i + (lane >> 5); ldv[i] = ld_nt(W + (size_t)(k0 + kk) * N + n0 + (lane & 31)); }
    __builtin_amdgcn_sched_barrier(0);
#pragma unroll
    for (int i = 0; i < 32; ++i) { const int kk = 2 * i + (lane >> 5); scr[kk * 33 + (lane & 31)] = ldv[i]; }
    asm volatile("s_waitcnt lgkmcnt(0)" ::: "memory");
    const int c = lane & 7;
#pragma unroll
    for (int j = 0; j < 4; ++j) { const int n = (lane >> 3) + 8 * j; const LAS float* s = scr + (8 * c) * 33 + n;
        u32x2 o; o.x = pk_fp8x4(s[0 * 33] * scale, s[1 * 33] * scale, s[2 * 33] * scale, s[3 * 33] * scale); o.y = pk_fp8x4(s[4 * 33] * scale, s[5 * 33] * scale, s[6 * 33] * scale, s[7 * 33] * scale);
        *(u32x2*)(WT + (size_t)(n0 + n) * K + k0 + 8 * c) = o; }
    asm volatile("s_waitcnt lgkmcnt(0)" ::: "memory");
}
DI void transpose_weight_fp8(const Frame& F, const float* W, int K, int N, unsigned char* WT, float scale) {
    LAS float* scr = (LAS float*)(F.lds + F.wave * 16384);
    const int gw = F.vcu * NWAVES + F.wave, NGW = F.G * NWAVES, nblk = N / 32, nitems = (K / 64) * nblk;
    for (int it = gw; it < nitems; it += NGW) { const int kb = it / nblk, nb = it - kb * nblk; transpose_item_fp8(W, K, N, WT, 64 * kb, 32 * nb, scale, scr, F.lane); }
}
DI void transpose_weight(const Frame& F, const float* W, int K, int N, bf16_t* WT, bool cin_map, unsigned char* WQ = nullptr, float qscale = 1.f) {
    LAS float* scr = (LAS float*)(F.lds + F.wave * 16384);
    const int gw = F.vcu * NWAVES + F.wave, NGW = F.G * NWAVES, nblk = N / 32, nitems = (K / 64) * nblk;
    for (int it = gw; it < nitems; it += NGW) { const int kb = it / nblk, nb = it - kb * nblk, n0 = 32 * nb; int orow0 = n0;
        if (cin_map) { if (n0 < 4096) orow0 = 256 * (n0 >> 7) + (n0 & 127); else if (n0 < 8192) orow0 = 256 * ((n0 - 4096) >> 7) + 128 + (n0 & 127); }
        if (cin_map) transpose_item<true>(W, K, N, WT, 64 * kb, n0, orow0, scr, F.lane, WQ, qscale); else transpose_item<false>(W, K, N, WT, 64 * kb, n0, orow0, scr, F.lane); }
}

DI void phase_prologue(const Frame& F, const Params& p) {
    unsigned char* ws = p.ws;
    { LAS float* scr = (LAS float*)(F.lds + F.wave * 16384);
      const int gw = F.vcu * NWAVES + F.wave, NGW = F.G * NWAVES, nblk = 2 * INNER / 32, nitems = (DM / 64) * nblk;
      for (int it = gw; it < nitems; it += NGW) { const int kb = it / nblk, nb = it - kb * nblk, n0 = 32 * nb;
          if (n0 < INNER) transpose_item<false>(p.w_up, DM, 2 * INNER, (bf16_t*)(ws + WS_WUP), 64 * kb, n0, n0, scr, F.lane);
          else transpose_item_fp8(p.w_up, DM, 2 * INNER, ws + WS_WZQ - (size_t)INNER * DM, 64 * kb, n0, FP8_SB_WZ, scr, F.lane); } }
    const size_t gt = (size_t)F.vcu * NTHR + F.tid, NT = (size_t)F.G * NTHR;
    bf16_t* xb = (bf16_t*)(ws + WS_XB);
    for (size_t i0 = gt; i0 < (size_t)TT * (DM / 8); i0 += 4 * NT) {
        f32x4 a[4], b[4];
#pragma unroll
        for (int u = 0; u < 4; ++u) { const size_t i = i0 + (size_t)u * NT; if (i < (size_t)TT * (DM / 8)) { const size_t tok = i >> 9; const int c8 = (int)(i & 511) * 8;
            const float* src = tok < TP ? p.x_prompt + tok * DM + c8 : p.x_sample + (tok - TP) * DM + c8; a[u] = ld_nt((const f32x4*)src); b[u] = ld_nt((const f32x4*)(src + 4)); } }
#pragma unroll
        for (int u = 0; u < 4; ++u) { const size_t i = i0 + (size_t)u * NT; if (i < (size_t)TT * (DM / 8)) { const size_t tok = i >> 9; const int c8 = (int)(i & 511) * 8;
            u32x4 w; w.x = pk_bf16(a[u][0], a[u][1]); w.y = pk_bf16(a[u][2], a[u][3]); w.z = pk_bf16(b[u][0], b[u][1]); w.w = pk_bf16(b[u][2], b[u][3]);
            *(u32x4*)(xb + tok * DM + c8) = w;
            u32x2 q8; q8.x = pk_fp8x4(a[u][0] * FP8_SA_X, a[u][1] * FP8_SA_X, a[u][2] * FP8_SA_X, a[u][3] * FP8_SA_X); q8.y = pk_fp8x4(b[u][0] * FP8_SA_X, b[u][1] * FP8_SA_X, b[u][2] * FP8_SA_X, b[u][3] * FP8_SA_X);
            *(u32x2*)(ws + WS_XQ + tok * DM + c8) = q8; } }
    }
    for (size_t i = gt; i < (WS_ZERO_BYTES - WS_GATES) / 16; i += NT) *(u32x4*)(ws + WS_GATES + 16 * i) = (u32x4){0u, 0u, 0u, 0u};
    for (size_t i = gt; i < (size_t)32 * 1024 / 4; i += NT) *(f32x4*)(p.out + O_PN + 4 * i) = (f32x4){0.f, 0.f, 0.f, 0.f};
    bf16_t* GT = (bf16_t*)(ws + WS_GT);
    for (size_t i = gt; i < (size_t)2 * 16 * INNER; i += NT) { const int c = (int)(i & 8191), g = (int)(i >> 13) & 15, which = (int)(i >> 17);
        const int n = c >> 2, d = c & 3; float s = 0.f;
        if (which == 0) {
#pragma unroll
            for (int e = 0; e < 4; ++e) s += p.w_q[n * 16 + d * 4 + e] * p.w_gate[(size_t)(0 * INNER + 4 * n + e) * 16 + g] + p.w_k[n * 16 + d * 4 + e] * p.w_gate[(size_t)(1 * INNER + 4 * n + e) * 16 + g];
        } else {
#pragma unroll
            for (int e = 0; e < 4; ++e) s += p.w_v[n * 16 + d * 4 + e] * p.w_gate[(size_t)(2 * INNER + 4 * n + e) * 16 + g];
        }
        GT[i] = f2bf(s); }
}

template <bool SAMP>
DI void passA_item(const Frame& F, const Params& p, int tg, int cg, int step0 = 0, int nstep = 4) {
    unsigned char* ws = p.ws;
    const bf16_t* __restrict__ xm = (const bf16_t*)(ws + WS_XM); bf16_t* __restrict__ xa = (bf16_t*)(ws + WS_XA); const bf16_t* __restrict__ GT = (const bf16_t*)(ws + WS_GT); float* gates = (float*)(ws + WS_GATES);
    LAS f32x4* red = (LAS f32x4*)F.lds;
    LAS unsigned short* tVw = (LAS unsigned short*)(F.lds + 32768 + F.wave * 4096);
    const int fr = F.lane & 15, fq = F.lane >> 4;
    f32x4 accg[4];
#pragma unroll
    for (int j = 0; j < 4; ++j) accg[j] = (f32x4){0.f, 0.f, 0.f, 0.f};
    const int tokb = tg * 64 + fr;
    for (int step = step0; step < step0 + nstep; ++step) {
        const int c = cg * 1024 + F.wave * 128 + 32 * step + 8 * fq;
        f32x4 wv[5][2];
#pragma unroll
        for (int j = 0; j < 4; ++j) { wv[j][0] = *(const f32x4*)(p.w_mconv + (size_t)j * INNER + c); wv[j][1] = *(const f32x4*)(p.w_mconv + (size_t)j * INNER + c + 4); }
        wv[4][0] = *(const f32x4*)(p.b_mconv + c); wv[4][1] = *(const f32x4*)(p.b_mconv + c + 4);
        const bf16x8 ga = *(const bf16x8*)(GT + (size_t)(0 * 16 + fr) * INNER + c), gm = *(const bf16x8*)(GT + (size_t)(1 * 16 + fr) * INNER + c);
        f32x4 wvv[2][4];
        if (!SAMP) {
#pragma unroll
            for (int bb = 0; bb < 2; ++bb)
#pragma unroll
                for (int d = 0; d < 4; ++d) wvv[bb][d] = *(const f32x4*)(p.w_v + (size_t)((c >> 2) + bb) * 16 + 4 * d); }
#pragma unroll
      for (int th = 0; th < 2; ++th) {
        u32x4 raw[4][4];
#pragma unroll
        for (int tl = 2 * th; tl < 2 * th + 2; ++tl) { const int tok = tokb + 16 * tl; const int t = SAMP ? ((tok - TP) & 31) : (tok & 4095);
#pragma unroll
            for (int j = 0; j < 4; ++j) { const int back = (3 - j) < t ? (3 - j) : t;
                raw[tl][j] = *(const u32x4*)(xm + (size_t)(tok - back) * INNER + c); } }
#pragma unroll
        for (int tl = 2 * th; tl < 2 * th + 2; ++tl) { const int tok = tokb + 16 * tl; const int t = SAMP ? ((tok - TP) & 31) : (tok & 4095);
            float xc[8];
#pragma unroll
            for (int i = 0; i < 8; ++i) xc[i] = wv[4][i >> 2][i & 3];
#pragma unroll
            for (int j = 0; j < 4; ++j) { const int tj = t + j - 3; float xin[8]; unpack8(raw[tl][j], xin);
                if (tj < 0) {
                    if (SAMP) { const int bsm = (tok - TP) >> 5; const float* hp = p.st_mconv + (size_t)(bsm * 3 + tj + 3) * INNER + c; const f32x4 h0 = *(const f32x4*)hp, h1 = *(const f32x4*)(hp + 4);
                        xin[0] = h0[0]; xin[1] = h0[1]; xin[2] = h0[2]; xin[3] = h0[3]; xin[4] = h1[0]; xin[5] = h1[1]; xin[6] = h1[2]; xin[7] = h1[3]; }
                    else {
#pragma unroll
                        for (int i = 0; i < 8; ++i) xin[i] = 0.f; } }
#pragma unroll
                for (int i = 0; i < 8; ++i) xc[i] += wv[j][i >> 2][i & 3] * xin[i]; }
#pragma unroll
            for (int i = 0; i < 8; ++i) xc[i] = fsilu(xc[i]);
            const u32x4 xa4 = pack8(xc);
            *(u32x4*)(xa + (size_t)tok * INNER + c) = xa4;
            if (!SAMP) { u32x2 x8v; x8v.x = pk_fp8x4(xc[0] * FP8_SA_XA, xc[1] * FP8_SA_XA, xc[2] * FP8_SA_XA, xc[3] * FP8_SA_XA); x8v.y = pk_fp8x4(xc[4] * FP8_SA_XA, xc[5] * FP8_SA_XA, xc[6] * FP8_SA_XA, xc[7] * FP8_SA_XA);
                *(u32x2*)((unsigned char*)p.out + O8_XA8 + (size_t)tok * INNER + c) = x8v; }
            accg[tl] = __builtin_amdgcn_mfma_f32_16x16x32_bf16(__builtin_bit_cast(bf16x8, xa4), ga, accg[tl], 0, 0, 0);
            accg[tl] = __builtin_amdgcn_mfma_f32_16x16x32_bf16(__builtin_bit_cast(bf16x8, raw[tl][3]), gm, accg[tl], 0, 0, 0);
            if (!SAMP) {
                float xv[8]; unpack8(raw[tl][3], xv);
                const int col = 16 * tl + fr, dw = ((col >> 1) ^ (8 * fq)) << 1;
#pragma unroll
                for (int bb = 0; bb < 2; ++bb)
#pragma unroll
                    for (int e = 0; e < 4; ++e) { const float v = xv[4 * bb] * wvv[bb][0][e] + xv[4 * bb + 1] * wvv[bb][1][e] + xv[4 * bb + 2] * wvv[bb][2][e] + xv[4 * bb + 3] * wvv[bb][3][e];
                        tVw[(8 * fq + 4 * bb + e) * 64 + dw + (col & 1)] = f2bf(v); } }
        }
      }
        if (!SAMP) {
            asm volatile("s_waitcnt lgkmcnt(0)" ::: "memory");
#pragma unroll
            for (int k = 0; k < 4; ++k) { const int q = F.lane + 64 * k, row = q >> 3, ch = q & 7;
                const u32x4 vrow = *(const LAS u32x4*)(tVw + row * 64 + ((((4 * ch) ^ (8 * (row >> 3)))) << 1));
                const size_t chan = (size_t)(cg * 1024 + F.wave * 128 + 32 * step + row);
                *(u32x4*)((bf16_t*)(ws + WS_VT) + chan * TPP + tg * 64 + 8 * ch) = vrow;
                float vf[8]; unpack8(vrow, vf); u32x2 v8; v8.x = pk_fp8x4(vf[0] * FP8_SA_V, vf[1] * FP8_SA_V, vf[2] * FP8_SA_V, vf[3] * FP8_SA_V); v8.y = pk_fp8x4(vf[4] * FP8_SA_V, vf[5] * FP8_SA_V, vf[6] * FP8_SA_V, vf[7] * FP8_SA_V);
                *(u32x2*)(ws + WS_VT8 + chan * P8 + tg * 64 + 8 * ch) = v8; }
            asm volatile("s_waitcnt lgkmcnt(0)" ::: "memory"); }
    }
    __syncthreads();
#pragma unroll
    for (int tl = 0; tl < 4; ++tl) red[(F.wave * 4 + tl) * 64 + F.lane] = accg[tl];
    __syncthreads();
    if (F.tid < 256 && !F.dry) { const int tl = F.tid >> 6, ln = F.tid & 63; f32x4 sacc = (f32x4){0.f, 0.f, 0.f, 0.f};
#pragma unroll
        for (int w = 0; w < NWAVES; ++w) sacc += red[(w * 4 + tl) * 64 + ln];
#pragma unroll
        for (int j = 0; j < 4; ++j) atomicAdd(gates + (size_t)(tg * 64 + 16 * tl + 4 * (ln >> 4) + j) * 16 + (ln & 15), sacc[j]); }
}
DI void phase_passA(const Frame& F, const Params& p) {
    unsigned char* ws = p.ws;
    const bf16_t* xm = (const bf16_t*)(ws + WS_XM);
    for (int it = F.vcu; it < (TP / 64) * 8 + (TS / 64) * 8 * 4; it += F.G) { const int item = (TP / 64) * 8 + (TS / 64) * 8 * 4 - 1 - it;
        if (item < (TP / 64) * 8) passA_item<false>(F, p, item >> 3, item & 7);
        else { const int si = item - (TP / 64) * 8; passA_item<true>(F, p, TP / 64 + (si >> 5), (si >> 2) & 7, si & 3, 1); } }
    const size_t gt = (size_t)F.vcu * NTHR + F.tid, NT = (size_t)F.G * NTHR;
    for (size_t i = gt; i < (size_t)(4 + 16) * 3 * (INNER / 8); i += NT) { const int c8 = (int)(i & 1023) * 8, ri = (int)(i >> 10), sq = ri / 3, k = ri - sq * 3;
        size_t tok; float* dst;
        if (sq < 4) { tok = (size_t)sq * 4096 + 4093 + k; dst = p.out + O_PMC + (size_t)(sq * 3 + k) * INNER + c8; }
        else { const int b = sq - 4; tok = (size_t)TP + b * 32 + 29 + k; dst = p.out + O_SMC + (size_t)(b * 3 + k) * INNER + c8; }
        float f[8]; unpack8(*(const u32x4*)(xm + tok * INNER + c8), f);
        *(f32x4*)dst = (f32x4){f[0], f[1], f[2], f[3]}; *(f32x4*)(dst + 4) = (f32x4){f[4], f[5], f[6], f[7]}; }
}

DI void headwise8(const float (&x)[8], const float* W, int n0, float scale, float (&y)[8]) {
#pragma unroll
    for (int bb = 0; bb < 2; ++bb) { const float* w = W + (size_t)(n0 + bb) * 16; const f32x4 w0 = *(const f32x4*)w, w1 = *(const f32x4*)(w + 4), w2 = *(const f32x4*)(w + 8), w3 = *(const f32x4*)(w + 12);
#pragma unroll
        for (int e = 0; e < 4; ++e) y[4 * bb + e] = (x[4 * bb] * w0[e] + x[4 * bb + 1] * w1[e] + x[4 * bb + 2] * w2[e] + x[4 * bb + 3] * w3[e]) * scale; }
}

DI float block_excl_add(float v, LAS float* sm, int lane, int wave) {
    float incl = v;
#pragma unroll
    for (int o = 1; o < 64; o <<= 1) { const float t = __shfl_up(incl, o); if (lane >= o) incl += t; }
    __syncthreads();
    if (lane == 63) sm[wave] = incl;
    __syncthreads();
    float woff = 0.f;
#pragma unroll
    for (int w = 0; w < NWAVES; ++w) { const float t = sm[w]; if (w < wave) woff += t; }
    return woff + incl - v;
}
DI float block_excl_max(float v, LAS float* sm, int lane, int wave) {
    float incl = v;
#pragma unroll
    for (int o = 1; o < 64; o <<= 1) { const float t = __shfl_up(incl, o); if (lane >= o) incl = fmaxf(incl, t); }
    float excl = __shfl_up(incl, 1); if (lane == 0) excl = -3.0e38f;
    __syncthreads();
    if (lane == 63) sm[wave] = incl;
    __syncthreads();
    float woff = -3.0e38f;
#pragma unroll
    for (int w = 0; w < NWAVES; ++w) { const float t = sm[w]; if (w < wave) woff = fmaxf(woff, t); }
    return fmaxf(woff, excl);
}
DI void scan_prompt(const Frame& F, const Params& p, int bh) {
    unsigned char* ws = p.ws;
    const float* gates = (const float*)(ws + WS_GATES); float* cs = (float*)(ws + WS_CS); float* mx = (float*)(ws + WS_MX); float* em = (float*)(ws + WS_EM); float* mxl = (float*)(ws + WS_MXL);
    LAS float* sm = (LAS float*)(F.lds + 1024);
    const int b = bh >> 3, h = bh & 7; const float bi = p.b_gate[h], bf = p.b_gate[8 + h];
    const float* gp = gates + (size_t)(b * 4096 + 8 * F.tid) * 16;
    float ig[8], lf[8];
#pragma unroll
    for (int k = 0; k < 8; ++k) { ig[k] = gp[k * 16 + h]; lf[k] = gp[k * 16 + 8 + h]; }
    float s = 0.f;
#pragma unroll
    for (int k = 0; k < 8; ++k) { ig[k] += bi; lf[k] = logsig(lf[k] + bf); s += lf[k]; }
    float run = block_excl_add(s, sm, F.lane, F.wave);
    float c[8], B[8], mloc = -3.0e38f;
#pragma unroll
    for (int k = 0; k < 8; ++k) { run += lf[k]; B[k] = run; c[k] = ig[k] - run; mloc = fmaxf(mloc, c[k]); }
    float rm = fmaxf(0.f, block_excl_max(mloc, sm, F.lane, F.wave));
    f32x4 oc[2], om[2], oe[2];
#pragma unroll
    for (int k = 0; k < 8; ++k) { rm = fmaxf(rm, c[k]); oc[k >> 2][k & 3] = c[k]; om[k >> 2][k & 3] = rm; oe[k >> 2][k & 3] = expf(-(B[k] + rm)); }
    const size_t o = (size_t)bh * 4096 + 8 * F.tid;
    *(f32x4*)(cs + o) = oc[0]; *(f32x4*)(cs + o + 4) = oc[1]; *(f32x4*)(mx + o) = om[0]; *(f32x4*)(mx + o + 4) = om[1]; *(f32x4*)(em + o) = oe[0]; *(f32x4*)(em + o + 4) = oe[1];
    if (F.tid == NTHR - 1) { p.out[O_PM + bh] = B[7] + rm; mxl[bh] = rm; }
}

DI void sample_prep(const Frame& F, const Params& p, int bh) {
    unsigned char* ws = p.ws;
    const float* gates = (const float*)(ws + WS_GATES); const bf16_t* __restrict__ xa = (const bf16_t*)(ws + WS_XA); const bf16_t* __restrict__ xm = (const bf16_t*)(ws + WS_XM);
    bf16_t* __restrict__ Sp = (bf16_t*)(ws + WS_SSP); bf16_t* __restrict__ qt = (bf16_t*)(ws + WS_SQT); bf16_t* __restrict__ wkT = (bf16_t*)(ws + WS_SWK); bf16_t* __restrict__ vTs = (bf16_t*)(ws + WS_SVT); float* scb = (float*)(ws + WS_MXL + 1024);
    LAS float* red = (LAS float*)(F.lds + 4096);
    LAS float* scr = (LAS float*)(F.lds + F.wave * 512);
    const int lane = F.lane, b = bh >> 3, h = bh & 7, r = lane & 31, hf = lane >> 5, tok0 = TP + 32 * b;
    const float ig = gates[(size_t)(tok0 + r) * 16 + h] + p.b_gate[h], lf = logsig(gates[(size_t)(tok0 + r) * 16 + 8 + h] + p.b_gate[8 + h]);
    float bc = lf;
#pragma unroll
    for (int o = 1; o < 32; o <<= 1) { const float v = __shfl_up(bc, o, 32); if (r >= o) bc += v; }
    const float m0 = p.st_m[bh], c = ig - bc;
    float pmx = c;
#pragma unroll
    for (int o = 1; o < 32; o <<= 1) { const float v = __shfl_up(pmx, o, 32); if (r >= o) pmx = fmaxf(pmx, v); }
    const float mxt = fmaxf(m0, pmx), m_t = bc + mxt, inter = expf(m0 - mxt), emt = expf(-m_t);
    const float mx31 = __shfl(mxt, 31), b31 = __shfl(bc, 31);
    const float w_s = expf(c - mx31), scv = expf(m0 - mx31);
    const int dkw = 128 * F.wave;
    const bf16_t* xar = xa + (size_t)(tok0 + r) * INNER + h * 1024 + dkw + 8 * hf; const bf16_t* xmr = xm + (size_t)(tok0 + r) * INNER + h * 1024 + dkw + 8 * hf;
    const float* n0v = p.st_n + (size_t)bh * 1024 + dkw + 8 * hf;
    f32x16 accS;
#pragma unroll
    for (int i = 0; i < 16; ++i) accS[i] = 0.f;
    float qn = 0.f;
#pragma unroll 4
    for (int kk = 0; kk < 8; ++kk) {
        float x[8], q[8], k[8]; unpack8(*(const u32x4*)(xar + 16 * kk), x);
        const int n0 = (h * 1024 + dkw + 16 * kk + 8 * hf) >> 2;
        headwise8(x, p.w_q, n0, 1.0f, q); headwise8(x, p.w_k, n0, 0.03125f, k);
        const f32x4 na = *(const f32x4*)(n0v + 16 * kk), nb = *(const f32x4*)(n0v + 16 * kk + 4);
        qn += q[0] * na[0] + q[1] * na[1] + q[2] * na[2] + q[3] * na[3] + q[4] * nb[0] + q[5] * nb[1] + q[6] * nb[2] + q[7] * nb[3];
        accS = __builtin_amdgcn_mfma_f32_32x32x16_bf16(__builtin_bit_cast(bf16x8, pack8(q)), __builtin_bit_cast(bf16x8, pack8(k)), accS, 0, 0, 0);
    }
    __syncthreads();
#pragma unroll
    for (int i = 0; i < 16; ++i) red[(F.wave * 17 + i) * 64 + lane] = accS[i];
    red[(F.wave * 17 + 16) * 64 + lane] = qn;
    __syncthreads();
    qn = 0.f;
#pragma unroll
    for (int i = 0; i < 16; ++i) accS[i] = 0.f;
#pragma unroll
    for (int w = 0; w < NWAVES; ++w) {
#pragma unroll
        for (int i = 0; i < 16; ++i) accS[i] += red[(w * 17 + i) * 64 + lane];
        qn += red[(w * 17 + 16) * 64 + lane]; }
    qn += __shfl_xor(qn, 32);
    float sv[16];
#pragma unroll
    for (int i = 0; i < 16; ++i) { const int t = (i & 3) + 8 * (i >> 2) + 4 * hf; const float mxq = __shfl(mxt, t);
        const float d = (r <= t) ? expf(c - mxq) : 0.f; sv[i] = accS[i] * d;
        float rs = sv[i];
#pragma unroll
        for (int o = 1; o < 32; o <<= 1) rs += __shfl_xor(rs, o);
        if (r == 0) scr[t] = rs; }
    asm volatile("s_waitcnt lgkmcnt(0)" ::: "memory");
    const float den = scr[r] + inter * qn, g = 1.0f / fmaxf(fabsf(den), emt), f = inter * g;
    asm volatile("s_waitcnt lgkmcnt(0)" ::: "memory");
    if (hf == 0) scr[32 + r] = g;
    asm volatile("s_waitcnt lgkmcnt(0)" ::: "memory");
    if (F.wave == 0) {
#pragma unroll
        for (int i = 0; i < 16; ++i) { const int t = (i & 3) + 8 * (i >> 2) + 4 * hf; Sp[(size_t)(bh * 32 + t) * 32 + r] = f2bf(sv[i] * scr[32 + t]); } }
    asm volatile("s_waitcnt lgkmcnt(0)" ::: "memory");
#pragma unroll 2
    for (int kk = 0; kk < 8; ++kk) {
        float x[8], xv[8], q[8], k[8], v[8]; unpack8(*(const u32x4*)(xar + 16 * kk), x); unpack8(*(const u32x4*)(xmr + 16 * kk), xv);
        const int dk0 = dkw + 16 * kk + 8 * hf, n0 = (h * 1024 + dk0) >> 2;
        const float n0s[8] = {p.st_n[(size_t)bh * 1024 + dk0], p.st_n[(size_t)bh * 1024 + dk0 + 1], p.st_n[(size_t)bh * 1024 + dk0 + 2], p.st_n[(size_t)bh * 1024 + dk0 + 3],
                              p.st_n[(size_t)bh * 1024 + dk0 + 4], p.st_n[(size_t)bh * 1024 + dk0 + 5], p.st_n[(size_t)bh * 1024 + dk0 + 6], p.st_n[(size_t)bh * 1024 + dk0 + 7]};
        headwise8(x, p.w_q, n0, 1.0f, q); headwise8(x, p.w_k, n0, 0.03125f, k); headwise8(xv, p.w_v, n0, 1.0f, v);
#pragma unroll
        for (int i = 0; i < 8; ++i) q[i] *= f;
        *(u32x4*)(qt + (size_t)(bh * 32 + r) * 1024 + dk0) = pack8(q);
#pragma unroll
        for (int i = 0; i < 8; ++i) { const float wk = k[i] * w_s; wkT[(size_t)(bh * 1024 + dk0 + i) * 32 + r] = f2bf(wk); vTs[(size_t)(bh * 1024 + dk0 + i) * 32 + r] = f2bf(v[i]);
            float ns = wk;
#pragma unroll
            for (int o = 1; o < 32; o <<= 1) ns += __shfl_xor(ns, o);
            if (r == 0) p.out[O_SN + (size_t)bh * 1024 + dk0 + i] = scv * n0s[i] + ns; }
    }
    if (F.tid == 0) { p.out[O_SM + bh] = b31 + mx31; scb[bh] = scv; }
    __syncthreads();
}

DI void phase_passB(const Frame& F, const Params& p) {
    unsigned char* ws = p.ws;
    const bf16_t* __restrict__ xa = (const bf16_t*)(ws + WS_XA); const bf16_t* __restrict__ xm = (const bf16_t*)(ws + WS_XM); bf16_t* __restrict__ qp = (bf16_t*)(ws + WS_QP); bf16_t* __restrict__ kwT = (bf16_t*)(ws + WS_KWT); bf16_t* __restrict__ vT = (bf16_t*)(ws + WS_VT);
    const float* cs = (const float*)(ws + WS_CS); const float* mxl = (const float*)(ws + WS_MXL);
    unsigned char* __restrict__ q8 = (unsigned char*)p.out + O8_Q8; unsigned char* __restrict__ xa8 = (unsigned char*)p.out + O8_XA8;
    LAS bf16_t* tK = (LAS bf16_t*)F.lds;
    const int g = F.tid & 7, tl = F.tid >> 3;
    for (int item = F.vcu; item < 2048; item += F.G) {
        const int cb = item & 127, tb = item >> 7, b = tb >> 2, h = cb >> 4, bh = b * 8 + h, c = cb * 64 + 8 * g, n0 = c >> 2;
        float wqk[2][4][4], wkk[2][4][4], wvv[2][4][4];
#pragma unroll
        for (int bb = 0; bb < 2; ++bb) { float wq[4][4];
#pragma unroll
            for (int d = 0; d < 4; ++d) { const f32x4 a = *(const f32x4*)(p.w_q + (size_t)(n0 + bb) * 16 + 4 * d), k4 = *(const f32x4*)(p.w_k + (size_t)(n0 + bb) * 16 + 4 * d), v4 = *(const f32x4*)(p.w_v + (size_t)(n0 + bb) * 16 + 4 * d);
#pragma unroll
                for (int e = 0; e < 4; ++e) { wq[d][e] = a[e]; wkk[bb][d][e] = k4[e] * 0.03125f; wvv[bb][d][e] = v4[e]; } }
#pragma unroll
            for (int d = 0; d < 4; ++d)
#pragma unroll
                for (int d2 = 0; d2 < 4; ++d2) wqk[bb][d][d2] = wq[d][0] * wkk[bb][d2][0] + wq[d][1] * wkk[bb][d2][1] + wq[d][2] * wkk[bb][d2][2] + wq[d][3] * wkk[bb][d2][3]; }
        const float mxlast = mxl[bh];
        float nacc[8];
#pragma unroll
        for (int i = 0; i < 8; ++i) nacc[i] = 0.f;
        const int tokb = tb * 1024 + tl;
#pragma unroll 1
        for (int sub4 = 0; sub4 < 16; sub4 += 2) {
          u32x4 rxa[2];
#pragma unroll
          for (int u = 0; u < 2; ++u) { const int tk = tokb + (sub4 + u) * 64; rxa[u] = *(const u32x4*)(xa + (size_t)tk * INNER + c); }
          const float rcs0 = cs[bh * 4096 + ((tokb + sub4 * 64) & 4095)], rcs1 = cs[bh * 4096 + ((tokb + sub4 * 64 + 64) & 4095)];
#pragma unroll
          for (int u = 0; u < 2; ++u) {
            const int sub = sub4 + u, tok = tokb + sub * 64;
            const u32x4 cxa = rxa[u]; const float ccs = u ? rcs1 : rcs0;
            float x[8], q[8], kw[8]; unpack8(cxa, x);
            const float w = fexp(ccs - mxlast);
#pragma unroll
            for (int bb = 0; bb < 2; ++bb)
#pragma unroll
                for (int e = 0; e < 4; ++e) {
                    q[4 * bb + e] = x[4 * bb] * wqk[bb][0][e] + x[4 * bb + 1] * wqk[bb][1][e] + x[4 * bb + 2] * wqk[bb][2][e] + x[4 * bb + 3] * wqk[bb][3][e];
                    kw[4 * bb + e] = (x[4 * bb] * wkk[bb][0][e] + x[4 * bb + 1] * wkk[bb][1][e] + x[4 * bb + 2] * wkk[bb][2][e] + x[4 * bb + 3] * wkk[bb][3][e]) * w; }
            *(u32x4*)(qp + (size_t)tok * INNER + c) = pack8(q);
            { u32x2 q8v, x8v; q8v.x = pk_fp8x4(q[0] * FP8_SA_Q, q[1] * FP8_SA_Q, q[2] * FP8_SA_Q, q[3] * FP8_SA_Q); q8v.y = pk_fp8x4(q[4] * FP8_SA_Q, q[5] * FP8_SA_Q, q[6] * FP8_SA_Q, q[7] * FP8_SA_Q);
              *(u32x2*)(q8 + (size_t)tok * INNER + c) = q8v; (void)x8v; }
            LAS bf16_t* bK = tK + (sub & 1) * (64 * 72);
#pragma unroll
            for (int i = 0; i < 8; ++i) { nacc[i] += kw[i]; bK[(8 * i + g) * 72 + tl] = f2bf(kw[i]); }
            LDS_BARRIER();
            { const int row = F.tid >> 3, ch = F.tid & 7, chan = 8 * (row & 7) + (row >> 3); const size_t o = (size_t)(cb * 64 + chan) * TPP + tb * 1024 + sub * 64 + 8 * ch;
              *(u32x4*)(kwT + o) = *(const LAS u32x4*)(bK + row * 72 + 8 * ch); }
          }
        }
        LDS_BARRIER();
#pragma unroll
        for (int i = 0; i < 8; ++i) { float v = nacc[i]; v += __shfl_xor(v, 8); v += __shfl_xor(v, 16); v += __shfl_xor(v, 32);
            if (F.lane < 8 && !F.dry) atomicAdd(p.out + O_PN + (size_t)bh * 1024 + (c & 1023) + i, v); }
    }
}

DI void phase_sample_cell(const Frame& F, const Params& p) {
    unsigned char* ws = p.ws;
    const bf16_t* __restrict__ Sp = (const bf16_t*)(ws + WS_SSP); const bf16_t* __restrict__ qt = (const bf16_t*)(ws + WS_SQT); const bf16_t* __restrict__ wkT = (const bf16_t*)(ws + WS_SWK); const bf16_t* __restrict__ vTs = (const bf16_t*)(ws + WS_SVT);
    const float* scb = (const float*)(ws + WS_MXL + 1024); bf16_t* __restrict__ hs = (bf16_t*)(ws + WS_HS);
    const int r = F.lane & 31, hf = F.lane >> 5, gw = F.vcu * NWAVES + F.wave, NGW = F.G * NWAVES;
    for (int item = gw; item < 128 * 16; item += NGW) {
        const int bh = item >> 4, dvp = item & 15, b = bh >> 3, h = bh & 7;
        const __amdgpu_buffer_rsrc_t rC0 = __builtin_amdgcn_make_buffer_rsrc((void*)(p.st_C + ((size_t)bh << 20)), 0, 1 << 22, 0x00020000);
        const __amdgpu_buffer_rsrc_t rCn = __builtin_amdgcn_make_buffer_rsrc((void*)(p.out + O_SC + ((size_t)bh << 20)), 0, 1 << 22, 0x00020000);
        const unsigned voff = (unsigned)((4 * hf) * 1024 + r) * 4u; const int sbase = dvp * 256;
#define SC_OFF(dkt_, i_, d_) (sbase + ((dkt_) * 32 + ((i_) & 3) + 8 * ((i_) >> 2)) * 4096 + (d_) * 128)
        const float sc = scb[bh];
        bf16x8 vf[2][2], sf[2];
#pragma unroll
        for (int s2 = 0; s2 < 2; ++s2) { sf[s2] = *(const bf16x8*)(Sp + (size_t)(bh * 32 + r) * 32 + 16 * s2 + 8 * hf);
#pragma unroll
            for (int d = 0; d < 2; ++d) vf[d][s2] = *(const bf16x8*)(vTs + (size_t)(bh * 1024 + dvp * 64 + 32 * d + r) * 32 + 16 * s2 + 8 * hf); }
        f32x16 acch[2];
#pragma unroll
        for (int d = 0; d < 2; ++d) {
#pragma unroll
            for (int i = 0; i < 16; ++i) acch[d][i] = 0.f;
            acch[d] = __builtin_amdgcn_mfma_f32_32x32x16_bf16(sf[0], vf[d][0], acch[d], 0, 0, 0); acch[d] = __builtin_amdgcn_mfma_f32_32x32x16_bf16(sf[1], vf[d][1], acch[d], 0, 0, 0); }
        const bf16_t* qrow = qt + (size_t)(bh * 32 + r) * 1024 + 4 * hf; const bf16_t* wkrow = wkT + (size_t)(bh * 1024 + r) * 32 + 8 * hf;
        f32x16 cn[2];
#pragma unroll
        for (int d = 0; d < 2; ++d)
#pragma unroll
            for (int i = 0; i < 16; ++i) cn[d][i] = __uint_as_float(__builtin_amdgcn_raw_buffer_load_b32(rC0, voff, SC_OFF(0, i, d), 2));
        for (int dkt = 0; dkt < 32; ++dkt) {
            f32x16 c[2] = {cn[0], cn[1]};
            if (dkt < 31) {
#pragma unroll
                for (int d = 0; d < 2; ++d)
#pragma unroll
                    for (int i = 0; i < 16; ++i) cn[d][i] = __uint_as_float(__builtin_amdgcn_raw_buffer_load_b32(rC0, voff, SC_OFF(dkt + 1, i, d), 2)); }
            bf16x8 pa[2], wa[2];
#pragma unroll
            for (int s = 0; s < 2; ++s) { const u32x2 lo = *(const u32x2*)(qrow + dkt * 32 + 16 * s), hi = *(const u32x2*)(qrow + dkt * 32 + 16 * s + 8);
                u32x4 t4; t4.x = lo.x; t4.y = lo.y; t4.z = hi.x; t4.w = hi.y; pa[s] = __builtin_bit_cast(bf16x8, t4);
                wa[s] = *(const bf16x8*)(wkrow + (size_t)dkt * 32 * 32 + 16 * s); }
#pragma unroll
            for (int d = 0; d < 2; ++d) {
#pragma unroll
                for (int s = 0; s < 2; ++s) { u32x4 xs; xs.x = pk_bf16(c[d][8 * s], c[d][8 * s + 1]); xs.y = pk_bf16(c[d][8 * s + 2], c[d][8 * s + 3]); xs.z = pk_bf16(c[d][8 * s + 4], c[d][8 * s + 5]); xs.w = pk_bf16(c[d][8 * s + 6], c[d][8 * s + 7]);
                    acch[d] = __builtin_amdgcn_mfma_f32_32x32x16_bf16(pa[s], __builtin_bit_cast(bf16x8, xs), acch[d], 0, 0, 0); }
#pragma unroll
                for (int i = 0; i < 16; ++i) c[d][i] *= sc;
                c[d] = __builtin_amdgcn_mfma_f32_32x32x16_bf16(wa[0], vf[d][0], c[d], 0, 0, 0); c[d] = __builtin_amdgcn_mfma_f32_32x32x16_bf16(wa[1], vf[d][1], c[d], 0, 0, 0);
#pragma unroll
                for (int i = 0; i < 16; ++i) __builtin_amdgcn_raw_buffer_store_b32(__float_as_uint(c[d][i]), rCn, voff, SC_OFF(dkt, i, d), 2); }
        }
#pragma unroll
        for (int d = 0; d < 2; ++d)
#pragma unroll
            for (int i = 0; i < 16; ++i) { const int t = (i & 3) + 8 * (i >> 2) + 4 * hf; hs[(size_t)(b * 32 + t) * INNER + h * 1024 + dvp * 64 + 32 * d + r] = f2bf(acch[d][i]); }
#undef SC_OFF
    }
}

DI void phase_predown(const Frame& F, const Params& p) {
    unsigned char* ws = p.ws;
    const bf16_t* __restrict__ hb = (const bf16_t*)(ws + WS_H); const bf16_t* __restrict__ hs = (const bf16_t*)(ws + WS_HS); const bf16_t* __restrict__ xa = (const bf16_t*)(ws + WS_XA); const bf16_t* __restrict__ sz = (const bf16_t*)(ws + WS_SZ);
    unsigned char* __restrict__ pre = ws + WS_PRE;
    const int gw = F.vcu * NWAVES + F.wave, NGW = F.G * NWAVES;
    if ((NGW & 7) != 0) return;
    const int h = gw & 7, cc0 = h * 1024 + 8 * F.lane;
    f32x4 gk[2][4];
#pragma unroll
    for (int j = 0; j < 2; ++j) { gk[j][0] = *(const f32x4*)(p.mh_gain + cc0 + 512 * j); gk[j][1] = *(const f32x4*)(p.mh_gain + cc0 + 512 * j + 4); gk[j][2] = *(const f32x4*)(p.skip + cc0 + 512 * j); gk[j][3] = *(const f32x4*)(p.skip + cc0 + 512 * j + 4); }
    u32x4 nh[2], na[2], nz[2];
#define PD_LOAD(item_) do { const int tok_ = (item_) >> 3; const bf16_t* hrow_ = tok_ < TP ? hb + (size_t)tok_ * INNER + cc0 : hs + (size_t)(tok_ - TP) * INNER + cc0; \
        _Pragma("unroll") for (int j = 0; j < 2; ++j) { nh[j] = ld_nt((const u32x4*)(hrow_ + 512 * j)); na[j] = ld_nt((const u32x4*)(xa + (size_t)tok_ * INNER + cc0 + 512 * j)); nz[j] = ld_nt((const u32x4*)(sz + (size_t)tok_ * INNER + cc0 + 512 * j)); } } while (0)
    if (gw < TT * NH) PD_LOAD(gw);
    for (int item = gw; item < TT * NH; item += NGW) {
        const int tok = item >> 3;
        u32x4 ch[2] = {nh[0], nh[1]}, ca[2] = {na[0], na[1]}, cz[2] = {nz[0], nz[1]};
        if (item + NGW < TT * NH) PD_LOAD(item + NGW);
        float v[2][8]; float s = 0.f;
#pragma unroll
        for (int j = 0; j < 2; ++j) { unpack8(ch[j], v[j]);
#pragma unroll
            for (int i = 0; i < 8; ++i) s += v[j][i]; }
        const float mean = wave_sum(s) * (1.0f / 1024.0f); float s2 = 0.f;
#pragma unroll
        for (int j = 0; j < 2; ++j)
#pragma unroll
            for (int i = 0; i < 8; ++i) { v[j][i] -= mean; s2 += v[j][i] * v[j][i]; }
        const float rstd = 1.0f / sqrtf(wave_sum(s2) * (1.0f / 1024.0f) + LN_EPS);
#pragma unroll
        for (int j = 0; j < 2; ++j) { float a[8], z[8], o[8]; unpack8(ca[j], a); unpack8(cz[j], z);
#pragma unroll
            for (int i = 0; i < 4; ++i) { o[i] = (v[j][i] * rstd * gk[j][0][i] + gk[j][2][i] * a[i]) * z[i]; o[4 + i] = (v[j][4 + i] * rstd * gk[j][1][i] + gk[j][3][i] * a[4 + i]) * z[4 + i]; }
            u32x2 w8; w8.x = pk_fp8x4(o[0] * FP8_SA_PRE, o[1] * FP8_SA_PRE, o[2] * FP8_SA_PRE, o[3] * FP8_SA_PRE); w8.y = pk_fp8x4(o[4] * FP8_SA_PRE, o[5] * FP8_SA_PRE, o[6] * FP8_SA_PRE, o[7] * FP8_SA_PRE);
            *(u32x2*)(pre + (size_t)tok * INNER + cc0 + 512 * j) = w8; }
    }
#undef PD_LOAD
}

DI void ln_rows(const Frame& F, const bf16_t* src, const float* rstat, const float* part, const float* g, const float* bta, float* dstA, float* dstB, bf16_t* dstb, unsigned char* dstq, float* lnst) {
    const int gw = F.vcu * NWAVES + F.wave, NGW = F.G * NWAVES;
    LAS f32x4* gl = (LAS f32x4*)F.lds; LAS f32x4* bl = gl + DM / 4;
    __syncthreads();
    for (int i = F.tid; i < DM / 4; i += NTHR) { gl[i] = *(const f32x4*)(g + 4 * i); bl[i] = *(const f32x4*)(bta + 4 * i); }
    __syncthreads();
    constexpr int TV = TP + 4 * TS;
    for (int vr = gw + ((TV - 1 - gw) / NGW) * NGW; vr >= 0; vr -= NGW) {
        int row = vr;
        if (vr >= TP) { if ((vr - TP) & 3) continue; row = TP + ((vr - TP) >> 2); }
        f32x4 v[16]; float mean, rstd;
        if (row < TP) { const u32x2* xr = (const u32x2*)(src + (size_t)row * DM) + F.lane;
#pragma unroll
            for (int j = 0; j < 16; ++j) { const u32x2 w = xr[64 * j]; v[j] = (f32x4){bf_lo(w.x), bf_hi(w.x), bf_lo(w.y), bf_hi(w.y)}; }
            mean = rstat[(size_t)row * 2] * (1.0f / DM); rstd = 1.0f / sqrtf(fmaxf(rstat[(size_t)row * 2 + 1] * (1.0f / DM) - mean * mean, 0.f) + LN_EPS);
#pragma unroll
            for (int j = 0; j < 16; ++j) v[j] = v[j] - mean;
        } else {
#pragma unroll
            for (int j = 0; j < 16; ++j) v[j] = (f32x4){0.f, 0.f, 0.f, 0.f};
#pragma unroll 1
            for (int sp = 0; sp < 8; ++sp) { const f32x4* xr = (const f32x4*)(part + ((size_t)sp * TS + (row - TP)) * DM) + F.lane; f32x4 t[16];
#pragma unroll
                for (int j = 0; j < 16; ++j) t[j] = xr[64 * j];
                __builtin_amdgcn_sched_barrier(0);
#pragma unroll
                for (int j = 0; j < 16; ++j) v[j] += t[j]; }
            float s = 0.f;
#pragma unroll
            for (int j = 0; j < 16; ++j) s += (v[j][0] + v[j][1]) + (v[j][2] + v[j][3]);
            mean = wave_sum(s) * (1.0f / DM); float s2 = 0.f;
#pragma unroll
            for (int j = 0; j < 16; ++j) { v[j] = v[j] - mean; s2 += (v[j][0] * v[j][0] + v[j][1] * v[j][1]) + (v[j][2] * v[j][2] + v[j][3] * v[j][3]); }
            rstd = 1.0f / sqrtf(wave_sum(s2) * (1.0f / DM) + LN_EPS); }
        float* drow = row < TP ? (dstA ? dstA + (size_t)row * DM : nullptr) : dstB + (size_t)(row - TP) * DM;
        if (lnst && row < TP && F.lane == 0) { lnst[(size_t)row * 2] = mean; lnst[(size_t)row * 2 + 1] = rstd; }
        const bool wb = dstb && (row >= TP || ((row >> 8) & 15) == 15);
#pragma unroll
        for (int j = 0; j < 16; ++j) { const int cc = 4 * F.lane + 256 * j; const f32x4 gg = gl[F.lane + 64 * j], bb = bl[F.lane + 64 * j]; const f32x4 o = v[j] * rstd * gg + bb;
            if (drow) { if (dstq) *(f32x4*)(drow + cc) = o; else st_nt((f32x4*)(drow + cc), o); }
            if (wb) { u32x2 w; w.x = pk_bf16(o[0], o[1]); w.y = pk_bf16(o[2], o[3]); *(u32x2*)(dstb + (size_t)row * DM + cc) = w; }
            if (dstq) {
                *(unsigned*)(dstq + (size_t)row * DM + cc) = pk_fp8x4(o[0] * FP8_SA_X1, o[1] * FP8_SA_X1, o[2] * FP8_SA_X1, o[3] * FP8_SA_X1); } }
    }
}

DI void phase_conv31(const Frame& F, const Params& p) {
    unsigned char* ws = p.ws;
    const bf16_t* ub = (const bf16_t*)(ws + WS_U); bf16_t* cb = (bf16_t*)(ws + WS_C); float* stats = (float*)(ws + WS_STATS);
    LAS bf16_t* T = (LAS bf16_t*)F.lds;
    float w[31][2]; float2 bv = make_float2(0.f, 0.f); bool wloaded = false; int wcq = -1;
    for (int it = F.vcu; it < (TT / 32) * 4; it += F.G) { const int item = (TT / 32) * 4 - 1 - it;
        const int tt = item >> 2, cq = item & 3, cbase = cq * 1024, ch = cbase + 2 * F.tid, tok0 = tt * 32;
        const bool samp = tok0 >= TP; const int t0 = samp ? 0 : (tok0 & 4095), bsm = samp ? ((tok0 - TP) >> 5) : 0;
        __syncthreads();
#pragma unroll
        for (int k0 = 0; k0 < 16; k0 += 8) { u32x4 v[8];
#pragma unroll
            for (int k = 0; k < 8; ++k) { const int i = F.tid + (k0 + k) * NTHR, row = i >> 7, c8 = (i & 127) * 8; v[k] = (u32x4){0u, 0u, 0u, 0u};
                if (row < 62 && (row >= 30 || t0 > 0)) v[k] = *(const u32x4*)(ub + (size_t)(tok0 - 30 + row) * DM + cbase + c8); }
            __builtin_amdgcn_sched_barrier(0);
#pragma unroll
            for (int k = 0; k < 8; ++k) { const int i = F.tid + (k0 + k) * NTHR, row = i >> 7, c8 = (i & 127) * 8;
                if (row < 62) *(LAS u32x4*)(T + row * 1024 + c8) = v[k]; } }
        if (samp)
            for (int i = F.tid; i < 30 * 128; i += NTHR) { const int row = i >> 7, c8 = (i & 127) * 8; u32x4 v;
                const float* hp = p.st_cconv + (size_t)(bsm * 30 + row) * DM + cbase + c8; const f32x4 h0 = *(const f32x4*)hp, h1 = *(const f32x4*)(hp + 4);
                v.x = pk_bf16(h0[0], h0[1]); v.y = pk_bf16(h0[2], h0[3]); v.z = pk_bf16(h1[0], h1[1]); v.w = pk_bf16(h1[2], h1[3]);
                *(LAS u32x4*)(T + row * 1024 + c8) = v; }
        __syncthreads();
        if (!wloaded || cq != wcq) { wloaded = true; wcq = cq;
#pragma unroll
            for (int j = 0; j < 31; ++j) { const float2 wv = *(const float2*)(p.w_dw + (size_t)j * DM + ch); w[j][0] = wv.x; w[j][1] = wv.y; }
            bv = *(const float2*)(p.b_dw + ch); }
        float sv[64];
#pragma unroll
        for (int tq = 0; tq < 4; ++tq) {
            float x[38][2];
#pragma unroll
            for (int i = 0; i < 38; ++i) { const unsigned raw = *(const LAS unsigned*)(T + (8 * tq + i) * 1024 + 2 * F.tid); x[i][0] = bf_lo(raw); x[i][1] = bf_hi(raw); }
#pragma unroll
            for (int o = 0; o < 8; ++o) { float a0 = bv.x, a1 = bv.y;
#pragma unroll
                for (int j = 0; j < 31; ++j) { a0 += w[j][0] * x[o + j][0]; a1 += w[j][1] * x[o + j][1]; }
                const int tok = tok0 + 8 * tq + o;
                *(unsigned*)(cb + (size_t)tok * DM + ch) = pk_bf16(a0, a1);
                sv[8 * tq + o] = a0 + a1; sv[32 + 8 * tq + o] = a0 * a0 + a1 * a1; }
        }
#pragma unroll
        for (int st = 0; st < 6; ++st) { const int off = 32 >> st, n2 = 32 >> st; const bool up = (F.lane & off) != 0;
#pragma unroll
            for (int i = 0; i < n2; ++i) { const float keep = up ? sv[i + n2] : sv[i], send = up ? sv[i] : sv[i + n2]; sv[i] = keep + __shfl_xor(send, off); } }
        if (!F.dry) atomicAdd(stats + (size_t)(tok0 + (F.lane & 31)) * 2 + (F.lane >> 5), sv[0]);
    }
    __syncthreads();
    const size_t gt = (size_t)F.vcu * NTHR + F.tid, NT = (size_t)F.G * NTHR;
    for (size_t i = gt; i < (size_t)(4 + 16) * 30 * (DM / 8); i += NT) { const int c8 = (int)(i & 511) * 8, ri = (int)(i >> 9), sq = ri / 30, k = ri - sq * 30;
        size_t tok; float* dst;
        if (sq < 4) { tok = (size_t)sq * 4096 + 4066 + k; dst = p.out + O_PCC + (size_t)(sq * 30 + k) * DM + c8; }
        else { const int b = sq - 4; tok = (size_t)TP + b * 32 + 2 + k; dst = p.out + O_SCC + (size_t)(b * 30 + k) * DM + c8; }
        float f[8]; unpack8(*(const u32x4*)(ub + tok * DM + c8), f);
        *(f32x4*)dst = (f32x4){f[0], f[1], f[2], f[3]}; *(f32x4*)(dst + 4) = (f32x4){f[4], f[5], f[6], f[7]}; }
}

DI void phase_norm2(const Frame& F, const Params& p) {
    unsigned char* ws = p.ws;
    const bf16_t* __restrict__ cb = (const bf16_t*)(ws + WS_C); const bf16_t* __restrict__ szg = (const bf16_t*)(ws + WS_SZG); const float* __restrict__ stats = (const float*)(ws + WS_STATS);
    unsigned char* __restrict__ pre2 = ws + WS_PRE2;
    const size_t gt = (size_t)F.vcu * NTHR + F.tid, NT = (size_t)F.G * NTHR, NI = (size_t)TT * (DM / 8);
    if ((NT & 511) != 0) return;
    const int c8 = (int)(gt & 511) * 8;
    const f32x4 g0 = *(const f32x4*)(p.cln_g + c8), g1 = *(const f32x4*)(p.cln_g + c8 + 4), b0 = *(const f32x4*)(p.cln_b + c8), b1 = *(const f32x4*)(p.cln_b + c8 + 4);
    u32x4 ncc[4], ncz[4]; float ns1[4], ns2[4];
#pragma unroll
    for (int u = 0; u < 4; ++u) { ncc[u] = (u32x4){0u, 0u, 0u, 0u}; ncz[u] = (u32x4){0u, 0u, 0u, 0u}; ns1[u] = 0.f; ns2[u] = 0.f; }
#define N2_LOAD(i0_) do { _Pragma("unroll") for (int u = 0; u < 4; ++u) { const size_t i = (i0_) + (size_t)u * NT; if (i < NI) { const size_t tok_ = i >> 9; \
        ncc[u] = *(const u32x4*)(cb + tok_ * DM + c8); ncz[u] = *(const u32x4*)(szg + tok_ * DM + c8); ns1[u] = stats[tok_ * 2]; ns2[u] = stats[tok_ * 2 + 1]; } } } while (0)
    N2_LOAD(gt);
    u32x2 res[4]; size_t pi0 = NI;
#pragma unroll
    for (int u = 0; u < 4; ++u) res[u] = (u32x2){0u, 0u};
    for (size_t i0 = gt; ; i0 += 4 * NT) {
        u32x4 cc[4], cz[4]; float s1[4], s2[4];
#pragma unroll
        for (int u = 0; u < 4; ++u) { cc[u] = ncc[u]; cz[u] = ncz[u]; s1[u] = ns1[u]; s2[u] = ns2[u]; }
        if (pi0 < NI) {
#pragma unroll
            for (int u = 0; u < 4; ++u) { const size_t i = pi0 + (size_t)u * NT; if (i < NI) *(u32x2*)(pre2 + (i >> 9) * DM + c8) = res[u]; } }
        if (i0 >= NI) break;
        N2_LOAD(i0 + 4 * NT);
#pragma unroll
        for (int u = 0; u < 4; ++u) { const size_t i = i0 + (size_t)u * NT; if (i < NI) {
            const float mean = s1[u] * (1.0f / DM), var = fmaxf(s2[u] * (1.0f / DM) - mean * mean, 0.f), rstd = 1.0f / sqrtf(var + LN_EPS);
            float c[8], z[8], o[8]; unpack8(cc[u], c); unpack8(cz[u], z);
#pragma unroll
            for (int k = 0; k < 4; ++k) { o[k] = fsilu((c[k] - mean) * rstd * g0[k] + b0[k]) * z[k]; o[4 + k] = fsilu((c[4 + k] - mean) * rstd * g1[k] + b1[k]) * z[4 + k]; }
            u32x2 w8; w8.x = pk_fp8x4(o[0] * FP8_SA_PRE2, o[1] * FP8_SA_PRE2, o[2] * FP8_SA_PRE2, o[3] * FP8_SA_PRE2); w8.y = pk_fp8x4(o[4] * FP8_SA_PRE2, o[5] * FP8_SA_PRE2, o[6] * FP8_SA_PRE2, o[7] * FP8_SA_PRE2);
            res[u] = w8; } }
        pi0 = i0;
    }
#undef N2_LOAD
}

constexpr int N_PHASES = 16;
constexpr int LDS_BYTES = 147456;
constexpr int MISC_OFF = 131072;

__global__ void __launch_bounds__(NTHR, 2) mlstm_conformer_fwd(Params p) {
    extern __shared__ __attribute__((aligned(16))) unsigned char lds_raw[];
    Frame F; F.lds = (LAS unsigned char*)lds_raw; F.wave = __builtin_amdgcn_readfirstlane((int)threadIdx.x >> 6); F.lane = lane_id(); F.tid = F.wave * 64 + F.lane;
    F.G = gridDim.x; F.bx = blockIdx.x; F.vcu = (F.G % 8 == 0) ? (F.bx % 8) * (F.G / 8) + F.bx / 8 : F.bx;
    volatile LAS unsigned* MISC = (volatile LAS unsigned*)(F.lds + MISC_OFF);
    if (F.tid < 64) MISC[F.tid] = 0u;
    __syncthreads();
    unsigned char* ws = p.ws;
#if MK_LAUNCHES == 1
    XcdBarrier bar = xcd_barrier_post((unsigned*)(ws + WS_BAR), MISC + 8, F.wave);
#define GRID_BAR() xcd_barrier(bar)
#else
#define GRID_BAR() do { } while (0)
#endif
    const int lo = p.ph_lo, hi = p.ph_hi;
#ifndef PHMASK
#define PHMASK 0xFFFF
#endif
#define IN(k) (((PHMASK >> (k)) & 1) && lo <= (k) && (k) < hi)
#define SEAM(k) do { if (IN(k) && IN((k) + 1)) GRID_BAR(); } while (0)
    LAS unsigned char* ring = F.lds;

#ifndef P5PARTS
#define P5PARTS 7
#endif
#ifndef REPMASK
#define REPMASK 0
#endif
#define NREP(k) ((((REPMASK) >> (k)) & 1) + 1)
#define RUN(k, ...) do { if (IN(k)) { _Pragma("unroll") for (int rep = 0; rep < NREP(k); ++rep) { F.dry = rep; { int t_ = F.wave * 64 + lane_id(); asm volatile("" : "+v"(t_)); F.tid = t_; F.lane = t_ & 63; } __VA_ARGS__; if (rep + 1 < NREP(k)) GRID_BAR(); } } SEAM(k); } while (0)
    F.dry = 0;
    RUN(0, phase_prologue(F, p));
    RUN(1, {
        const bool side_first = ((F.bx & 7) & 1) != 0;
        if (side_first) { transpose_weight_fp8(F, p.w_down, INNER, DM, ws + WS_WDOWN, FP8_SB_W); __syncthreads(); }
        { g8::DenseSched S; S.init(ws + WS_XQ, ws + WS_WZQ, TT, INNER, DM, F.G, (F.G == 256) ? ((F.bx + 192) & 255) : F.bx); S.wave = F.wave;
          if (F.G == 256) { S.rag_r0 = 7; S.rag_w1 = 192; S.rag_w2 = 128; }
          EpiUp E{(bf16_t*)(ws + WS_SZ), 1, 1.0f / (FP8_SA_X * FP8_SB_WZ)};
          g8::gemm_phase<EpiUp, g8::DenseSched, false, true>(ring, DM, DM, S, E); }
        { g8::DenseSched S; S.init(ws + WS_XB, ws + WS_WUP, TT, INNER, DM * 2, F.G, F.bx); S.wave = F.wave;
          EpiUp E{(bf16_t*)(ws + WS_XM), 0, 1.0f};
          g8::gemm_phase<EpiUp, g8::DenseSched, false, false>(ring, DM * 2, DM * 2, S, E); }
        if (!side_first) transpose_weight_fp8(F, p.w_down, INNER, DM, ws + WS_WDOWN, FP8_SB_W); });
    RUN(2, phase_passA(F, p));
    RUN(3, { for (int it = F.vcu; it < 32; it += F.G) scan_prompt(F, p, it); });
    RUN(4, { for (int it = F.G - 1 - F.vcu; it < 128; it += F.G) sample_prep(F, p, it);
             phase_passB(F, p); });
    RUN(5, {
        const bool cell_first = ((F.bx & 7) & 1) != 0;
        if ((P5PARTS & 4) && cell_first) _Pragma("unroll") for (int r2 = 0; r2 < NREP(18); ++r2) phase_sample_cell(F, p);
        if (P5PARTS & 1) _Pragma("unroll") for (int r2 = 0; r2 < NREP(16); ++r2) {
          { SchedS S{(const char*)(ws + WS_QP), (const char*)(ws + WS_XA), F.G, F.vcu, 0, F.wave};
            EpiS E{(bf16_t*)(ws + WS_S), (const float*)(ws + WS_CS), (const float*)(ws + WS_MX), (float*)(ws + WS_DEN), F.dry | r2, 1.0f, 0};
            g8::gemm_phase<EpiS, SchedS, false, false>(ring, INNER * 2, INNER * 2, S, E); }
          { SchedS S{(const char*)p.out + O8_Q8, (const char*)p.out + O8_XA8, F.G, (F.G == 256) ? ((F.vcu + 32) & 255) : F.vcu, 1, F.wave};
            EpiS E{(bf16_t*)(ws + WS_S), (const float*)(ws + WS_CS), (const float*)(ws + WS_MX), (float*)(ws + WS_DEN), F.dry | r2, 1.0f, 1};
            g8::gemm_phase<EpiS, SchedS, false, true>(ring, INNER, INNER, S, E, 0x75757575  , 0x7b7b7b7b  ); } }
        if (P5PARTS & 2) _Pragma("unroll") for (int r2 = 0; r2 < NREP(17); ++r2) { SchedState S{(const char*)(ws + WS_KWT), (const char*)(ws + WS_VT), F.G, F.vcu, F.wave};
          EpiState E{p.out + O_PC};
          g8::gemm_phase<EpiState, SchedState, false>(ring, TPP * 2, TPP * 2, S, E); }
        if ((P5PARTS & 4) && !cell_first) _Pragma("unroll") for (int r2 = 0; r2 < NREP(18); ++r2) phase_sample_cell(F, p); });
    RUN(6, {
        SchedSV S{(const char*)(ws + WS_S8), (const char*)(ws + WS_S16), (const char*)(ws + WS_VT8), (const char*)(ws + WS_VT), F.G, F.vcu, F.wave};
        EpiSV E{(bf16_t*)(ws + WS_H), (const float*)(ws + WS_DEN), (const float*)(ws + WS_EM)};
        g8::gemm_phase_mixed<EpiSV, SchedSV>(ring, P8, TPP * 2, S, E, 0x7b7b7b7b  , 0x79797979  ); });
    RUN(7, phase_predown(F, p));
    RUN(8, {
        const bool side_first = ((F.bx & 7) & 1) != 0;
        if (side_first) { transpose_weight(F, p.w_cin, DM, 3 * DM, (bf16_t*)(ws + WS_WCIN), true, ws + WS_WCINQ, FP8_SB_WCIN); transpose_weight_fp8(F, p.w_cout, DM, DM, ws + WS_WCOUT, FP8_SB_W); __syncthreads(); }
        g8::DenseSched S; S.init(ws + WS_PRE, ws + WS_WDOWN, TT, DM, INNER, F.G, F.bx, TP / 256, 8); S.wave = F.wave;
        EpiRes E{p.x_prompt, p.x_sample, nullptr, (bf16_t*)(ws + WS_R), (float*)(ws + WS_PART), 1.0f / (FP8_SA_PRE * FP8_SB_W), (float*)(ws + WS_RST0), nullptr, nullptr, nullptr, nullptr};
        g8::gemm_phase<EpiRes, g8::DenseSched, false, true>(ring, INNER, INNER, S, E);
        if (!side_first) { transpose_weight(F, p.w_cin, DM, 3 * DM, (bf16_t*)(ws + WS_WCIN), true, ws + WS_WCINQ, FP8_SB_WCIN); transpose_weight_fp8(F, p.w_cout, DM, DM, ws + WS_WCOUT, FP8_SB_W); } });
    RUN(9, {
        ln_rows(F, (const bf16_t*)(ws + WS_R), (const float*)(ws + WS_RST0), (const float*)(ws + WS_PART), p.pln_g, p.pln_b, nullptr, (float*)(ws + WS_X1F), (bf16_t*)(ws + WS_X1B), ws + WS_X1Q, (float*)(ws + WS_LNST));
        });
    RUN(10, {
        { g8::DenseSched S; if (F.G == 256) S.init(ws + WS_X1B, ws + WS_WCIN, 6 * 256, 3 * DM, DM * 2, 144, F.bx < 144 ? F.bx : 100000); else S.init(ws + WS_X1B, ws + WS_WCIN, 6 * 256, 3 * DM, DM * 2, F.G, F.bx);
          S.wave = F.wave; S.pmode = 2;
          EpiCin E{(bf16_t*)(ws + WS_U), (bf16_t*)(ws + WS_SZG), p.b_cin, 1.0f};
          g8::gemm_phase<EpiCin, g8::DenseSched, false, false>(ring, DM * 2, DM * 2, S, E); }
        { g8::DenseSched S; S.init(ws + WS_X1Q, ws + WS_WCINQ, 60 * 256, 3 * DM, DM, F.G, (F.G == 256) ? ((F.bx + 112) & 255) : F.bx); S.wave = F.wave; S.pmode = 1;
          if (F.G == 256) { S.rag_r0 = 10; S.rag_w1 = 112; S.rag_w2 = 112; S.rag_w3 = 96; }
          EpiCin E{(bf16_t*)(ws + WS_U), (bf16_t*)(ws + WS_SZG), p.b_cin, 1.0f / (FP8_SA_X1 * FP8_SB_WCIN)};
          g8::gemm_phase<EpiCin, g8::DenseSched, false, true>(ring, DM, DM, S, E); } });
    RUN(11, phase_conv31(F, p));
    RUN(12, phase_norm2(F, p));
    RUN(13, {
        g8::DenseSched S; S.init(ws + WS_PRE2, ws + WS_WCOUT, TT, DM, DM, F.G, F.bx, TP / 256, 8); S.wave = F.wave;
        EpiRes E{nullptr, (const float*)(ws + WS_X1F), p.b_cout, (bf16_t*)(ws + WS_R2), (float*)(ws + WS_PART), 1.0f / (FP8_SA_PRE2 * FP8_SB_W), (float*)(ws + WS_RST1), (const bf16_t*)(ws + WS_R), (const float*)(ws + WS_LNST), p.pln_g, p.pln_b};
        g8::gemm_phase<EpiRes, g8::DenseSched, false, true>(ring, DM, DM, S, E); });
    RUN(14, ln_rows(F, (const bf16_t*)(ws + WS_R2), (const float*)(ws + WS_RST1), (const float*)(ws + WS_PART), p.pln_g + DM, p.pln_b + DM, p.out + O_YP, p.out + O_YS, nullptr, nullptr, nullptr));
#undef RUN
#undef NREP
#undef IN
#undef SEAM
}

extern "C" void kernel_launch(void* const* d_in, const int* in_sizes, int n_in, void* d_out, int out_size, void* d_ws, size_t ws_size, hipStream_t stream) {
    static int grid = 0;
    if (grid == 0) {
        if (n_in != 28 || (size_t)out_size != O_END || ws_size < WS_END) { fprintf(stderr, "kernel_launch: unexpected shapes (n_in %d, out %d, ws %zu); nothing launched\n", n_in, out_size, ws_size); grid = -1; return; }
        int dev = 0, cus = 0;
        if (hipGetDevice(&dev) != hipSuccess || hipDeviceGetAttribute(&cus, hipDeviceAttributeMultiprocessorCount, dev) != hipSuccess) { grid = -1; return; }
        if (hipFuncSetAttribute((const void*)mlstm_conformer_fwd, hipFuncAttributeMaxDynamicSharedMemorySize, LDS_BYTES) != hipSuccess) { fprintf(stderr, "kernel_launch: hipFuncSetAttribute failed\n"); grid = -1; return; }
        int per_cu = 0;
        if (hipOccupancyMaxActiveBlocksPerMultiprocessor(&per_cu, (const void*)mlstm_conformer_fwd, NTHR, LDS_BYTES) != hipSuccess || per_cu < 1) { fprintf(stderr, "kernel_launch: occupancy query says %d\n", per_cu); }
        (void)hipGetLastError();
        grid = cus;
    }
    if (grid < 0) return;
    (void)hipMemsetAsync((char*)d_ws, 0, WS_GATES, stream);
    Params p{};
    const float** pf = (const float**)&p;
    for (int i = 0; i < 28; ++i) pf[i] = (const float*)d_in[i];
    p.out = (float*)d_out; p.ws = (unsigned char*)d_ws;
#if MK_LAUNCHES == 1
    p.ph_lo = 0; p.ph_hi = N_PHASES;
    hipLaunchKernelGGL(mlstm_conformer_fwd, dim3(grid), dim3(NTHR), LDS_BYTES, stream, p);
#else
    for (int k = 0; k < 15; ++k) { p.ph_lo = k; p.ph_hi = k + 1; hipLaunchKernelGGL(mlstm_conformer_fwd, dim3(grid), dim3(NTHR), LDS_BYTES, stream, p); }
#endif
}
```

```cpp
#include <hip/hip_runtime.h>
#include <cstdio>
#include <cstdint>

#ifndef MK_LAUNCHES
#define MK_LAUNCHES 1
#endif

#define LAS __attribute__((address_space(3)))
typedef unsigned short bf16_t;
typedef short bf16x8 __attribute__((ext_vector_type(8)));
typedef float f32x4 __attribute__((ext_vector_type(4)));
typedef float f32x16 __attribute__((ext_vector_type(16)));
typedef unsigned u32x4 __attribute__((ext_vector_type(4)));
typedef unsigned u32x2 __attribute__((ext_vector_type(2)));
#define DI __device__ __forceinline__

constexpr int DM = 4096, INNER = 8192, NH = 8, DKV = 1024;
constexpr int TPP = 16384 + 64;
constexpr int TP = 16384, TS = 512, TT = TP + TS;
constexpr float ALPHA = 1.41421356237309515f, LN_EPS = 1e-5f;
constexpr int NWAVES = 8, NTHR = 512;

constexpr size_t O_YP = 0, O_YS = 67108864, O_PC = 69206016, O_PN = 102760448, O_PM = 102793216, O_PMC = 102793248, O_PCC = 102891552,
                 O_SC = 103383072, O_SN = 237600800, O_SM = 237731872, O_SMC = 237732000, O_SCC = 238125216, O_END = 240091296;

constexpr size_t MiB = 1u << 20;
constexpr size_t O8_Q8 = 0, O8_XA8 = (size_t)TP * INNER;
constexpr size_t WS_BAR = 0;
constexpr size_t WS_GATES = 64 * 1024;
constexpr size_t WS_DEN = WS_GATES + (size_t)TT * 16 * 4;
constexpr size_t WS_STATS = WS_DEN + (size_t)TP * 8 * 4;
constexpr size_t WS_RST0 = WS_STATS + (size_t)TT * 2 * 4, WS_RST1 = WS_RST0 + (size_t)TP * 2 * 4;
constexpr size_t WS_ZERO_BYTES = 3 * MiB;
static_assert(WS_RST1 + (size_t)TP * 2 * 4 <= WS_ZERO_BYTES, "zero region");
constexpr size_t WS_CS = 3 * MiB, WS_MX = WS_CS + 512 * 1024, WS_EM = WS_MX + 512 * 1024;
constexpr size_t WS_MXL = WS_EM + 512 * 1024;
constexpr size_t WS_GT = 5 * MiB;
constexpr size_t WS_WDOWN = 8 * MiB;
constexpr size_t WS_SZ = 72 * MiB;
constexpr size_t WS_XA = 336 * MiB;
constexpr size_t WS_QP = 600 * MiB;
constexpr size_t WS_KWT = 856 * MiB;
constexpr size_t WS_VT = 1113 * MiB;
constexpr size_t WS_XM = 1370 * MiB;
constexpr size_t WS_XB = 600 * MiB, WS_WUP = 732 * MiB, WS_H = 600 * MiB, WS_PRE = 864 * MiB, WS_S = 1370 * MiB, WS_R = 1392 * MiB;
constexpr size_t WS_WCIN = 1656 * MiB, WS_WCOUT = 1752 * MiB, WS_X1F = 72 * MiB, WS_X1B = 336 * MiB, WS_U = 468 * MiB, WS_SZG = 600 * MiB, WS_C = 732 * MiB,
                 WS_PRE2 = 864 * MiB, WS_R2 = 1128 * MiB;
constexpr size_t WS_XQ = 864 * MiB, WS_WZQ = 930 * MiB;
constexpr size_t WS_X1Q = 996 * MiB, WS_WCINQ = 1062 * MiB;
constexpr size_t WS_LNST = 88 * MiB;
constexpr size_t WS_PART = 1784 * MiB;
constexpr size_t WS_S8 = 1370 * MiB, WS_S16 = 1580 * MiB, WS_VT8 = 1704 * MiB;
constexpr size_t S8_BH = (size_t)105 * 65536, S16_BH = (size_t)31 * 131072;
constexpr int P8 = 16384 + 128;
constexpr size_t WS_SMALL = 1914 * MiB;
constexpr size_t WS_SSP = WS_SMALL;
constexpr size_t WS_SQT = WS_SMALL + 1 * MiB;
constexpr size_t WS_SWK = WS_SMALL + 9 * MiB;
constexpr size_t WS_SVT = WS_SMALL + 17 * MiB;
constexpr size_t WS_HS = WS_SMALL + 25 * MiB;
constexpr size_t WS_END = WS_SMALL + 33 * MiB;
static_assert(WS_S + 544 * MiB <= WS_SMALL && WS_END <= 2048 * MiB, "ws map");

typedef __bf16 bf16v2_t __attribute__((ext_vector_type(2)));
typedef float f32v2_t __attribute__((ext_vector_type(2)));
DI unsigned pk_bf16(float lo, float hi) { const f32v2_t f = {lo, hi}; const bf16v2_t t = __builtin_convertvector(f, bf16v2_t); return __builtin_bit_cast(unsigned, t); }
DI float bf_lo(unsigned u) { return __uint_as_float(u << 16); }
DI float bf_hi(unsigned u) { return __uint_as_float(u & 0xffff0000u); }
DI float bf1(bf16_t b) { return __uint_as_float((unsigned)b << 16); }
DI bf16_t f2bf(float f) { return (bf16_t)(pk_bf16(f, 0.f) & 0xffffu); }
DI void unpack8(const u32x4 v, float (&f)[8]) { f[0] = bf_lo(v.x); f[1] = bf_hi(v.x); f[2] = bf_lo(v.y); f[3] = bf_hi(v.y); f[4] = bf_lo(v.z); f[5] = bf_hi(v.z); f[6] = bf_lo(v.w); f[7] = bf_hi(v.w); }
DI u32x4 pack8(const float (&f)[8]) { u32x4 v; v.x = pk_bf16(f[0], f[1]); v.y = pk_bf16(f[2], f[3]); v.z = pk_bf16(f[4], f[5]); v.w = pk_bf16(f[6], f[7]); return v; }
constexpr float FP8_SA_PRE = 8.0f, FP8_SA_PRE2 = 16.0f, FP8_SB_W = 4096.0f, FP8_SA_X1 = 16.0f, FP8_SB_WCIN = 1024.0f, FP8_SA_X = 16.0f, FP8_SB_WZ = 1024.0f, FP8_SA_Q = 1024.0f, FP8_SA_XA = 16.0f, FP8_SA_S = 64.0f, FP8_SA_V = 16.0f;
DI unsigned pk_fp8x4(float a, float b, float c, float d) {
    a = fminf(fmaxf(a, -448.f), 448.f); b = fminf(fmaxf(b, -448.f), 448.f); c = fminf(fmaxf(c, -448.f), 448.f); d = fminf(fmaxf(d, -448.f), 448.f);
    int r = 0; r = __builtin_amdgcn_cvt_pk_fp8_f32(a, b, r, false); r = __builtin_amdgcn_cvt_pk_fp8_f32(c, d, r, true); return (unsigned)r; }
DI float fexp(float x) { return __builtin_amdgcn_exp2f(x * 1.44269504088896341f); }
DI float frcp(float x) { return __builtin_amdgcn_rcpf(x); }
DI float fsilu(float x) { return x * frcp(1.0f + fexp(-x)); }
DI float fsigm(float x) { return frcp(1.0f + fexp(-x)); }
DI float logsig(float x) { return fminf(x, 0.f) - log1pf(expf(-fabsf(x))); }
#define LDS_BARRIER() do { asm volatile("s_waitcnt lgkmcnt(0)" ::: "memory"); __builtin_amdgcn_s_barrier(); asm volatile("" ::: "memory"); } while (0)
DI int lane_id() { int l; asm volatile("v_mbcnt_lo_u32_b32 %0, -1, 0\n\tv_mbcnt_hi_u32_b32 %0, -1, %0" : "=v"(l)); return l; }
template <class T> DI T ld_nt(const T* p) { return __builtin_nontemporal_load(p); }
template <class T> DI void st_nt(T* p, const T v) { __builtin_nontemporal_store(v, p); }
DI float wave_sum(float v) {
#pragma unroll
    for (int o = 1; o < 64; o <<= 1) v += __shfl_xor(v, o);
    return v;
}

#define XB_TMO      128
#define XB_XCNT(j)  (256  + 64 * (j))
#define XB_XSUB(j)  (1280 + 64 * (j))
#define XB_XGEN(j)  (2304 + 64 * (j))
#define XB_TOP      3328
#define XB_TOPGEN   3392
#define XCD_BAR_WORDS 3456
#define XB_SPIN_CAP (1u << 22)
__device__ __forceinline__ unsigned xb_ld(unsigned* p)              { return __hip_atomic_load(p, __ATOMIC_RELAXED, __HIP_MEMORY_SCOPE_AGENT); }
__device__ __forceinline__ unsigned xb_add(unsigned* p, unsigned v) { return __hip_atomic_fetch_add(p, v, __ATOMIC_RELAXED, __HIP_MEMORY_SCOPE_AGENT); }
__device__ __forceinline__ unsigned xb_xcc_id() { return (unsigned)__builtin_amdgcn_s_getreg((3 << 11) | 20) & 0xFu; }
#define XB_SPIN(cond, bar) do { unsigned _sp = 0; while (cond) { __builtin_amdgcn_s_sleep(1); \
    if ((++_sp & 255u) == 0u) { if (xb_ld(&(bar)[XB_TMO])) break; if (_sp > XB_SPIN_CAP) { atomicAdd(&(bar)[XB_TMO], 1u); break; } } } } while (0)
struct XcdBarrier { unsigned* bar; unsigned x; volatile LAS unsigned* st; int wave; };
__device__ __forceinline__ XcdBarrier xcd_barrier_post(unsigned* bar, volatile LAS unsigned* st, int wave) {
    XcdBarrier b; b.bar = bar; b.x = xb_xcc_id(); b.st = st; b.wave = wave;
    if (wave == 0 && lane_id() == 0) (void)xb_add(&bar[XB_XCNT(b.x)], 1u);
    return b;
}
__device__ __forceinline__ void xcd_barrier_complete(unsigned* bar, unsigned x, unsigned& nloc, unsigned& nx) {
    const unsigned G = gridDim.x * gridDim.y * gridDim.z;
    unsigned sum, cnt, mine, sp = 0u;
    for (;;) {
        sum = 0u; cnt = 0u; mine = 0u;
#pragma unroll
        for (unsigned j = 0; j < 16; ++j) { const unsigned c = xb_ld(&bar[XB_XCNT(j)]); sum += c; cnt += (c > 0u) ? 1u : 0u; mine = (j == x) ? c : mine; }
        if (sum == G) break;
        __builtin_amdgcn_s_sleep(1);
        if ((++sp & 255u) == 0u) { if (xb_ld(&bar[XB_TMO])) break; if (sp > XB_SPIN_CAP) { atomicAdd(&bar[XB_TMO], 1u); break; } }
    }
    nloc = mine > 0u ? mine : 1u; nx = cnt > 0u ? cnt : 1u;
}
__device__ __forceinline__ void xcd_barrier(const XcdBarrier& b) {
    asm volatile("s_waitcnt vmcnt(0)" ::: "memory");
    __syncthreads();
    if (b.wave == 0 && lane_id() == 0) {
        unsigned* bar = b.bar;
        __builtin_amdgcn_s_waitcnt(0);
        unsigned nloc = b.st[0], nx = b.st[1];
        if (nloc == 0u) { xcd_barrier_complete(bar, b.x, nloc, nx); b.st[0] = nloc; b.st[1] = nx; }
        const unsigned old = xb_add(&bar[XB_XSUB(b.x)], 1u);
        const unsigned gen = old / nloc;
        if (old + 1u == (gen + 1u) * nloc) {
            __builtin_amdgcn_fence(__ATOMIC_RELEASE, "agent");
            asm volatile("s_waitcnt vmcnt(0)" ::: "memory");
            const unsigned og = xb_add(&bar[XB_TOP], 1u);
            const unsigned tg = og / nx;
            if (og + 1u == (tg + 1u) * nx) xb_add(&bar[XB_TOPGEN], 1u);
            else XB_SPIN(xb_ld(&bar[XB_TOPGEN]) == tg, bar);
            __builtin_amdgcn_fence(__ATOMIC_ACQUIRE, "agent");
            xb_add(&bar[XB_XGEN(b.x)], 1u);
            asm volatile("s_waitcnt vmcnt(0)" ::: "memory");
        } else {
            XB_SPIN(xb_ld(&bar[XB_XGEN(b.x)]) == gen, bar);
            __builtin_amdgcn_fence(__ATOMIC_ACQUIRE, "agent");
            asm volatile("s_waitcnt vmcnt(0)" ::: "memory");
        }
    }
    __syncthreads();
}

namespace g8 {
constexpr int BM = 256, BK = 64, HALF = 128, HTB = HALF * BK * 2, STAGE_BYTES = 8 * HTB, NXCD = 8, WGM = 8;
__host__ __device__ __forceinline__ int lds_byte(int r, int c) { const int st = (r >> 4) * 2 + (c >> 5), rr = r & 15, cc = c & 31, ob = rr * 64 + cc * 2; return st * 1024 + (ob ^ (((ob >> 9) & 1) << 5)); }
__host__ __device__ __forceinline__ void stage_rc(int b, int& R, int& C) { const int st = b / 1024, sb = b % 1024, swz = sb ^ (((sb >> 9) & 1) << 5); R = (st >> 1) * 16 + swz / 64; C = (st & 1) * 32 + (swz % 64) / 2; }
__host__ __device__ __forceinline__ int perm32(int rho) { const int n = rho >> 4, i = rho & 15; return 8 * (i >> 2) + 4 * n + (i & 3); }

typedef int i32x8 __attribute__((ext_vector_type(8)));
DI i32x8 cat8(const bf16x8 lo, const bf16x8 hi) { const u32x4 a = __builtin_bit_cast(u32x4, lo), b = __builtin_bit_cast(u32x4, hi); i32x8 r; r[0] = (int)a.x; r[1] = (int)a.y; r[2] = (int)a.z; r[3] = (int)a.w; r[4] = (int)b.x; r[5] = (int)b.y; r[6] = (int)b.z; r[7] = (int)b.w; return r; }
struct GUnit { const char* A; const char* B; int nt; int i0, i1, i2; };

struct DenseSched {
    int wave;
    const char* A; const char* B; size_t tstepA, tstepB; int nM, nN, nMf, ksp, G, c, nt, pmode;
    DI void init(const void* A_, const void* B_, int M, int N, int Kbytes, int G_, int c_, int nMfull = -1, int ksp_ = 0) { A = (const char*)A_; B = (const char*)B_; tstepA = (size_t)BM * Kbytes; tstepB = (size_t)BM * Kbytes; nM = M / BM; nN = N / BM;
        nMf = nMfull < 0 ? nM : nMfull; ksp = ksp_; G = G_; c = c_; nt = Kbytes / 128; pmode = 0; }
    int rag_r0 = -1, rag_w1 = 0, rag_w2 = 0, rag_w3 = 0;
    DI bool next(int i, GUnit& u) const {
        long L = (long)i * G + c; const int nwg = nMf * nN;
        if (rag_r0 >= 0 && i >= rag_r0) { if (i == rag_r0) { if (c >= rag_w1) return false; } else if (i == rag_r0 + 1) { if (c >= rag_w2) return false; L = (long)rag_r0 * G + rag_w1 + c; }
            else if (i == rag_r0 + 2) { if (c >= rag_w3) return false; L = (long)rag_r0 * G + rag_w1 + rag_w2 + c; } else return false; }
        if (L >= nwg) {
            if (!ksp) return false;
            const int L2 = (int)(L - nwg); if (L2 >= (nM - nMf) * nN * ksp) return false;
            const int sp = L2 % ksp, uu = L2 / ksp, pm = nMf + uu / nN, pn = uu % nN, ntu = nt / ksp;
            u.A = A + (size_t)pm * tstepA + (size_t)sp * ntu * 128; u.B = B + (size_t)pn * tstepB + (size_t)sp * ntu * 128; u.nt = ntu; u.i0 = 1 + sp; u.i1 = pm; u.i2 = pn; return true; }
        int wgid = (int)L; { const int q = nwg / NXCD, r = nwg % NXCD, xcd = wgid % NXCD, off = wgid / NXCD; wgid = (xcd < r ? xcd * (q + 1) : r * (q + 1) + (xcd - r) * q) + off; }
        const int nig = WGM * nN, gid = wgid / nig, fm = gid * WGM, gsz = (nMf - fm) < WGM ? (nMf - fm) : WGM;
        int pm = fm + ((wgid % nig) % gsz); const int pn = (wgid % nig) / gsz;
        if (pmode == 1) pm += pm / 15; else if (pmode == 2) pm = pm < 4 ? 16 * pm + 15 : 60 + pm;
        u.A = A + (size_t)pm * tstepA; u.B = B + (size_t)pn * tstepB; u.nt = nt; u.i0 = 0; u.i1 = pm; u.i2 = pn; return true;
    }
};

template <class Epi, class Sched, bool ATILED, bool FP8 = false>
__device__ __forceinline__ void gemm_phase(LAS unsigned char* lds, const unsigned ldaB, const unsigned ldbB, const Sched& S, const Epi& E, const int fp8_scale_a = 0x7f7f7f7f, const int fp8_scale_b = 0x7f7f7f7f) {
    const int wid = __builtin_amdgcn_readfirstlane(S.wave);
    int tid = wid * 64 + lane_id(); asm volatile("" : "+v"(tid));
    const int lane = tid & 63, wr = wid >> 2, wc = wid & 3, fr = lane & 15, fq = lane >> 4;
    unsigned voffA[2], voffB[2];
#pragma unroll
    for (int i = 0; i < 2; ++i) { int R, C; stage_rc(tid * 16 + i * 8192, R, C); const int Rb = Epi::PERM ? ((R & ~31) + perm32(R & 31)) : R;
        voffA[i] = (unsigned)R * ldaB + (unsigned)C * 2u; voffB[i] = (unsigned)Rb * ldbB + (unsigned)C * 2u; }
    const size_t kstep = (size_t)(BK * 2);
    const size_t hstepA = (size_t)HALF * ldaB, hstepB = (size_t)HALF * ldbB;
    const unsigned ldsw = (unsigned)wid * 1024u;
    const int aoff = lds_byte(wr * 64 + fr, fq * 8), boff = lds_byte(wc * 32 + fr, fq * 8);
#define G8_KA(p, kt) (ATILED ? ((p) + (size_t)((kt) >> 2) * 131072u + (size_t)((kt) & 3) * 128u) : ((p) + (size_t)(kt) * 128u))
#define G8_SA(b, h) (((b) * 2 + (h)) * HTB)
#define G8_SB(b, h) ((4 + (b) * 2 + (h)) * HTB)
#define G8_STAGE(bufoff, gbase, voff) do { _Pragma("unroll") for (int _i = 0; _i < 2; ++_i) \
        __builtin_amdgcn_global_load_lds((const unsigned*)((const char*)(gbase) + (voff)[_i]), (LAS unsigned*)(lds + (bufoff) + ldsw + _i * 8192), 16, 0, 0); } while (0)
#define G8_RDA(b, h, m, k) (*(const LAS bf16x8*)(lds + G8_SA(b, h) + aoff + (m) * 2048 + (k) * 1024))
#define G8_RDB(b, h, n, k) (*(const LAS bf16x8*)(lds + G8_SB(b, h) + boff + (n) * 2048 + (k) * 1024))
#define G8_LDA(dst, b, h) do { _Pragma("unroll") for (int m = 0; m < 4; ++m) { if constexpr (FP8) dst##8[m] = cat8(G8_RDA(b, h, m, 0), G8_RDA(b, h, m, 1)); else { dst[m][0] = G8_RDA(b, h, m, 0); dst[m][1] = G8_RDA(b, h, m, 1); } } } while (0)
#define G8_LDB(dst, b, h) do { _Pragma("unroll") for (int n = 0; n < 2; ++n) { if constexpr (FP8) dst##8[n] = cat8(G8_RDB(b, h, n, 0), G8_RDB(b, h, n, 1)); else { dst[n][0] = G8_RDB(b, h, n, 0); dst[n][1] = G8_RDB(b, h, n, 1); } } } while (0)
#define G8_MMA(ai, bj, At, Bt) do { __builtin_amdgcn_s_setprio(1); _Pragma("unroll") for (int m = 0; m < 4; ++m) _Pragma("unroll") for (int n = 0; n < 2; ++n) { \
        if constexpr (FP8) { asm volatile("v_mfma_scale_f32_16x16x128_f8f6f4 %0, %1, %2, %0, %3, %4 op_sel_hi:[0,0,0]" : "+v"(acc[ai][bj][m][n]) : "v"(Bt##8[n]), "v"(At##8[m]), "v"(fp8_sb_v), "v"(fp8_sa_v)); } \
        else { _Pragma("unroll") for (int k = 0; k < 2; ++k) acc[ai][bj][m][n] = __builtin_amdgcn_mfma_f32_16x16x32_bf16(Bt[n][k], At[m][k], acc[ai][bj][m][n], 0, 0, 0); } } \
        __builtin_amdgcn_s_setprio(0); } while (0)
#define G8_WAIT_V(n) asm volatile("s_waitcnt vmcnt(" #n ")" ::: "memory")
#define G8_WAIT_L(n) asm volatile("s_waitcnt lgkmcnt(" #n ")" ::: "memory")
#define G8_BAR __builtin_amdgcn_s_barrier()
#define G8_SCHED __builtin_amdgcn_sched_barrier(0)
    GUnit cur, nxt; int ui = 0;
    if (!S.next(0, cur)) return;
    f32x4 acc[2][2][4][2];
#pragma unroll
    for (int a = 0; a < 2; ++a)
#pragma unroll
        for (int b = 0; b < 2; ++b)
#pragma unroll
            for (int m = 0; m < 4; ++m)
#pragma unroll
                for (int n = 0; n < 2; ++n) acc[a][b][m][n] = (f32x4){0.f, 0.f, 0.f, 0.f};
    const int fp8_sb_v = fp8_scale_b, fp8_sa_v = fp8_scale_a;
    bf16x8 At[4][2], B0[2][2], B1[2][2]; i32x8 At8[4], B08[2], B18[2];
    const char* cA = cur.A; const char* cB = cur.B;
    G8_STAGE(G8_SB(0, 0), cB, voffB); G8_STAGE(G8_SB(0, 1), cB + hstepB, voffB); G8_STAGE(G8_SA(0, 0), cA, voffA); G8_STAGE(G8_SA(0, 1), cA + hstepA, voffA);
    if (wr == 1) G8_BAR;
    G8_WAIT_V(2); G8_BAR;
    G8_STAGE(G8_SB(1, 0), cB + kstep, voffB); G8_STAGE(G8_SA(1, 0), G8_KA(cA, 1), voffA); G8_STAGE(G8_SB(1, 1), cB + hstepB + kstep, voffB);
    G8_WAIT_V(6); G8_BAR;
    for (;;) {
        const bool has_next = S.next(ui + 1, nxt);
        const char* nA = has_next ? nxt.A : cA; const char* nB = has_next ? nxt.B : cB;
        const int nt = cur.nt;
        for (int t = 0; t < nt; t += 2) {
            const bool last = (t == nt - 2);
            const char* a1 = G8_KA(cA, t + 1);
            const char* a2 = last ? nA : G8_KA(cA, t + 2); const char* b2 = last ? nB : cB + (size_t)(t + 2) * kstep;
            const char* a3 = a2 + kstep; const char* b3 = b2 + kstep;
            G8_LDB(B0, 0, 0); G8_LDB(B1, 0, 1); G8_SCHED; G8_LDA(At, 0, 0); G8_STAGE(G8_SA(1, 1), a1 + hstepA, voffA);
            G8_WAIT_V(8); G8_WAIT_L(0); G8_BAR; G8_MMA(0, 0, At, B0); G8_MMA(0, 1, At, B1); G8_BAR; G8_SCHED;
            G8_LDA(At, 0, 1); G8_STAGE(G8_SB(0, 0), b2, voffB); G8_STAGE(G8_SB(0, 1), b2 + hstepB, voffB); G8_STAGE(G8_SA(0, 0), a2, voffA);
            G8_WAIT_V(8); G8_WAIT_L(0); G8_BAR; G8_MMA(1, 0, At, B0); G8_MMA(1, 1, At, B1); G8_BAR; G8_SCHED;
            G8_LDB(B0, 1, 0); G8_LDB(B1, 1, 1); G8_SCHED; G8_LDA(At, 1, 0); G8_STAGE(G8_SA(0, 1), a2 + hstepA, voffA);
            G8_WAIT_V(8); G8_WAIT_L(0); G8_BAR; G8_MMA(0, 0, At, B0); G8_MMA(0, 1, At, B1); G8_BAR; G8_SCHED;
            G8_LDA(At, 1, 1); G8_STAGE(G8_SB(1, 0), b3, voffB); G8_STAGE(G8_SB(1, 1), b3 + hstepB, voffB); G8_STAGE(G8_SA(1, 0), a3, voffA);
            G8_WAIT_V(8); G8_WAIT_L(0); G8_BAR; G8_MMA(1, 0, At, B0); G8_MMA(1, 1, At, B1); G8_BAR; G8_SCHED;
        }
        if constexpr (FP8) asm volatile("s_nop 15\n\ts_nop 15\n\ts_nop 15" ::: "memory");
        if (wr == 0) G8_BAR;
        E(acc, cur, wr, wc, fr, fq);
        if (!has_next) break;
#pragma unroll
        for (int a = 0; a < 2; ++a)
#pragma unroll
            for (int b = 0; b < 2; ++b)
#pragma unroll
                for (int m = 0; m < 4; ++m)
#pragma unroll
                    for (int n = 0; n < 2; ++n) acc[a][b][m][n] = (f32x4){0.f, 0.f, 0.f, 0.f};
        cur = nxt; cA = nA; cB = nB; ++ui;
        if (wr == 1) G8_BAR;
    }
    G8_WAIT_V(0);
    G8_BAR;
#undef G8_KA
#undef G8_SA
#undef G8_SB
#undef G8_STAGE
#undef G8_LDA
#undef G8_RDA
#undef G8_RDB
#undef G8_LDB
#undef G8_MMA
#undef G8_WAIT_V
#undef G8_WAIT_L
#undef G8_BAR
#undef G8_SCHED
}

struct GUnitM { const char* A8; const char* B8; const char* A16; const char* B16; int nt8, nt; int i0, i1, i2; };
typedef int i32x4 __attribute__((ext_vector_type(4)));
template <class Epi, class Sched>
__device__ __forceinline__ void gemm_phase_mixed(LAS unsigned char* lds, const unsigned ldb8, const unsigned ldb16, const Sched& S, const Epi& E, const int scale_b8, const int scale_a8) {
    const int wid = __builtin_amdgcn_readfirstlane(S.wave);
    int tid = wid * 64 + lane_id(); asm volatile("" : "+v"(tid));
    const int lane = tid & 63, wr = wid >> 2, wc = wid & 3, fr = lane & 15, fq = lane >> 4;
    unsigned voffA8[2], rowB[2];
#pragma unroll
    for (int i = 0; i < 2; ++i) { int R, C; stage_rc(tid * 16 + i * 8192, R, C); const int Rb = Epi::PERM ? ((R & ~31) + perm32(R & 31)) : R;
        voffA8[i] = (unsigned)R * 256u + (unsigned)C * 2u; rowB[i] = (unsigned)Rb; }
#define GM_VA(is8, i) ((is8) ? voffA8[i] : voffA8[i] + (voffA8[i] & ~255u))
#define GM_VB(is8, i) (rowB[i] * ((is8) ? ldb8 : ldb16) + (voffA8[i] & 255u))
    const unsigned ldsw = (unsigned)wid * 1024u;
    const int aoff = lds_byte(wr * 64 + fr, fq * 8), boff = lds_byte(wc * 32 + fr, fq * 8);
#define GM_SA(b, h) (((b) * 2 + (h)) * HTB)
#define GM_SB(b, h) ((4 + (b) * 2 + (h)) * HTB)
#define GM_PA(u, kt) ((kt) < (u).nt8 ? (u).A8 + (size_t)((kt) >> 1) * 65536u + (size_t)((kt) & 1) * 128u : (u).A16 + (size_t)(((kt) - (u).nt8) >> 2) * 131072u + (size_t)(((kt) - (u).nt8) & 3) * 128u)
#define GM_PB(u, kt) ((kt) < (u).nt8 ? (u).B8 + (size_t)(kt) * 128u : (u).B16 + (size_t)((kt) - (u).nt8) * 128u)
#define GM_STAGE_A(bufoff, gbase, is8, half) do { const char* _g = (gbase) + ((half) ? ((is8) ? 32768u : 65536u) : 0u); _Pragma("unroll") for (int _i = 0; _i < 2; ++_i) \
        __builtin_amdgcn_global_load_lds((const unsigned*)(_g + GM_VA(is8, _i)), (LAS unsigned*)(lds + (bufoff) + ldsw + _i * 8192), 16, 0, 0); } while (0)
#define GM_STAGE_B(bufoff, gbase, is8, half) do { const char* _g = (gbase) + ((half) ? (size_t)HALF * ((is8) ? ldb8 : ldb16) : (size_t)0); _Pragma("unroll") for (int _i = 0; _i < 2; ++_i) \
        __builtin_amdgcn_global_load_lds((const unsigned*)(_g + GM_VB(is8, _i)), (LAS unsigned*)(lds + (bufoff) + ldsw + _i * 8192), 16, 0, 0); } while (0)
#define GM_RDA(b, h, m, k) (*(const LAS bf16x8*)(lds + GM_SA(b, h) + aoff + (m) * 2048 + (k) * 1024))
#define GM_RDB(b, h, n, k) (*(const LAS bf16x8*)(lds + GM_SB(b, h) + boff + (n) * 2048 + (k) * 1024))
#define GM_LDA8(b, h) do { _Pragma("unroll") for (int m = 0; m < 4; ++m) At8[m] = cat8(GM_RDA(b, h, m, 0), GM_RDA(b, h, m, 1)); } while (0)
#define GM_LDB8(dst, b, h) do { _Pragma("unroll") for (int n = 0; n < 2; ++n) dst##8[n] = cat8(GM_RDB(b, h, n, 0), GM_RDB(b, h, n, 1)); } while (0)
#define GM_LDA16(b, h) do { _Pragma("unroll") for (int m = 0; m < 4; ++m) { At[m][0] = GM_RDA(b, h, m, 0); At[m][1] = GM_RDA(b, h, m, 1); } } while (0)
#define GM_LDB16(dst, b, h) do { _Pragma("unroll") for (int n = 0; n < 2; ++n) { dst[n][0] = GM_RDB(b, h, n, 0); dst[n][1] = GM_RDB(b, h, n, 1); } } while (0)
#define GM_MMA8(ai, bj, Bt) do { __builtin_amdgcn_s_setprio(1); _Pragma("unroll") for (int m = 0; m < 4; ++m) _Pragma("unroll") for (int n = 0; n < 2; ++n) \
        asm volatile("v_mfma_scale_f32_16x16x128_f8f6f4 %0, %1, %2, %0, %3, %4 op_sel_hi:[0,0,0]" : "+v"(acc[ai][bj][m][n]) : "v"(Bt##8[n]), "v"(At8[m]), "v"(sb8_v), "v"(sa8_v)); \
        __builtin_amdgcn_s_setprio(0); } while (0)
#define GM_MMA16(ai, bj, Bt) do { __builtin_amdgcn_s_setprio(1); _Pragma("unroll") for (int m = 0; m < 4; ++m) _Pragma("unroll") for (int n = 0; n < 2; ++n) _Pragma("unroll") for (int k = 0; k < 2; ++k) \
        acc[ai][bj][m][n] = __builtin_amdgcn_mfma_f32_16x16x32_bf16(Bt[n][k], At[m][k], acc[ai][bj][m][n], 0, 0, 0); __builtin_amdgcn_s_setprio(0); } while (0)
#define GM_TRIP(LDA_, LDB_, MMA_, c8_) do { \
            const bool last = (t == nt - 2); \
            const char* a1 = GM_PA(cur, t) + 128; \
            bool n8; const char* a2; const char* b2; \
            if (!last) { n8 = (t + 2) < cur.nt8; a2 = GM_PA(cur, t + 2); b2 = GM_PB(cur, t + 2); } \
            else if (has_next) { n8 = 0 < nxt.nt8; a2 = GM_PA(nxt, 0); b2 = GM_PB(nxt, 0); } \
            else { n8 = 0 < cur.nt8; a2 = GM_PA(cur, 0); b2 = GM_PB(cur, 0); } \
            const char* a3 = a2 + 128; const char* b3 = b2 + 128; \
            LDB_(B0, 0, 0); LDB_(B1, 0, 1); GM_SCHED; LDA_(0, 0); GM_STAGE_A(GM_SA(1, 1), a1, c8_, 1); \
            GM_WAIT_V(8); GM_WAIT_L(0); GM_BAR; MMA_(0, 0, B0); MMA_(0, 1, B1); GM_BAR; GM_SCHED; \
            LDA_(0, 1); GM_STAGE_B(GM_SB(0, 0), b2, n8, 0); GM_STAGE_B(GM_SB(0, 1), b2, n8, 1); GM_STAGE_A(GM_SA(0, 0), a2, n8, 0); \
            GM_WAIT_V(8); GM_WAIT_L(0); GM_BAR; MMA_(1, 0, B0); MMA_(1, 1, B1); GM_BAR; GM_SCHED; \
            LDB_(B0, 1, 0); LDB_(B1, 1, 1); GM_SCHED; LDA_(1, 0); GM_STAGE_A(GM_SA(0, 1), a2, n8, 1); \
            GM_WAIT_V(8); GM_WAIT_L(0); GM_BAR; MMA_(0, 0, B0); MMA_(0, 1, B1); GM_BAR; GM_SCHED; \
            LDA_(1, 1); GM_STAGE_B(GM_SB(1, 0), b3, n8, 0); GM_STAGE_B(GM_SB(1, 1), b3, n8, 1); GM_STAGE_A(GM_SA(1, 0), a3, n8, 0); \
            GM_WAIT_V(8); GM_WAIT_L(0); GM_BAR; MMA_(1, 0, B0); MMA_(1, 1, B1); GM_BAR; GM_SCHED; } while (0)
#define GM_WAIT_V(n) asm volatile("s_waitcnt vmcnt(" #n ")" ::: "memory")
#define GM_WAIT_L(n) asm volatile("s_waitcnt lgkmcnt(" #n ")" ::: "memory")
#define GM_BAR __builtin_amdgcn_s_barrier()
#define GM_SCHED __builtin_amdgcn_sched_barrier(0)
    GUnitM cur, nxt; int ui = 0;
    if (!S.next(0, cur)) return;
    f32x4 acc[2][2][4][2];
#pragma unroll
    for (int a = 0; a < 2; ++a)
#pragma unroll
        for (int b = 0; b < 2; ++b)
#pragma unroll
            for (int m = 0; m < 4; ++m)
#pragma unroll
                for (int n = 0; n < 2; ++n) acc[a][b][m][n] = (f32x4){0.f, 0.f, 0.f, 0.f};
    const int sb8_v = scale_b8, sa8_v = scale_a8;
    i32x8 At8[4], B08[2], B18[2]; bf16x8 At[4][2], B0[2][2], B1[2][2];
    { const bool p8 = 0 < cur.nt8; const char* a0 = GM_PA(cur, 0); const char* b0 = GM_PB(cur, 0);
      GM_STAGE_B(GM_SB(0, 0), b0, p8, 0); GM_STAGE_B(GM_SB(0, 1), b0, p8, 1); GM_STAGE_A(GM_SA(0, 0), a0, p8, 0); GM_STAGE_A(GM_SA(0, 1), a0, p8, 1);
      if (wr == 1) GM_BAR;
      GM_WAIT_V(2); GM_BAR;
      GM_STAGE_B(GM_SB(1, 0), b0 + 128, p8, 0); GM_STAGE_A(GM_SA(1, 0), a0 + 128, p8, 0); GM_STAGE_B(GM_SB(1, 1), b0 + 128, p8, 1);
      GM_WAIT_V(6); GM_BAR; }
    for (;;) {
        const bool has_next = S.next(ui + 1, nxt);
        const int nt = cur.nt, nt8 = cur.nt8;
        for (int t = 0; t < nt8; t += 2) GM_TRIP(GM_LDA8, GM_LDB8, GM_MMA8, true);
        for (int t = nt8; t < nt; t += 2) GM_TRIP(GM_LDA16, GM_LDB16, GM_MMA16, false);
        asm volatile("s_nop 15\n\ts_nop 15\n\ts_nop 15" ::: "memory");
        if (wr == 0) GM_BAR;
        { int tz = lane_id(); asm volatile("" : "+v"(tz));
          const int ln = tz & 63; E(acc, cur, wr, wc, ln & 15, ln >> 4); }
        if (!has_next) break;
#pragma unroll
        for (int a = 0; a < 2; ++a)
#pragma unroll
            for (int b = 0; b < 2; ++b)
#pragma unroll
                for (int m = 0; m < 4; ++m)
#pragma unroll
                    for (int n = 0; n < 2; ++n) acc[a][b][m][n] = (f32x4){0.f, 0.f, 0.f, 0.f};
        cur = nxt; ++ui;
        if (wr == 1) GM_BAR;
    }
    GM_WAIT_V(0);
    GM_BAR;
#undef GM_VA
#undef GM_VB
#undef GM_SA
#undef GM_SB
#undef GM_PA
#undef GM_PB
#undef GM_STAGE_A
#undef GM_STAGE_B
#undef GM_RDA
#undef GM_RDB
#undef GM_LDA8
#undef GM_LDB8
#undef GM_LDA16
#undef GM_LDB16
#undef GM_MMA8
#undef GM_MMA16
#undef GM_TRIP
#undef GM_WAIT_V
#undef GM_WAIT_L
#undef GM_BAR
#undef GM_SCHED
}
}
using g8::GUnit;
using g8::GUnitM;
using g8::HALF;

struct Params {
    const float *x_prompt, *x_sample, *st_C, *st_n, *st_m, *st_mconv, *st_cconv;
    const float *w_up, *w_mconv, *b_mconv, *w_q, *w_k, *w_v, *w_gate, *b_gate, *mh_gain, *skip, *w_down;
    const float *w_cin, *b_cin, *w_dw, *b_dw, *cln_g, *cln_b, *w_cout, *b_cout, *pln_g, *pln_b;
    float* out; unsigned char* ws; int ph_lo, ph_hi;
};
struct Frame { LAS unsigned char* lds; int tid, lane, wave, G, bx, vcu, dry; };

struct EpiUp {
    static constexpr bool PERM = true;
    bf16_t* base; int act; float sc;
    DI void operator()(const f32x4 (&acc)[2][2][4][2], const GUnit& u, int wr, int wc, int fr, int fq) const {
        const int row0 = u.i1 * 256 + wr * 64 + fr, col0 = u.i2 * 256 + wc * 32 + 8 * fq;
#pragma unroll
        for (int ai = 0; ai < 2; ++ai)
#pragma unroll
            for (int m = 0; m < 4; ++m) { bf16_t* rowp = base + (size_t)(row0 + ai * HALF + m * 16) * INNER + col0;
#pragma unroll
                for (int bj = 0; bj < 2; ++bj) { f32x4 v0 = acc[ai][bj][m][0], v1 = acc[ai][bj][m][1];
                    if (act) {
#pragma unroll
                        for (int j = 0; j < 4; ++j) { v0[j] = fsilu(v0[j] * sc); v1[j] = fsilu(v1[j] * sc); } }
                    u32x4 w; w.x = pk_bf16(v0[0], v0[1]); w.y = pk_bf16(v0[2], v0[3]); w.z = pk_bf16(v1[0], v1[1]); w.w = pk_bf16(v1[2], v1[3]);
                    *(u32x4*)(rowp + bj * HALF) = w; } }
    }
};
struct EpiS {
    static constexpr bool PERM = true;
    bf16_t* Sb; const float* cs; const float* mx; float* den; int dry; float sc; int far;
    DI void operator()(const f32x4 (&acc)[2][2][4][2], const GUnit& u, int wr, int wc, int fr, int fq) const {
        const int bh = u.i0, pm = u.i1, pn = u.i2;
        bf16_t* tile = (bf16_t*)((unsigned char*)Sb + WS_S16 - WS_S + (size_t)bh * S16_BH + (size_t)(pm + pn) * 131072);
        unsigned char* tile8 = (unsigned char*)Sb + (size_t)bh * S8_BH + (size_t)((pm - 2) * (pm - 1) / 2 + pn) * 65536;
        const float* csb = cs + bh * 4096 + pn * 256; const float* mxb = mx + bh * 4096 + pm * 256; float* denb = den + bh * 4096 + pm * 256;
        const bool diag = (pm == pn);
        f32x4 cv[2][2];
#pragma unroll
        for (int bj = 0; bj < 2; ++bj)
#pragma unroll
            for (int n = 0; n < 2; ++n) cv[bj][n] = *(const f32x4*)(csb + bj * HALF + wc * 32 + 8 * fq + 4 * n);
#pragma unroll
        for (int ai = 0; ai < 2; ++ai)
#pragma unroll
            for (int m = 0; m < 4; ++m) { const int rloc = ai * HALF + wr * 64 + m * 16 + fr; const float mxt = mxb[rloc]; float rs = 0.f;
                const int rowlim = diag ? rloc - (wc * 32 + 8 * fq) : 0x10000;
#pragma unroll
                for (int bj = 0; bj < 2; ++bj) { f32x4 v[2];
#pragma unroll
                    for (int n = 0; n < 2; ++n) { v[n] = acc[ai][bj][m][n];
#pragma unroll
                        for (int j = 0; j < 4; ++j) { const bool masked = (bj * HALF + 4 * n + j) > rowlim;
                            const float d = masked ? 0.f : fexp(cv[bj][n][j] - mxt) * sc; v[n][j] *= d; rs += v[n][j]; } }
                    if (far) { u32x2 w8; w8.x = pk_fp8x4(v[0][0] * FP8_SA_S, v[0][1] * FP8_SA_S, v[0][2] * FP8_SA_S, v[0][3] * FP8_SA_S); w8.y = pk_fp8x4(v[1][0] * FP8_SA_S, v[1][1] * FP8_SA_S, v[1][2] * FP8_SA_S, v[1][3] * FP8_SA_S);
                        *(u32x2*)(tile8 + (size_t)rloc * 256 + bj * HALF + wc * 32 + 8 * fq) = w8; }
                    else { u32x4 w; w.x = pk_bf16(v[0][0], v[0][1]); w.y = pk_bf16(v[0][2], v[0][3]); w.z = pk_bf16(v[1][0], v[1][1]); w.w = pk_bf16(v[1][2], v[1][3]);
                        *(u32x4*)(tile + (size_t)rloc * 256 + bj * HALF + wc * 32 + 8 * fq) = w; } }
                rs += __shfl_xor(rs, 16); rs += __shfl_xor(rs, 32);
                if (fq == 0 && !dry) atomicAdd(denb + rloc, rs); }
    }
};
struct EpiState {
    static constexpr bool PERM = false;
    float* C;
    DI void operator()(const f32x4 (&acc)[2][2][4][2], const GUnit& u, int wr, int wc, int fr, int fq) const {
        float* base = C + ((size_t)u.i0 << 20);
        const int row0 = u.i1 * 256 + wr * 64 + fr, col0 = u.i2 * 256 + wc * 32 + 4 * fq;
#pragma unroll
        for (int ai = 0; ai < 2; ++ai)
#pragma unroll
            for (int m = 0; m < 4; ++m) { float* rowp = base + (size_t)(row0 + ai * HALF + m * 16) * 1024 + col0;
#pragma unroll
                for (int bj = 0; bj < 2; ++bj)
#pragma unroll
                    for (int n = 0; n < 2; ++n) st_nt((f32x4*)(rowp + bj * HALF + n * 16), acc[ai][bj][m][n]); }
    }
};
struct EpiSV {
    static constexpr bool PERM = true;
    bf16_t* hb; const float* den; const float* em;
    template <class U> DI void operator()(const f32x4 (&acc)[2][2][4][2], const U& u, int wr, int wc, int fr, int fq) const {
        const int bh = u.i0, pm = u.i1, pn = u.i2, b = bh >> 3, h = bh & 7;
        const float* denb = den + bh * 4096 + pm * 256; const float* emb = em + bh * 4096 + pm * 256;
        bf16_t* base = hb + (size_t)(b * 4096 + pm * 256) * INNER + h * 1024 + pn * 256 + wc * 32 + 8 * fq;
        float dn[2][4], ee[2][4];
#pragma unroll
        for (int ai = 0; ai < 2; ++ai)
#pragma unroll
            for (int m = 0; m < 4; ++m) { const int rloc = ai * HALF + wr * 64 + m * 16 + fr; dn[ai][m] = denb[rloc]; ee[ai][m] = emb[rloc]; }
        __builtin_amdgcn_sched_barrier(0);
#pragma unroll
        for (int ai = 0; ai < 2; ++ai)
#pragma unroll
            for (int m = 0; m < 4; ++m) { const int rloc = ai * HALF + wr * 64 + m * 16 + fr; const float g = 1.0f / fmaxf(fabsf(dn[ai][m]), ee[ai][m]);
#pragma unroll
                for (int bj = 0; bj < 2; ++bj) { const f32x4 v0 = acc[ai][bj][m][0] * g, v1 = acc[ai][bj][m][1] * g;
                    u32x4 w; w.x = pk_bf16(v0[0], v0[1]); w.y = pk_bf16(v0[2], v0[3]); w.z = pk_bf16(v1[0], v1[1]); w.w = pk_bf16(v1[2], v1[3]);
                    *(u32x4*)(base + (size_t)rloc * INNER + bj * HALF) = w; } }
    }
};
struct EpiRes {
    static constexpr bool PERM = true;
    const float* resA; const float* resB; const float* bias; bf16_t* r; float* part; float sc;
    float* rstat;
    const bf16_t* resLn; const float* lnst; const float* lng; const float* lnb;
    DI void operator()(const f32x4 (&acc)[2][2][4][2], const GUnit& u, int wr, int wc, int fr, int fq) const {
        const int pm = u.i1, row0 = pm * 256 + wr * 64 + fr, col0 = u.i2 * 256 + wc * 32 + 8 * fq;
        f32x4 bv[2][2];
#pragma unroll
        for (int bj = 0; bj < 2; ++bj)
#pragma unroll
            for (int n = 0; n < 2; ++n) bv[bj][n] = bias ? *(const f32x4*)(bias + col0 + bj * HALF + n * 4) : (f32x4){0.f, 0.f, 0.f, 0.f};
        if (u.i0 == 0) {
            f32x4 lg[2][2], lb[2][2];
            if (resLn) {
#pragma unroll
                for (int bj = 0; bj < 2; ++bj)
#pragma unroll
                    for (int n = 0; n < 2; ++n) { lg[bj][n] = *(const f32x4*)(lng + col0 + bj * HALF + n * 4); lb[bj][n] = *(const f32x4*)(lnb + col0 + bj * HALF + n * 4); }
                __builtin_amdgcn_sched_barrier(0);
#pragma unroll
                for (int bj = 0; bj < 2; ++bj)
#pragma unroll
                    for (int n = 0; n < 2; ++n) { lg[bj][n] = lg[bj][n] * ALPHA; lb[bj][n] = lb[bj][n] * ALPHA + bv[bj][n]; } }
#define ER_FINISH(xr_) do { f32x4 v[2]; \
                    _Pragma("unroll") for (int n = 0; n < 2; ++n) { v[n] = (xr_)[n] + acc[ai][bj][m][n] * sc; \
                        s1 += (v[n][0] + v[n][1]) + (v[n][2] + v[n][3]); s2 += (v[n][0] * v[n][0] + v[n][1] * v[n][1]) + (v[n][2] * v[n][2] + v[n][3] * v[n][3]); } \
                    u32x4 w; w.x = pk_bf16(v[0][0], v[0][1]); w.y = pk_bf16(v[0][2], v[0][3]); w.z = pk_bf16(v[1][0], v[1][1]); w.w = pk_bf16(v[1][2], v[1][3]); \
                    *(u32x4*)(r + ro + bj * HALF) = w; } while (0)
#define ER_STATS() do { s1 += __shfl_xor(s1, 16); s1 += __shfl_xor(s1, 32); s2 += __shfl_xor(s2, 16); s2 += __shfl_xor(s2, 32); \
                    if (fq == 0) { atomicAdd(rstat + (size_t)row * 2, s1); atomicAdd(rstat + (size_t)row * 2 + 1, s2); } } while (0)
#pragma unroll
        for (int ai = 0; ai < 2; ++ai) {
            if (resLn) {
                u32x4 rw[4][2]; float mn[4], rs[4];
#pragma unroll
                for (int m = 0; m < 4; ++m) { const int row = row0 + ai * HALF + m * 16; const size_t ro = (size_t)row * DM + col0;
                    mn[m] = lnst[(size_t)row * 2]; rs[m] = lnst[(size_t)row * 2 + 1];
#pragma unroll
                    for (int bj = 0; bj < 2; ++bj) rw[m][bj] = ld_nt((const u32x4*)(resLn + ro + bj * HALF)); }
                __builtin_amdgcn_sched_barrier(0);
#pragma unroll
                for (int m = 0; m < 4; ++m) { const int row = row0 + ai * HALF + m * 16; const size_t ro = (size_t)row * DM + col0; const float mean = mn[m], rstd = rs[m];
                    float s1 = 0.f, s2 = 0.f;
#pragma unroll
                    for (int bj = 0; bj < 2; ++bj) { const u32x4 q = rw[m][bj]; f32x4 xr[2];
                        xr[0] = ((f32x4){bf_lo(q.x), bf_hi(q.x), bf_lo(q.y), bf_hi(q.y)} - mean) * rstd * lg[bj][0] + lb[bj][0]; xr[1] = ((f32x4){bf_lo(q.z), bf_hi(q.z), bf_lo(q.w), bf_hi(q.w)} - mean) * rstd * lg[bj][1] + lb[bj][1];
                        ER_FINISH(xr); }
                    ER_STATS(); }
            } else {
#pragma unroll
              for (int mh = 0; mh < 4; mh += 2) {
                f32x4 xq[2][2][2];
#pragma unroll
                for (int m = mh; m < mh + 2; ++m) { const size_t ro = (size_t)(row0 + ai * HALF + m * 16) * DM + col0;
#pragma unroll
                    for (int bj = 0; bj < 2; ++bj) { xq[m - mh][bj][0] = ld_nt((const f32x4*)(resA + ro + bj * HALF)); xq[m - mh][bj][1] = ld_nt((const f32x4*)(resA + ro + bj * HALF + 4)); } }
                __builtin_amdgcn_sched_barrier(0);
#pragma unroll
                for (int m = mh; m < mh + 2; ++m) { const int row = row0 + ai * HALF + m * 16; const size_t ro = (size_t)row * DM + col0;
                    float s1 = 0.f, s2 = 0.f;
#pragma unroll
                    for (int bj = 0; bj < 2; ++bj) { f32x4 xr[2]; xr[0] = xq[m - mh][bj][0] * ALPHA + bv[bj][0]; xr[1] = xq[m - mh][bj][1] * ALPHA + bv[bj][1]; ER_FINISH(xr); }
                    ER_STATS(); }
              }
            }
        }
#undef ER_FINISH
#undef ER_STATS
        } else {
            const bool first = (u.i0 == 1); float* pr = part + (size_t)(u.i0 - 1) * TS * DM - (size_t)TP * DM; const float* res = resB + (size_t)(row0 - TP) * DM;
#pragma unroll
        for (int ai = 0; ai < 2; ++ai)
#pragma unroll
          for (int mh = 0; mh < 4; mh += 2) { f32x4 xq[2][2][2];
            if (first) {
#pragma unroll
                for (int m = mh; m < mh + 2; ++m) { const size_t ro = (size_t)(ai * HALF + m * 16) * DM + col0;
#pragma unroll
                    for (int bj = 0; bj < 2; ++bj)
#pragma unroll
                        for (int n = 0; n < 2; ++n) xq[m - mh][bj][n] = *(const f32x4*)(res + ro + bj * HALF + n * 4); }
                __builtin_amdgcn_sched_barrier(0); }
#pragma unroll
            for (int m = mh; m < mh + 2; ++m) { const size_t ro = (size_t)(ai * HALF + m * 16) * DM + col0; float* rowp = pr + (size_t)row0 * DM + ro;
#pragma unroll
                for (int bj = 0; bj < 2; ++bj)
#pragma unroll
                    for (int n = 0; n < 2; ++n) { f32x4 v = acc[ai][bj][m][n] * sc;
                        if (first) v += xq[m - mh][bj][n] * ALPHA + bv[bj][n];
                        *(f32x4*)(rowp + bj * HALF + n * 4) = v; } } }
        }
    }
};
struct EpiCin {
    static constexpr bool PERM = true;
    bf16_t* ub; bf16_t* szg; const float* bias; float sc;
    DI void operator()(const f32x4 (&acc)[2][2][4][2], const GUnit& u, int wr, int wc, int fr, int fq) const {
        const int pm = u.i1, pn = u.i2, row0 = pm * 256 + wr * 64 + fr;
        if (pn < 32) {
            const int ch0 = pn * 128 + wc * 32 + 8 * fq;
            f32x4 ba[2], bg[2];
#pragma unroll
            for (int n = 0; n < 2; ++n) { ba[n] = *(const f32x4*)(bias + ch0 + 4 * n); bg[n] = *(const f32x4*)(bias + 4096 + ch0 + 4 * n); }
#pragma unroll
            for (int ai = 0; ai < 2; ++ai)
#pragma unroll
                for (int m = 0; m < 4; ++m) { f32x4 o[2];
#pragma unroll
                    for (int n = 0; n < 2; ++n) { const f32x4 a = acc[ai][0][m][n] * sc + ba[n], g = acc[ai][1][m][n] * sc + bg[n];
#pragma unroll
                        for (int j = 0; j < 4; ++j) o[n][j] = a[j] * fsigm(g[j]); }
                    u32x4 w; w.x = pk_bf16(o[0][0], o[0][1]); w.y = pk_bf16(o[0][2], o[0][3]); w.z = pk_bf16(o[1][0], o[1][1]); w.w = pk_bf16(o[1][2], o[1][3]);
                    *(u32x4*)(ub + (size_t)(row0 + ai * HALF + m * 16) * DM + ch0) = w; }
        } else {
            const int ch0 = (pn - 32) * 256 + wc * 32 + 8 * fq;
            f32x4 bzz[2][2];
#pragma unroll
            for (int bj = 0; bj < 2; ++bj)
#pragma unroll
                for (int n = 0; n < 2; ++n) bzz[bj][n] = *(const f32x4*)(bias + 8192 + ch0 + bj * HALF + 4 * n);
            __builtin_amdgcn_sched_barrier(0);
#pragma unroll
            for (int bj = 0; bj < 2; ++bj) {
#pragma unroll
                for (int ai = 0; ai < 2; ++ai)
#pragma unroll
                    for (int m = 0; m < 4; ++m) { f32x4 o[2];
#pragma unroll
                        for (int n = 0; n < 2; ++n) { const f32x4 z = acc[ai][bj][m][n] * sc + bzz[bj][n];
#pragma unroll
                            for (int j = 0; j < 4; ++j) o[n][j] = fsilu(z[j]); }
                        u32x4 w; w.x = pk_bf16(o[0][0], o[0][1]); w.y = pk_bf16(o[0][2], o[0][3]); w.z = pk_bf16(o[1][0], o[1][1]); w.w = pk_bf16(o[1][2], o[1][3]);
                        *(u32x4*)(szg + (size_t)(row0 + ai * HALF + m * 16) * DM + ch0 + bj * HALF) = w; } }
        }
    }
};

struct SchedS {
    const char* qp; const char* xa; int G, c, far, wave;
    DI bool next(int i, GUnit& u) const {
        const int per = far ? 105 : 31, L = i * G + c; if (L >= 32 * per) return false;
        const int bh = L / per, rr = L - bh * per; int pm, pn;
        if (far) { int q = 0; while ((q + 1) * (q + 2) / 2 <= rr) ++q; pn = rr - q * (q + 1) / 2; pm = q + 2; }
        else if (rr < 16) { pm = rr; pn = rr; } else { pm = rr - 15; pn = rr - 16; }
        const int b = bh >> 3, h = bh & 7; const size_t es = far ? 1 : 2;
        u.A = qp + ((size_t)(b * 4096 + pm * 256) * INNER + h * 1024) * es; u.B = xa + ((size_t)(b * 4096 + pn * 256) * INNER + h * 1024) * es;
        u.nt = far ? 8 : 16; u.i0 = bh; u.i1 = pm; u.i2 = pn; return true;
    }
};
struct SchedState {
    const char* kwT; const char* vT; int G, c, wave;
    DI bool next(int i, GUnit& u) const {
        const int L = i * G + c; if (L >= 512) return false;
        const int bh = L >> 4, pm = (L >> 2) & 3, pn = L & 3, b = bh >> 3, h = bh & 7;
        u.A = kwT + ((size_t)(h * 1024 + pm * 256) * TPP + b * 4096) * 2; u.B = vT + ((size_t)(h * 1024 + pn * 256) * TPP + b * 4096) * 2;
        u.nt = 64; u.i0 = bh; u.i1 = pm; u.i2 = pn; return true;
    }
};
struct SchedSV {
    const char* S8; const char* S16; const char* vT8; const char* vT; int G, c, wave;
    DI bool next(int i, GUnitM& u) const {
        const int slot = c + G * (i >> 3); if (slot >= 256) return false;
        const int sub = i & 7, bh = slot >> 3, j = slot & 7, pn = j & 3, set = j >> 2, p = 4 * set + (sub >> 1), pm = (sub & 1) ? 15 - p : p, b = bh >> 3, h = bh & 7;
        const int pn0 = pm >= 1 ? pm - 1 : 0;
        u.nt8 = pm >= 2 ? 2 * (pm - 1) : 0; u.nt = u.nt8 + (pm >= 1 ? 8 : 4);
        u.A8 = S8 + (size_t)bh * S8_BH + (size_t)((pm - 2) * (pm - 1) / 2) * 65536; u.A16 = S16 + (size_t)bh * S16_BH + (size_t)(pm + pn0) * 131072;
        u.B8 = vT8 + (size_t)(h * 1024 + pn * 256) * P8 + b * 4096; u.B16 = vT + ((size_t)(h * 1024 + pn * 256) * TPP + b * 4096 + pn0 * 256) * 2;
        u.i0 = bh; u.i1 = pm; u.i2 = pn; return true;
    }
};

template <bool ALSO_FP8>
DI void transpose_item(const float* W, int K, int N, bf16_t* WT, int k0, int n0, int orow0, LAS float* scr, int lane, unsigned char* WQ = nullptr, float qscale = 1.f) {
    float ldv[32];
#pragma unroll
    for (int i = 0; i < 32; ++i) { const int kk = 2 * i + (lane >> 5); ldv[i] = ld_nt(W + (size_t)(k0 + kk) * N + n0 + (lane & 31)); }
    __builtin_amdgcn_sched_barrier(0);
#pragma unroll
    for (int i = 0; i < 32; ++i) { const int kk = 2 * i + (lane >> 5); scr[kk * 33 + (lane & 31)] = ldv[i]; }
    asm volatile("s_waitcnt lgkmcnt(0)" ::: "memory");
    const int c = lane & 7;
#pragma unroll
    for (int j = 0; j < 4; ++j) { const int n = (lane >> 3) + 8 * j; const LAS float* s = scr + (8 * c) * 33 + n;
        u32x4 o; o.x = pk_bf16(s[0 * 33], s[1 * 33]); o.y = pk_bf16(s[2 * 33], s[3 * 33]); o.z = pk_bf16(s[4 * 33], s[5 * 33]); o.w = pk_bf16(s[6 * 33], s[7 * 33]);
        *(u32x4*)(WT + (size_t)(orow0 + n) * K + k0 + 8 * c) = o;
        if constexpr (ALSO_FP8) { u32x2 q; q.x = pk_fp8x4(s[0 * 33] * qscale, s[1 * 33] * qscale, s[2 * 33] * qscale, s[3 * 33] * qscale); q.y = pk_fp8x4(s[4 * 33] * qscale, s[5 * 33] * qscale, s[6 * 33] * qscale, s[7 * 33] * qscale);
            *(u32x2*)(WQ + (size_t)(orow0 + n) * K + k0 + 8 * c) = q; } }
    asm volatile("s_waitcnt lgkmcnt(0)" ::: "memory");
}
DI void transpose_item_fp8(const float* W, int K, int N, unsigned char* WT, int k0, int n0, float scale, LAS float* scr, int lane) {
    float ldv[32];
#pragma unroll
    for (int i = 0; i < 32; ++i) { const int kk = 2 * i + (lane >> 5); ldv[i] = ld_nt(W + (size_t)(k0 + kk) * N + n0 + (lane & 31)); }
    __builtin_amdgcn_sched_barrier(0);
#pragma unroll
    for (int i = 0; i < 32; ++i) { const int kk = 2 * i + (lane >> 5); scr[kk * 33 + (lane & 31)] = ldv[i]; }
    asm volatile("s_waitcnt lgkmcnt(0)" ::: "memory");
    const int c = lane & 7;
#pragma unroll
    for (int j = 0; j < 4; ++j) { const int n = (lane >> 3) + 8 * j; const LAS float* s = scr + (8 * c) * 33 + n;
        u32x2 o; o.x = pk_fp8x4(s[0 * 33] * scale, s[1 * 33] * scale, s[2 * 33] * scale, s[3 * 33] * scale); o.y = pk_fp8x4(s[4 * 33] * scale, s[5 * 33] * scale, s[6 * 33] * scale, s[7 * 33] * scale);
        *(u32x2*)(WT + (size_t)(n0 + n) * K + k0 + 8 * c) = o; }
    asm volatile("s_waitcnt lgkmcnt(0)" ::: "memory");
}
DI void transpose_weight_fp8(const Frame& F, const float* W, int K, int N, unsigned char* WT, float scale) {
    LAS float* scr = (LAS float*)(F.lds + F.wave * 16384);
    const int gw = F.vcu * NWAVES + F.wave, NGW = F.G * NWAVES, nblk = N / 32, nitems = (K / 64) * nblk;
    for (int it = gw; it < nitems; it += NGW) { const int kb = it / nblk, nb = it - kb * nblk; transpose_item_fp8(W, K, N, WT, 64 * kb, 32 * nb, scale, scr, F.lane); }
}
DI void transpose_weight(const Frame& F, const float* W, int K, int N, bf16_t* WT, bool cin_map, unsigned char* WQ = nullptr, float qscale = 1.f) {
    LAS float* scr = (LAS float*)(F.lds + F.wave * 16384);
    const int gw = F.vcu * NWAVES + F.wave, NGW = F.G * NWAVES, nblk = N / 32, nitems = (K / 64) * nblk;
    for (int it = gw; it < nitems; it += NGW) { const int kb = it / nblk, nb = it - kb * nblk, n0 = 32 * nb; int orow0 = n0;
        if (cin_map) { if (n0 < 4096) orow0 = 256 * (n0 >> 7) + (n0 & 127); else if (n0 < 8192) orow0 = 256 * ((n0 - 4096) >> 7) + 128 + (n0 & 127); }
        if (cin_map) transpose_item<true>(W, K, N, WT, 64 * kb, n0, orow0, scr, F.lane, WQ, qscale); else transpose_item<false>(W, K, N, WT, 64 * kb, n0, orow0, scr, F.lane); }
}

DI void phase_prologue(const Frame& F, const Params& p) {
    unsigned char* ws = p.ws;
    { LAS float* scr = (LAS float*)(F.lds + F.wave * 16384);
      const int gw = F.vcu * NWAVES + F.wave, NGW = F.G * NWAVES, nblk = 2 * INNER / 32, nitems = (DM / 64) * nblk;
      for (int it = gw; it < nitems; it += NGW) { const int kb = it / nblk, nb = it - kb * nblk, n0 = 32 * nb;
          if (n0 < INNER) transpose_item<false>(p.w_up, DM, 2 * INNER, (bf16_t*)(ws + WS_WUP), 64 * kb, n0, n0, scr, F.lane);
          else transpose_item_fp8(p.w_up, DM, 2 * INNER, ws + WS_WZQ - (size_t)INNER * DM, 64 * kb, n0, FP8_SB_WZ, scr, F.lane); } }
    const size_t gt = (size_t)F.vcu * NTHR + F.tid, NT = (size_t)F.G * NTHR;
    bf16_t* xb = (bf16_t*)(ws + WS_XB);
    for (size_t i0 = gt; i0 < (size_t)TT * (DM / 8); i0 += 4 * NT) {
        f32x4 a[4], b[4];
#pragma unroll
        for (int u = 0; u < 4; ++u) { const size_t i = i0 + (size_t)u * NT; if (i < (size_t)TT * (DM / 8)) { const size_t tok = i >> 9; const int c8 = (int)(i & 511) * 8;
            const float* src = tok < TP ? p.x_prompt + tok * DM + c8 : p.x_sample + (tok - TP) * DM + c8; a[u] = ld_nt((const f32x4*)src); b[u] = ld_nt((const f32x4*)(src + 4)); } }
#pragma unroll
        for (int u = 0; u < 4; ++u) { const size_t i = i0 + (size_t)u * NT; if (i < (size_t)TT * (DM / 8)) { const size_t tok = i >> 9; const int c8 = (int)(i & 511) * 8;
            u32x4 w; w.x = pk_bf16(a[u][0], a[u][1]); w.y = pk_bf16(a[u][2], a[u][3]); w.z = pk_bf16(b[u][0], b[u][1]); w.w = pk_bf16(b[u][2], b[u][3]);
            *(u32x4*)(xb + tok * DM + c8) = w;
            u32x2 q8; q8.x = pk_fp8x4(a[u][0] * FP8_SA_X, a[u][1] * FP8_SA_X, a[u][2] * FP8_SA_X, a[u][3] * FP8_SA_X); q8.y = pk_fp8x4(b[u][0] * FP8_SA_X, b[u][1] * FP8_SA_X, b[u][2] * FP8_SA_X, b[u][3] * FP8_SA_X);
            *(u32x2*)(ws + WS_XQ + tok * DM + c8) = q8; } }
    }
    for (size_t i = gt; i < (WS_ZERO_BYTES - WS_GATES) / 16; i += NT) *(u32x4*)(ws + WS_GATES + 16 * i) = (u32x4){0u, 0u, 0u, 0u};
    for (size_t i = gt; i < (size_t)32 * 1024 / 4; i += NT) *(f32x4*)(p.out + O_PN + 4 * i) = (f32x4){0.f, 0.f, 0.f, 0.f};
    bf16_t* GT = (bf16_t*)(ws + WS_GT);
    for (size_t i = gt; i < (size_t)2 * 16 * INNER; i += NT) { const int c = (int)(i & 8191), g = (int)(i >> 13) & 15, which = (int)(i >> 17);
        const int n = c >> 2, d = c & 3; float s = 0.f;
        if (which == 0) {
#pragma unroll
            for (int e = 0; e < 4; ++e) s += p.w_q[n * 16 + d * 4 + e] * p.w_gate[(size_t)(0 * INNER + 4 * n + e) * 16 + g] + p.w_k[n * 16 + d * 4 + e] * p.w_gate[(size_t)(1 * INNER + 4 * n + e) * 16 + g];
        } else {
#pragma unroll
            for (int e = 0; e < 4; ++e) s += p.w_v[n * 16 + d * 4 + e] * p.w_gate[(size_t)(2 * INNER + 4 * n + e) * 16 + g];
        }
        GT[i] = f2bf(s); }
}

template <bool SAMP>
DI void passA_item(const Frame& F, const Params& p, int tg, int cg, int step0 = 0, int nstep = 4) {
    unsigned char* ws = p.ws;
    const bf16_t* __restrict__ xm = (const bf16_t*)(ws + WS_XM); bf16_t* __restrict__ xa = (bf16_t*)(ws + WS_XA); const bf16_t* __restrict__ GT = (const bf16_t*)(ws + WS_GT); float* gates = (float*)(ws + WS_GATES);
    LAS f32x4* red = (LAS f32x4*)F.lds;
    LAS unsigned short* tVw = (LAS unsigned short*)(F.lds + 32768 + F.wave * 4096);
    const int fr = F.lane & 15, fq = F.lane >> 4;
    f32x4 accg[4];
#pragma unroll
    for (int j = 0; j < 4; ++j) accg[j] = (f32x4){0.f, 0.f, 0.f, 0.f};
    const int tokb = tg * 64 + fr;
    for (int step = step0; step < step0 + nstep; ++step) {
        const int c = cg * 1024 + F.wave * 128 + 32 * step + 8 * fq;
        f32x4 wv[5][2];
#pragma unroll
        for (int j = 0; j < 4; ++j) { wv[j][0] = *(const f32x4*)(p.w_mconv + (size_t)j * INNER + c); wv[j][1] = *(const f32x4*)(p.w_mconv + (size_t)j * INNER + c + 4); }
        wv[4][0] = *(const f32x4*)(p.b_mconv + c); wv[4][1] = *(const f32x4*)(p.b_mconv + c + 4);
        const bf16x8 ga = *(const bf16x8*)(GT + (size_t)(0 * 16 + fr) * INNER + c), gm = *(const bf16x8*)(GT + (size_t)(1 * 16 + fr) * INNER + c);
        f32x4 wvv[2][4];
        if (!SAMP) {
#pragma unroll
            for (int bb = 0; bb < 2; ++bb)
#pragma unroll
                for (int d = 0; d < 4; ++d) wvv[bb][d] = *(const f32x4*)(p.w_v + (size_t)((c >> 2) + bb) * 16 + 4 * d); }
        u32x4 cur[5];
        { const int r0 = tokb - 16; cur[0] = *(const u32x4*)(xm + (size_t)(r0 < 0 ? 0 : r0) * INNER + c); }
#pragma unroll
        for (int tl = 0; tl < 4; ++tl) cur[1 + tl] = *(const u32x4*)(xm + (size_t)(tokb + 16 * tl) * INNER + c);
        __builtin_amdgcn_sched_barrier(0);
#define PA_ROR(S_, v_) ((unsigned)__builtin_amdgcn_update_dpp(0, (int)(v_), 0x120 + (S_), 0xF, 0xF, false))
#define PA_SH1(S_, c_, p_) ((unsigned)__builtin_amdgcn_update_dpp((int)PA_ROR(S_, p_), (int)(c_), 0x110 + (S_), 0xF, 0xF, false))
#define PA_SHIFT(S_, dst_) do { (dst_).x = PA_SH1(S_, cur[1 + tl].x, cur[tl].x); (dst_).y = PA_SH1(S_, cur[1 + tl].y, cur[tl].y); \
            (dst_).z = PA_SH1(S_, cur[1 + tl].z, cur[tl].z); (dst_).w = PA_SH1(S_, cur[1 + tl].w, cur[tl].w); } while (0)
#pragma unroll
        for (int tl = 0; tl < 4; ++tl) { const int tok = tokb + 16 * tl; const int t = SAMP ? ((tok - TP) & 31) : (tok & 4095);
            u32x4 raw[4][4];
            raw[tl][3] = cur[1 + tl]; PA_SHIFT(1, raw[tl][2]); PA_SHIFT(2, raw[tl][1]); PA_SHIFT(3, raw[tl][0]);
            float xc[8];
#pragma unroll
            for (int i = 0; i < 8; ++i) xc[i] = wv[4][i >> 2][i & 3];
#pragma unroll
            for (int j = 0; j < 4; ++j) { const int tj = t + j - 3; float xin[8]; unpack8(raw[tl][j], xin);
                if (tj < 0) {
                    if (SAMP) { const int bsm = (tok - TP) >> 5; const float* hp = p.st_mconv + (size_t)(bsm * 3 + tj + 3) * INNER + c; const f32x4 h0 = *(const f32x4*)hp, h1 = *(const f32x4*)(hp + 4);
                        xin[0] = h0[0]; xin[1] = h0[1]; xin[2] = h0[2]; xin[3] = h0[3]; xin[4] = h1[0]; xin[5] = h1[1]; xin[6] = h1[2]; xin[7] = h1[3]; }
                    else {
#pragma unroll
                        for (int i = 0; i < 8; ++i) xin[i] = 0.f; } }
#pragma unroll
                for (int i = 0; i < 8; ++i) xc[i] += wv[j][i >> 2][i & 3] * xin[i]; }
#pragma unroll
            for (int i = 0; i < 8; ++i) xc[i] = fsilu(xc[i]);
            const u32x4 xa4 = pack8(xc);
            *(u32x4*)(xa + (size_t)tok * INNER + c) = xa4;
            if (!SAMP) { u32x2 x8v; x8v.x = pk_fp8x4(xc[0] * FP8_SA_XA, xc[1] * FP8_SA_XA, xc[2] * FP8_SA_XA, xc[3] * FP8_SA_XA); x8v.y = pk_fp8x4(xc[4] * FP8_SA_XA, xc[5] * FP8_SA_XA, xc[6] * FP8_SA_XA, xc[7] * FP8_SA_XA);
                *(u32x2*)((unsigned char*)p.out + O8_XA8 + (size_t)tok * INNER + c) = x8v; }
            accg[tl] = __builtin_amdgcn_mfma_f32_16x16x32_bf16(__builtin_bit_cast(bf16x8, xa4), ga, accg[tl], 0, 0, 0);
            accg[tl] = __builtin_amdgcn_mfma_f32_16x16x32_bf16(__builtin_bit_cast(bf16x8, raw[tl][3]), gm, accg[tl], 0, 0, 0);
            if (!SAMP) {
                float xv[8]; unpack8(raw[tl][3], xv);
                const int col = 16 * tl + fr, dw = ((col >> 1) ^ (8 * fq)) << 1;
#pragma unroll
                for (int bb = 0; bb < 2; ++bb)
#pragma unroll
                    for (int e = 0; e < 4; ++e) { const float v = xv[4 * bb] * wvv[bb][0][e] + xv[4 * bb + 1] * wvv[bb][1][e] + xv[4 * bb + 2] * wvv[bb][2][e] + xv[4 * bb + 3] * wvv[bb][3][e];
                        tVw[(8 * fq + 4 * bb + e) * 64 + dw + (col & 1)] = f2bf(v); } }
        }
#undef PA_SHIFT
#undef PA_SH1
#undef PA_ROR
        if (!SAMP) {
            asm volatile("s_waitcnt lgkmcnt(0)" ::: "memory");
#pragma unroll
            for (int k = 0; k < 4; ++k) { const int q = F.lane + 64 * k, row = q >> 3, ch = q & 7;
                const u32x4 vrow = *(const LAS u32x4*)(tVw + row * 64 + ((((4 * ch) ^ (8 * (row >> 3)))) << 1));
                const size_t chan = (size_t)(cg * 1024 + F.wave * 128 + 32 * step + row);
                *(u32x4*)((bf16_t*)(ws + WS_VT) + chan * TPP + tg * 64 + 8 * ch) = vrow;
                float vf[8]; unpack8(vrow, vf); u32x2 v8; v8.x = pk_fp8x4(vf[0] * FP8_SA_V, vf[1] * FP8_SA_V, vf[2] * FP8_SA_V, vf[3] * FP8_SA_V); v8.y = pk_fp8x4(vf[4] * FP8_SA_V, vf[5] * FP8_SA_V, vf[6] * FP8_SA_V, vf[7] * FP8_SA_V);
                *(u32x2*)(ws + WS_VT8 + chan * P8 + tg * 64 + 8 * ch) = v8; }
            asm volatile("s_waitcnt lgkmcnt(0)" ::: "memory"); }
    }
    __syncthreads();
#pragma unroll
    for (int tl = 0; tl < 4; ++tl) red[(F.wave * 4 + tl) * 64 + F.lane] = accg[tl];
    __syncthreads();
    if (F.tid < 256 && !F.dry) { const int tl = F.tid >> 6, ln = F.tid & 63; f32x4 sacc = (f32x4){0.f, 0.f, 0.f, 0.f};
#pragma unroll
        for (int w = 0; w < NWAVES; ++w) sacc += red[(w * 4 + tl) * 64 + ln];
#pragma unroll
        for (int j = 0; j < 4; ++j) atomicAdd(gates + (size_t)(tg * 64 + 16 * tl + 4 * (ln >> 4) + j) * 16 + (ln & 15), sacc[j]); }
}
DI void phase_passA(const Frame& F, const Params& p) {
    unsigned char* ws = p.ws;
    const bf16_t* xm = (const bf16_t*)(ws + WS_XM);
    for (int it = F.vcu; it < (TP / 64) * 8 + (TS / 64) * 8 * 4; it += F.G) { const int item = (TP / 64) * 8 + (TS / 64) * 8 * 4 - 1 - it;
        if (item < (TP / 64) * 8) passA_item<false>(F, p, item >> 3, item & 7);
        else { const int si = item - (TP / 64) * 8; passA_item<true>(F, p, TP / 64 + (si >> 5), (si >> 2) & 7, si & 3, 1); } }
    const size_t gt = (size_t)F.vcu * NTHR + F.tid, NT = (size_t)F.G * NTHR;
    for (size_t i = gt; i < (size_t)(4 + 16) * 3 * (INNER / 8); i += NT) { const int c8 = (int)(i & 1023) * 8, ri = (int)(i >> 10), sq = ri / 3, k = ri - sq * 3;
        size_t tok; float* dst;
        if (sq < 4) { tok = (size_t)sq * 4096 + 4093 + k; dst = p.out + O_PMC + (size_t)(sq * 3 + k) * INNER + c8; }
        else { const int b = sq - 4; tok = (size_t)TP + b * 32 + 29 + k; dst = p.out + O_SMC + (size_t)(b * 3 + k) * INNER + c8; }
        float f[8]; unpack8(*(const u32x4*)(xm + tok * INNER + c8), f);
        *(f32x4*)dst = (f32x4){f[0], f[1], f[2], f[3]}; *(f32x4*)(dst + 4) = (f32x4){f[4], f[5], f[6], f[7]}; }
}

DI void headwise8(const float (&x)[8], const float* W, int n0, float scale, float (&y)[8]) {
#pragma unroll
    for (int bb = 0; bb < 2; ++bb) { const float* w = W + (size_t)(n0 + bb) * 16; const f32x4 w0 = *(const f32x4*)w, w1 = *(const f32x4*)(w + 4), w2 = *(const f32x4*)(w + 8), w3 = *(const f32x4*)(w + 12);
#pragma unroll
        for (int e = 0; e < 4; ++e) y[4 * bb + e] = (x[4 * bb] * w0[e] + x[4 * bb + 1] * w1[e] + x[4 * bb + 2] * w2[e] + x[4 * bb + 3] * w3[e]) * scale; }
}

DI float block_excl_add(float v, LAS float* sm, int lane, int wave) {
    float incl = v;
#pragma unroll
    for (int o = 1; o < 64; o <<= 1) { const float t = __shfl_up(incl, o); if (lane >= o) incl += t; }
    __syncthreads();
    if (lane == 63) sm[wave] = incl;
    __syncthreads();
    float woff = 0.f;
#pragma unroll
    for (int w = 0; w < NWAVES; ++w) { const float t = sm[w]; if (w < wave) woff += t; }
    return woff + incl - v;
}
DI float block_excl_max(float v, LAS float* sm, int lane, int wave) {
    float incl = v;
#pragma unroll
    for (int o = 1; o < 64; o <<= 1) { const float t = __shfl_up(incl, o); if (lane >= o) incl = fmaxf(incl, t); }
    float excl = __shfl_up(incl, 1); if (lane == 0) excl = -3.0e38f;
    __syncthreads();
    if (lane == 63) sm[wave] = incl;
    __syncthreads();
    float woff = -3.0e38f;
#pragma unroll
    for (int w = 0; w < NWAVES; ++w) { const float t = sm[w]; if (w < wave) woff = fmaxf(woff, t); }
    return fmaxf(woff, excl);
}
DI void scan_prompt(const Frame& F, const Params& p, int bh) {
    unsigned char* ws = p.ws;
    const float* gates = (const float*)(ws + WS_GATES); float* cs = (float*)(ws + WS_CS); float* mx = (float*)(ws + WS_MX); float* em = (float*)(ws + WS_EM); float* mxl = (float*)(ws + WS_MXL);
    LAS float* sm = (LAS float*)(F.lds + 1024);
    const int b = bh >> 3, h = bh & 7; const float bi = p.b_gate[h], bf = p.b_gate[8 + h];
    const float* gp = gates + (size_t)(b * 4096 + 8 * F.tid) * 16;
    float ig[8], lf[8];
#pragma unroll
    for (int k = 0; k < 8; ++k) { ig[k] = gp[k * 16 + h]; lf[k] = gp[k * 16 + 8 + h]; }
    float s = 0.f;
#pragma unroll
    for (int k = 0; k < 8; ++k) { ig[k] += bi; lf[k] = logsig(lf[k] + bf); s += lf[k]; }
    float run = block_excl_add(s, sm, F.lane, F.wave);
    float c[8], B[8], mloc = -3.0e38f;
#pragma unroll
    for (int k = 0; k < 8; ++k) { run += lf[k]; B[k] = run; c[k] = ig[k] - run; mloc = fmaxf(mloc, c[k]); }
    float rm = fmaxf(0.f, block_excl_max(mloc, sm, F.lane, F.wave));
    f32x4 oc[2], om[2], oe[2];
#pragma unroll
    for (int k = 0; k < 8; ++k) { rm = fmaxf(rm, c[k]); oc[k >> 2][k & 3] = c[k]; om[k >> 2][k & 3] = rm; oe[k >> 2][k & 3] = expf(-(B[k] + rm)); }
    const size_t o = (size_t)bh * 4096 + 8 * F.tid;
    *(f32x4*)(cs + o) = oc[0]; *(f32x4*)(cs + o + 4) = oc[1]; *(f32x4*)(mx + o) = om[0]; *(f32x4*)(mx + o + 4) = om[1]; *(f32x4*)(em + o) = oe[0]; *(f32x4*)(em + o + 4) = oe[1];
    if (F.tid == NTHR - 1) { p.out[O_PM + bh] = B[7] + rm; mxl[bh] = rm; }
}

DI void sample_prep(const Frame& F, const Params& p, int bh) {
    unsigned char* ws = p.ws;
    const float* gates = (const float*)(ws + WS_GATES); const bf16_t* __restrict__ xa = (const bf16_t*)(ws + WS_XA); const bf16_t* __restrict__ xm = (const bf16_t*)(ws + WS_XM);
    bf16_t* __restrict__ Sp = (bf16_t*)(ws + WS_SSP); bf16_t* __restrict__ qt = (bf16_t*)(ws + WS_SQT); bf16_t* __restrict__ wkT = (bf16_t*)(ws + WS_SWK); bf16_t* __restrict__ vTs = (bf16_t*)(ws + WS_SVT); float* scb = (float*)(ws + WS_MXL + 1024);
    LAS float* red = (LAS float*)(F.lds + 4096);
    LAS float* scr = (LAS float*)(F.lds + F.wave * 512);
    const int lane = F.lane, b = bh >> 3, h = bh & 7, r = lane & 31, hf = lane >> 5, tok0 = TP + 32 * b;
    const float ig = gates[(size_t)(tok0 + r) * 16 + h] + p.b_gate[h], lf = logsig(gates[(size_t)(tok0 + r) * 16 + 8 + h] + p.b_gate[8 + h]);
    float bc = lf;
#pragma unroll
    for (int o = 1; o < 32; o <<= 1) { const float v = __shfl_up(bc, o, 32); if (r >= o) bc += v; }
    const float m0 = p.st_m[bh], c = ig - bc;
    float pmx = c;
#pragma unroll
    for (int o = 1; o < 32; o <<= 1) { const float v = __shfl_up(pmx, o, 32); if (r >= o) pmx = fmaxf(pmx, v); }
    const float mxt = fmaxf(m0, pmx), m_t = bc + mxt, inter = expf(m0 - mxt), emt = expf(-m_t);
    const float mx31 = __shfl(mxt, 31), b31 = __shfl(bc, 31);
    const float w_s = expf(c - mx31), scv = expf(m0 - mx31);
    const int dkw = 128 * F.wave;
    const bf16_t* xar = xa + (size_t)(tok0 + r) * INNER + h * 1024 + dkw + 8 * hf; const bf16_t* xmr = xm + (size_t)(tok0 + r) * INNER + h * 1024 + dkw + 8 * hf;
    const float* n0v = p.st_n + (size_t)bh * 1024 + dkw + 8 * hf;
    f32x16 accS;
#pragma unroll
    for (int i = 0; i < 16; ++i) accS[i] = 0.f;
    float qn = 0.f;
#pragma unroll 4
    for (int kk = 0; kk < 8; ++kk) {
        float x[8], q[8], k[8]; unpack8(*(const u32x4*)(xar + 16 * kk), x);
        const int n0 = (h * 1024 + dkw + 16 * kk + 8 * hf) >> 2;
        headwise8(x, p.w_q, n0, 1.0f, q); headwise8(x, p.w_k, n0, 0.03125f, k);
        const f32x4 na = *(const f32x4*)(n0v + 16 * kk), nb = *(const f32x4*)(n0v + 16 * kk + 4);
        qn += q[0] * na[0] + q[1] * na[1] + q[2] * na[2] + q[3] * na[3] + q[4] * nb[0] + q[5] * nb[1] + q[6] * nb[2] + q[7] * nb[3];
        accS = __builtin_amdgcn_mfma_f32_32x32x16_bf16(__builtin_bit_cast(bf16x8, pack8(q)), __builtin_bit_cast(bf16x8, pack8(k)), accS, 0, 0, 0);
    }
    __syncthreads();
#pragma unroll
    for (int i = 0; i < 16; ++i) red[(F.wave * 17 + i) * 64 + lane] = accS[i];
    red[(F.wave * 17 + 16) * 64 + lane] = qn;
    __syncthreads();
    qn = 0.f;
#pragma unroll
    for (int i = 0; i < 16; ++i) accS[i] = 0.f;
#pragma unroll
    for (int w = 0; w < NWAVES; ++w) {
#pragma unroll
        for (int i = 0; i < 16; ++i) accS[i] += red[(w * 17 + i) * 64 + lane];
        qn += red[(w * 17 + 16) * 64 + lane]; }
    qn += __shfl_xor(qn, 32);
    float sv[16];
#pragma unroll
    for (int i = 0; i < 16; ++i) { const int t = (i & 3) + 8 * (i >> 2) + 4 * hf; const float mxq = __shfl(mxt, t);
        const float d = (r <= t) ? expf(c - mxq) : 0.f; sv[i] = accS[i] * d;
        float rs = sv[i];
#pragma unroll
        for (int o = 1; o < 32; o <<= 1) rs += __shfl_xor(rs, o);
        if (r == 0) scr[t] = rs; }
    asm volatile("s_waitcnt lgkmcnt(0)" ::: "memory");
    const float den = scr[r] + inter * qn, g = 1.0f / fmaxf(fabsf(den), emt), f = inter * g;
    asm volatile("s_waitcnt lgkmcnt(0)" ::: "memory");
    if (hf == 0) scr[32 + r] = g;
    asm volatile("s_waitcnt lgkmcnt(0)" ::: "memory");
    if (F.wave == 0) {
#pragma unroll
        for (int i = 0; i < 16; ++i) { const int t = (i & 3) + 8 * (i >> 2) + 4 * hf; Sp[(size_t)(bh * 32 + t) * 32 + r] = f2bf(sv[i] * scr[32 + t]); } }
    asm volatile("s_waitcnt lgkmcnt(0)" ::: "memory");
#pragma unroll 2
    for (int kk = 0; kk < 8; ++kk) {
        float x[8], xv[8], q[8], k[8], v[8]; unpack8(*(const u32x4*)(xar + 16 * kk), x); unpack8(*(const u32x4*)(xmr + 16 * kk), xv);
        const int dk0 = dkw + 16 * kk + 8 * hf, n0 = (h * 1024 + dk0) >> 2;
        const float n0s[8] = {p.st_n[(size_t)bh * 1024 + dk0], p.st_n[(size_t)bh * 1024 + dk0 + 1], p.st_n[(size_t)bh * 1024 + dk0 + 2], p.st_n[(size_t)bh * 1024 + dk0 + 3],
                              p.st_n[(size_t)bh * 1024 + dk0 + 4], p.st_n[(size_t)bh * 1024 + dk0 + 5], p.st_n[(size_t)bh * 1024 + dk0 + 6], p.st_n[(size_t)bh * 1024 + dk0 + 7]};
        headwise8(x, p.w_q, n0, 1.0f, q); headwise8(x, p.w_k, n0, 0.03125f, k); headwise8(xv, p.w_v, n0, 1.0f, v);
#pragma unroll
        for (int i = 0; i < 8; ++i) q[i] *= f;
        *(u32x4*)(qt + (size_t)(bh * 32 + r) * 1024 + dk0) = pack8(q);
#pragma unroll
        for (int i = 0; i < 8; ++i) { const float wk = k[i] * w_s; wkT[(size_t)(bh * 1024 + dk0 + i) * 32 + r] = f2bf(wk); vTs[(size_t)(bh * 1024 + dk0 + i) * 32 + r] = f2bf(v[i]);
            float ns = wk;
#pragma unroll
            for (int o = 1; o < 32; o <<= 1) ns += __shfl_xor(ns, o);
            if (r == 0) p.out[O_SN + (size_t)bh * 1024 + dk0 + i] = scv * n0s[i] + ns; }
    }
    if (F.tid == 0) { p.out[O_SM + bh] = b31 + mx31; scb[bh] = scv; }
    __syncthreads();
}

DI void phase_passB(const Frame& F, const Params& p) {
    unsigned char* ws = p.ws;
    const bf16_t* __restrict__ xa = (const bf16_t*)(ws + WS_XA); const bf16_t* __restrict__ xm = (const bf16_t*)(ws + WS_XM); bf16_t* __restrict__ qp = (bf16_t*)(ws + WS_QP); bf16_t* __restrict__ kwT = (bf16_t*)(ws + WS_KWT); bf16_t* __restrict__ vT = (bf16_t*)(ws + WS_VT);
    const float* cs = (const float*)(ws + WS_CS); const float* mxl = (const float*)(ws + WS_MXL);
    unsigned char* __restrict__ q8 = (unsigned char*)p.out + O8_Q8; unsigned char* __restrict__ xa8 = (unsigned char*)p.out + O8_XA8;
    LAS bf16_t* tK = (LAS bf16_t*)F.lds;
    const int g = F.tid & 7, tl = F.tid >> 3;
    for (int item = F.vcu; item < 2048; item += F.G) {
        const int cb = item & 127, tb = item >> 7, b = tb >> 2, h = cb >> 4, bh = b * 8 + h, c = cb * 64 + 8 * g, n0 = c >> 2;
        float wqk[2][4][4], wkk[2][4][4], wvv[2][4][4];
#pragma unroll
        for (int bb = 0; bb < 2; ++bb) { float wq[4][4];
#pragma unroll
            for (int d = 0; d < 4; ++d) { const f32x4 a = *(const f32x4*)(p.w_q + (size_t)(n0 + bb) * 16 + 4 * d), k4 = *(const f32x4*)(p.w_k + (size_t)(n0 + bb) * 16 + 4 * d), v4 = *(const f32x4*)(p.w_v + (size_t)(n0 + bb) * 16 + 4 * d);
#pragma unroll
                for (int e = 0; e < 4; ++e) { wq[d][e] = a[e]; wkk[bb][d][e] = k4[e] * 0.03125f; wvv[bb][d][e] = v4[e]; } }
#pragma unroll
            for (int d = 0; d < 4; ++d)
#pragma unroll
                for (int d2 = 0; d2 < 4; ++d2) wqk[bb][d][d2] = wq[d][0] * wkk[bb][d2][0] + wq[d][1] * wkk[bb][d2][1] + wq[d][2] * wkk[bb][d2][2] + wq[d][3] * wkk[bb][d2][3]; }
        const float mxlast = mxl[bh];
        float nacc[8];
#pragma unroll
        for (int i = 0; i < 8; ++i) nacc[i] = 0.f;
        const int tokb = tb * 1024 + tl;
#pragma unroll 1
        for (int sub4 = 0; sub4 < 16; sub4 += 2) {
          u32x4 rxa[2];
#pragma unroll
          for (int u = 0; u < 2; ++u) { const int tk = tokb + (sub4 + u) * 64; rxa[u] = *(const u32x4*)(xa + (size_t)tk * INNER + c); }
          const float rcs0 = cs[bh * 4096 + ((tokb + sub4 * 64) & 4095)], rcs1 = cs[bh * 4096 + ((tokb + sub4 * 64 + 64) & 4095)];
#pragma unroll
          for (int u = 0; u < 2; ++u) {
            const int sub = sub4 + u, tok = tokb + sub * 64;
            const u32x4 cxa = rxa[u]; const float ccs = u ? rcs1 : rcs0;
            float x[8], q[8], kw[8]; unpack8(cxa, x);
            const float w = fexp(ccs - mxlast);
#pragma unroll
            for (int bb = 0; bb < 2; ++bb)
#pragma unroll
                for (int e = 0; e < 4; ++e) {
                    q[4 * bb + e] = x[4 * bb] * wqk[bb][0][e] + x[4 * bb + 1] * wqk[bb][1][e] + x[4 * bb + 2] * wqk[bb][2][e] + x[4 * bb + 3] * wqk[bb][3][e];
                    kw[4 * bb + e] = (x[4 * bb] * wkk[bb][0][e] + x[4 * bb + 1] * wkk[bb][1][e] + x[4 * bb + 2] * wkk[bb][2][e] + x[4 * bb + 3] * wkk[bb][3][e]) * w; }
            *(u32x4*)(qp + (size_t)tok * INNER + c) = pack8(q);
            { u32x2 q8v, x8v; q8v.x = pk_fp8x4(q[0] * FP8_SA_Q, q[1] * FP8_SA_Q, q[2] * FP8_SA_Q, q[3] * FP8_SA_Q); q8v.y = pk_fp8x4(q[4] * FP8_SA_Q, q[5] * FP8_SA_Q, q[6] * FP8_SA_Q, q[7] * FP8_SA_Q);
              *(u32x2*)(q8 + (size_t)tok * INNER + c) = q8v; (void)x8v; }
            LAS bf16_t* bK = tK + (sub & 1) * (64 * 72);
#pragma unroll
            for (int i = 0; i < 8; ++i) { nacc[i] += kw[i]; bK[(8 * i + g) * 72 + tl] = f2bf(kw[i]); }
            LDS_BARRIER();
            { const int row = F.tid >> 3, ch = F.tid & 7, chan = 8 * (row & 7) + (row >> 3); const size_t o = (size_t)(cb * 64 + chan) * TPP + tb * 1024 + sub * 64 + 8 * ch;
              *(u32x4*)(kwT + o) = *(const LAS u32x4*)(bK + row * 72 + 8 * ch); }
          }
        }
        LDS_BARRIER();
#pragma unroll
        for (int i = 0; i < 8; ++i) { float v = nacc[i]; v += __shfl_xor(v, 8); v += __shfl_xor(v, 16); v += __shfl_xor(v, 32);
            if (F.lane < 8 && !F.dry) atomicAdd(p.out + O_PN + (size_t)bh * 1024 + (c & 1023) + i, v); }
    }
}

DI void phase_sample_cell(const Frame& F, const Params& p) {
    unsigned char* ws = p.ws;
    const bf16_t* __restrict__ Sp = (const bf16_t*)(ws + WS_SSP); const bf16_t* __restrict__ qt = (const bf16_t*)(ws + WS_SQT); const bf16_t* __restrict__ wkT = (const bf16_t*)(ws + WS_SWK); const bf16_t* __restrict__ vTs = (const bf16_t*)(ws + WS_SVT);
    const float* scb = (const float*)(ws + WS_MXL + 1024); bf16_t* __restrict__ hs = (bf16_t*)(ws + WS_HS);
    const int r = F.lane & 31, hf = F.lane >> 5, gw = F.vcu * NWAVES + F.wave, NGW = F.G * NWAVES;
    for (int item = gw; item < 128 * 16; item += NGW) {
        const int bh = item >> 4, dvp = item & 15, b = bh >> 3, h = bh & 7;
        const __amdgpu_buffer_rsrc_t rC0 = __builtin_amdgcn_make_buffer_rsrc((void*)(p.st_C + ((size_t)bh << 20)), 0, 1 << 22, 0x00020000);
        const __amdgpu_buffer_rsrc_t rCn = __builtin_amdgcn_make_buffer_rsrc((void*)(p.out + O_SC + ((size_t)bh << 20)), 0, 1 << 22, 0x00020000);
        const unsigned voff = (unsigned)((4 * hf) * 1024 + r) * 4u; const int sbase = dvp * 256;
#define SC_OFF(dkt_, i_, d_) (sbase + ((dkt_) * 32 + ((i_) & 3) + 8 * ((i_) >> 2)) * 4096 + (d_) * 128)
        const float sc = scb[bh];
        bf16x8 vf[2][2], sf[2];
#pragma unroll
        for (int s2 = 0; s2 < 2; ++s2) { sf[s2] = *(const bf16x8*)(Sp + (size_t)(bh * 32 + r) * 32 + 16 * s2 + 8 * hf);
#pragma unroll
            for (int d = 0; d < 2; ++d) vf[d][s2] = *(const bf16x8*)(vTs + (size_t)(bh * 1024 + dvp * 64 + 32 * d + r) * 32 + 16 * s2 + 8 * hf); }
        f32x16 acch[2];
#pragma unroll
        for (int d = 0; d < 2; ++d) {
#pragma unroll
            for (int i = 0; i < 16; ++i) acch[d][i] = 0.f;
            acch[d] = __builtin_amdgcn_mfma_f32_32x32x16_bf16(sf[0], vf[d][0], acch[d], 0, 0, 0); acch[d] = __builtin_amdgcn_mfma_f32_32x32x16_bf16(sf[1], vf[d][1], acch[d], 0, 0, 0); }
        const bf16_t* qrow = qt + (size_t)(bh * 32 + r) * 1024 + 4 * hf; const bf16_t* wkrow = wkT + (size_t)(bh * 1024 + r) * 32 + 8 * hf;
        f32x16 cn[2];
#pragma unroll
        for (int d = 0; d < 2; ++d)
#pragma unroll
            for (int i = 0; i < 16; ++i) cn[d][i] = __uint_as_float(__builtin_amdgcn_raw_buffer_load_b32(rC0, voff, SC_OFF(0, i, d), 2));
        for (int dkt = 0; dkt < 32; ++dkt) {
            f32x16 c[2] = {cn[0], cn[1]};
            if (dkt < 31) {
#pragma unroll
                for (int d = 0; d < 2; ++d)
#pragma unroll
                    for (int i = 0; i < 16; ++i) cn[d][i] = __uint_as_float(__builtin_amdgcn_raw_buffer_load_b32(rC0, voff, SC_OFF(dkt + 1, i, d), 2)); }
            bf16x8 pa[2], wa[2];
#pragma unroll
            for (int s = 0; s < 2; ++s) { const u32x2 lo = *(const u32x2*)(qrow + dkt * 32 + 16 * s), hi = *(const u32x2*)(qrow + dkt * 32 + 16 * s + 8);
                u32x4 t4; t4.x = lo.x; t4.y = lo.y; t4.z = hi.x; t4.w = hi.y; pa[s] = __builtin_bit_cast(bf16x8, t4);
                wa[s] = *(const bf16x8*)(wkrow + (size_t)dkt * 32 * 32 + 16 * s); }
#pragma unroll
            for (int d = 0; d < 2; ++d) {
#pragma unroll
                for (int s = 0; s < 2; ++s) { u32x4 xs; xs.x = pk_bf16(c[d][8 * s], c[d][8 * s + 1]); xs.y = pk_bf16(c[d][8 * s + 2], c[d][8 * s + 3]); xs.z = pk_bf16(c[d][8 * s + 4], c[d][8 * s + 5]); xs.w = pk_bf16(c[d][8 * s + 6], c[d][8 * s + 7]);
                    acch[d] = __builtin_amdgcn_mfma_f32_32x32x16_bf16(pa[s], __builtin_bit_cast(bf16x8, xs), acch[d], 0, 0, 0); }
#pragma unroll
                for (int i = 0; i < 16; ++i) c[d][i] *= sc;
                c[d] = __builtin_amdgcn_mfma_f32_32x32x16_bf16(wa[0], vf[d][0], c[d], 0, 0, 0); c[d] = __builtin_amdgcn_mfma_f32_32x32x16_bf16(wa[1], vf[d][1], c[d], 0, 0, 0);
#pragma unroll
                for (int i = 0; i < 16; ++i) __builtin_amdgcn_raw_buffer_store_b32(__float_as_uint(c[d][i]), rCn, voff, SC_OFF(dkt, i, d), 2); }
        }
#pragma unroll
        for (int d = 0; d < 2; ++d)
#pragma unroll
            for (int i = 0; i < 16; ++i) { const int t = (i & 3) + 8 * (i >> 2) + 4 * hf; hs[(size_t)(b * 32 + t) * INNER + h * 1024 + dvp * 64 + 32 * d + r] = f2bf(acch[d][i]); }
#undef SC_OFF
    }
}

DI void phase_predown(const Frame& F, const Params& p) {
    unsigned char* ws = p.ws;
    const bf16_t* __restrict__ hb = (const bf16_t*)(ws + WS_H); const bf16_t* __restrict__ hs = (const bf16_t*)(ws + WS_HS); const bf16_t* __restrict__ xa = (const bf16_t*)(ws + WS_XA); const bf16_t* __restrict__ sz = (const bf16_t*)(ws + WS_SZ);
    unsigned char* __restrict__ pre = ws + WS_PRE;
    const int gw = F.vcu * NWAVES + F.wave, NGW = F.G * NWAVES;
    if ((NGW & 7) != 0) return;
    const int h = gw & 7, cc0 = h * 1024 + 8 * F.lane;
    f32x4 gk[2][4];
#pragma unroll
    for (int j = 0; j < 2; ++j) { gk[j][0] = *(const f32x4*)(p.mh_gain + cc0 + 512 * j); gk[j][1] = *(const f32x4*)(p.mh_gain + cc0 + 512 * j + 4); gk[j][2] = *(const f32x4*)(p.skip + cc0 + 512 * j); gk[j][3] = *(const f32x4*)(p.skip + cc0 + 512 * j + 4); }
    u32x4 nh[2], na[2], nz[2];
#define PD_LOAD(item_) do { const int tok_ = (item_) >> 3; const bf16_t* hrow_ = tok_ < TP ? hb + (size_t)tok_ * INNER + cc0 : hs + (size_t)(tok_ - TP) * INNER + cc0; \
        _Pragma("unroll") for (int j = 0; j < 2; ++j) { nh[j] = ld_nt((const u32x4*)(hrow_ + 512 * j)); na[j] = ld_nt((const u32x4*)(xa + (size_t)tok_ * INNER + cc0 + 512 * j)); nz[j] = ld_nt((const u32x4*)(sz + (size_t)tok_ * INNER + cc0 + 512 * j)); } } while (0)
    if (gw < TT * NH) PD_LOAD(gw);
    for (int item = gw; item < TT * NH; item += NGW) {
        const int tok = item >> 3;
        u32x4 ch[2] = {nh[0], nh[1]}, ca[2] = {na[0], na[1]}, cz[2] = {nz[0], nz[1]};
        if (item + NGW < TT * NH) PD_LOAD(item + NGW);
        float v[2][8]; float s = 0.f;
#pragma unroll
        for (int j = 0; j < 2; ++j) { unpack8(ch[j], v[j]);
#pragma unroll
            for (int i = 0; i < 8; ++i) s += v[j][i]; }
        const float mean = wave_sum(s) * (1.0f / 1024.0f); float s2 = 0.f;
#pragma unroll
        for (int j = 0; j < 2; ++j)
#pragma unroll
            for (int i = 0; i < 8; ++i) { v[j][i] -= mean; s2 += v[j][i] * v[j][i]; }
        const float rstd = 1.0f / sqrtf(wave_sum(s2) * (1.0f / 1024.0f) + LN_EPS);
#pragma unroll
        for (int j = 0; j < 2; ++j) { float a[8], z[8], o[8]; unpack8(ca[j], a); unpack8(cz[j], z);
#pragma unroll
            for (int i = 0; i < 4; ++i) { o[i] = (v[j][i] * rstd * gk[j][0][i] + gk[j][2][i] * a[i]) * z[i]; o[4 + i] = (v[j][4 + i] * rstd * gk[j][1][i] + gk[j][3][i] * a[4 + i]) * z[4 + i]; }
            u32x2 w8; w8.x = pk_fp8x4(o[0] * FP8_SA_PRE, o[1] * FP8_SA_PRE, o[2] * FP8_SA_PRE, o[3] * FP8_SA_PRE); w8.y = pk_fp8x4(o[4] * FP8_SA_PRE, o[5] * FP8_SA_PRE, o[6] * FP8_SA_PRE, o[7] * FP8_SA_PRE);
            *(u32x2*)(pre + (size_t)tok * INNER + cc0 + 512 * j) = w8; }
    }
#undef PD_LOAD
}

DI void ln_rows(const Frame& F, const bf16_t* src, const float* rstat, const float* part, const float* g, const float* bta, float* dstA, float* dstB, bf16_t* dstb, unsigned char* dstq, float* lnst) {
    const int gw = F.vcu * NWAVES + F.wave, NGW = F.G * NWAVES;
    LAS f32x4* gl = (LAS f32x4*)F.lds; LAS f32x4* bl = gl + DM / 4;
    __syncthreads();
    for (int i = F.tid; i < DM / 4; i += NTHR) { gl[i] = *(const f32x4*)(g + 4 * i); bl[i] = *(const f32x4*)(bta + 4 * i); }
    __syncthreads();
    constexpr int TV = TP + 4 * TS;
    for (int vr = gw + ((TV - 1 - gw) / NGW) * NGW; vr >= 0; vr -= NGW) {
        int row = vr;
        if (vr >= TP) { if ((vr - TP) & 3) continue; row = TP + ((vr - TP) >> 2); }
        f32x4 v[16]; float mean, rstd;
        if (row < TP) { const u32x2* xr = (const u32x2*)(src + (size_t)row * DM) + F.lane;
#pragma unroll
            for (int j = 0; j < 16; ++j) { const u32x2 w = xr[64 * j]; v[j] = (f32x4){bf_lo(w.x), bf_hi(w.x), bf_lo(w.y), bf_hi(w.y)}; }
            mean = rstat[(size_t)row * 2] * (1.0f / DM); rstd = 1.0f / sqrtf(fmaxf(rstat[(size_t)row * 2 + 1] * (1.0f / DM) - mean * mean, 0.f) + LN_EPS);
#pragma unroll
            for (int j = 0; j < 16; ++j) v[j] = v[j] - mean;
        } else {
#pragma unroll
            for (int j = 0; j < 16; ++j) v[j] = (f32x4){0.f, 0.f, 0.f, 0.f};
#pragma unroll 1
            for (int sp = 0; sp < 8; ++sp) { const f32x4* xr = (const f32x4*)(part + ((size_t)sp * TS + (row - TP)) * DM) + F.lane; f32x4 t[16];
#pragma unroll
                for (int j = 0; j < 16; ++j) t[j] = xr[64 * j];
                __builtin_amdgcn_sched_barrier(0);
#pragma unroll
                for (int j = 0; j < 16; ++j) v[j] += t[j]; }
            float s = 0.f;
#pragma unroll
            for (int j = 0; j < 16; ++j) s += (v[j][0] + v[j][1]) + (v[j][2] + v[j][3]);
            mean = wave_sum(s) * (1.0f / DM); float s2 = 0.f;
#pragma unroll
            for (int j = 0; j < 16; ++j) { v[j] = v[j] - mean; s2 += (v[j][0] * v[j][0] + v[j][1] * v[j][1]) + (v[j][2] * v[j][2] + v[j][3] * v[j][3]); }
            rstd = 1.0f / sqrtf(wave_sum(s2) * (1.0f / DM) + LN_EPS); }
        float* drow = row < TP ? (dstA ? dstA + (size_t)row * DM : nullptr) : dstB + (size_t)(row - TP) * DM;
        if (lnst && row < TP && F.lane == 0) { lnst[(size_t)row * 2] = mean; lnst[(size_t)row * 2 + 1] = rstd; }
        const bool wb = dstb && (row >= TP || ((row >> 8) & 15) == 15);
#pragma unroll
        for (int j = 0; j < 16; ++j) { const int cc = 4 * F.lane + 256 * j; const f32x4 gg = gl[F.lane + 64 * j], bb = bl[F.lane + 64 * j]; const f32x4 o = v[j] * rstd * gg + bb;
            if (drow) { if (dstq) *(f32x4*)(drow + cc) = o; else st_nt((f32x4*)(drow + cc), o); }
            if (wb) { u32x2 w; w.x = pk_bf16(o[0], o[1]); w.y = pk_bf16(o[2], o[3]); *(u32x2*)(dstb + (size_t)row * DM + cc) = w; }
            if (dstq) {
                *(unsigned*)(dstq + (size_t)row * DM + cc) = pk_fp8x4(o[0] * FP8_SA_X1, o[1] * FP8_SA_X1, o[2] * FP8_SA_X1, o[3] * FP8_SA_X1); } }
    }
}

DI void phase_conv31(const Frame& F, const Params& p) {
    unsigned char* ws = p.ws;
    const bf16_t* ub = (const bf16_t*)(ws + WS_U); bf16_t* cb = (bf16_t*)(ws + WS_C); float* stats = (float*)(ws + WS_STATS);
    LAS bf16_t* T = (LAS bf16_t*)F.lds;
    float w[31][2]; float2 bv = make_float2(0.f, 0.f); bool wloaded = false; int wcq = -1;
    for (int it = F.vcu; it < (TT / 32) * 4; it += F.G) { const int item = (TT / 32) * 4 - 1 - it;
        const int tt = item >> 2, cq = item & 3, cbase = cq * 1024, ch = cbase + 2 * F.tid, tok0 = tt * 32;
        const bool samp = tok0 >= TP; const int t0 = samp ? 0 : (tok0 & 4095), bsm = samp ? ((tok0 - TP) >> 5) : 0;
        __syncthreads();
#pragma unroll
        for (int k0 = 0; k0 < 16; k0 += 8) { u32x4 v[8];
#pragma unroll
            for (int k = 0; k < 8; ++k) { const int i = F.tid + (k0 + k) * NTHR, row = i >> 7, c8 = (i & 127) * 8; v[k] = (u32x4){0u, 0u, 0u, 0u};
                if (row < 62 && (row >= 30 || t0 > 0)) v[k] = *(const u32x4*)(ub + (size_t)(tok0 - 30 + row) * DM + cbase + c8); }
            __builtin_amdgcn_sched_barrier(0);
#pragma unroll
            for (int k = 0; k < 8; ++k) { const int i = F.tid + (k0 + k) * NTHR, row = i >> 7, c8 = (i & 127) * 8;
                if (row < 62) *(LAS u32x4*)(T + row * 1024 + c8) = v[k]; } }
        if (samp)
            for (int i = F.tid; i < 30 * 128; i += NTHR) { const int row = i >> 7, c8 = (i & 127) * 8; u32x4 v;
                const float* hp = p.st_cconv + (size_t)(bsm * 30 + row) * DM + cbase + c8; const f32x4 h0 = *(const f32x4*)hp, h1 = *(const f32x4*)(hp + 4);
                v.x = pk_bf16(h0[0], h0[1]); v.y = pk_bf16(h0[2], h0[3]); v.z = pk_bf16(h1[0], h1[1]); v.w = pk_bf16(h1[2], h1[3]);
                *(LAS u32x4*)(T + row * 1024 + c8) = v; }
        __syncthreads();
        if (!wloaded || cq != wcq) { wloaded = true; wcq = cq;
#pragma unroll
            for (int j = 0; j < 31; ++j) { const float2 wv = *(const float2*)(p.w_dw + (size_t)j * DM + ch); w[j][0] = wv.x; w[j][1] = wv.y; }
            bv = *(const float2*)(p.b_dw + ch); }
        float sv[64];
#pragma unroll
        for (int tq = 0; tq < 4; ++tq) {
            float x[38][2];
#pragma unroll
            for (int i = 0; i < 38; ++i) { const unsigned raw = *(const LAS unsigned*)(T + (8 * tq + i) * 1024 + 2 * F.tid); x[i][0] = bf_lo(raw); x[i][1] = bf_hi(raw); }
#pragma unroll
            for (int o = 0; o < 8; ++o) { float a0 = bv.x, a1 = bv.y;
#pragma unroll
                for (int j = 0; j < 31; ++j) { a0 += w[j][0] * x[o + j][0]; a1 += w[j][1] * x[o + j][1]; }
                const int tok = tok0 + 8 * tq + o;
                *(unsigned*)(cb + (size_t)tok * DM + ch) = pk_bf16(a0, a1);
                sv[8 * tq + o] = a0 + a1; sv[32 + 8 * tq + o] = a0 * a0 + a1 * a1; }
        }
#pragma unroll
        for (int st = 0; st < 6; ++st) { const int off = 32 >> st, n2 = 32 >> st; const bool up = (F.lane & off) != 0;
#pragma unroll
            for (int i = 0; i < n2; ++i) { const float keep = up ? sv[i + n2] : sv[i], send = up ? sv[i] : sv[i + n2]; sv[i] = keep + __shfl_xor(send, off); } }
        if (!F.dry) atomicAdd(stats + (size_t)(tok0 + (F.lane & 31)) * 2 + (F.lane >> 5), sv[0]);
    }
    __syncthreads();
    const size_t gt = (size_t)F.vcu * NTHR + F.tid, NT = (size_t)F.G * NTHR;
    for (size_t i = gt; i < (size_t)(4 + 16) * 30 * (DM / 8); i += NT) { const int c8 = (int)(i & 511) * 8, ri = (int)(i >> 9), sq = ri / 30, k = ri - sq * 30;
        size_t tok; float* dst;
        if (sq < 4) { tok = (size_t)sq * 4096 + 4066 + k; dst = p.out + O_PCC + (size_t)(sq * 30 + k) * DM + c8; }
        else { const int b = sq - 4; tok = (size_t)TP + b * 32 + 2 + k; dst = p.out + O_SCC + (size_t)(b * 30 + k) * DM + c8; }
        float f[8]; unpack8(*(const u32x4*)(ub + tok * DM + c8), f);
        *(f32x4*)dst = (f32x4){f[0], f[1], f[2], f[3]}; *(f32x4*)(dst + 4) = (f32x4){f[4], f[5], f[6], f[7]}; }
}

DI void phase_norm2(const Frame& F, const Params& p) {
    unsigned char* ws = p.ws;
    const bf16_t* __restrict__ cb = (const bf16_t*)(ws + WS_C); const bf16_t* __restrict__ szg = (const bf16_t*)(ws + WS_SZG); const float* __restrict__ stats = (const float*)(ws + WS_STATS);
    unsigned char* __restrict__ pre2 = ws + WS_PRE2;
    const size_t gt = (size_t)F.vcu * NTHR + F.tid, NT = (size_t)F.G * NTHR, NI = (size_t)TT * (DM / 8);
    if ((NT & 511) != 0) return;
    const int c8 = (int)(gt & 511) * 8;
    const f32x4 g0 = *(const f32x4*)(p.cln_g + c8), g1 = *(const f32x4*)(p.cln_g + c8 + 4), b0 = *(const f32x4*)(p.cln_b + c8), b1 = *(const f32x4*)(p.cln_b + c8 + 4);
    u32x4 ncc[4], ncz[4]; float ns1[4], ns2[4];
#pragma unroll
    for (int u = 0; u < 4; ++u) { ncc[u] = (u32x4){0u, 0u, 0u, 0u}; ncz[u] = (u32x4){0u, 0u, 0u, 0u}; ns1[u] = 0.f; ns2[u] = 0.f; }
#define N2_LOAD(i0_) do { _Pragma("unroll") for (int u = 0; u < 4; ++u) { const size_t i = (i0_) + (size_t)u * NT; if (i < NI) { const size_t tok_ = i >> 9; \
        ncc[u] = *(const u32x4*)(cb + tok_ * DM + c8); ncz[u] = *(const u32x4*)(szg + tok_ * DM + c8); ns1[u] = stats[tok_ * 2]; ns2[u] = stats[tok_ * 2 + 1]; } } } while (0)
    N2_LOAD(gt);
    u32x2 res[4]; size_t pi0 = NI;
#pragma unroll
    for (int u = 0; u < 4; ++u) res[u] = (u32x2){0u, 0u};
    for (size_t i0 = gt; ; i0 += 4 * NT) {
        u32x4 cc[4], cz[4]; float s1[4], s2[4];
#pragma unroll
        for (int u = 0; u < 4; ++u) { cc[u] = ncc[u]; cz[u] = ncz[u]; s1[u] = ns1[u]; s2[u] = ns2[u]; }
        if (pi0 < NI) {
#pragma unroll
            for (int u = 0; u < 4; ++u) { const size_t i = pi0 + (size_t)u * NT; if (i < NI) *(u32x2*)(pre2 + (i >> 9) * DM + c8) = res[u]; } }
        if (i0 >= NI) break;
        N2_LOAD(i0 + 4 * NT);
#pragma unroll
        for (int u = 0; u < 4; ++u) { const size_t i = i0 + (size_t)u * NT; if (i < NI) {
            const float mean = s1[u] * (1.0f / DM), var = fmaxf(s2[u] * (1.0f / DM) - mean * mean, 0.f), rstd = 1.0f / sqrtf(var + LN_EPS);
            float c[8], z[8], o[8]; unpack8(cc[u], c); unpack8(cz[u], z);
#pragma unroll
            for (int k = 0; k < 4; ++k) { o[k] = fsilu((c[k] - mean) * rstd * g0[k] + b0[k]) * z[k]; o[4 + k] = fsilu((c[4 + k] - mean) * rstd * g1[k] + b1[k]) * z[4 + k]; }
            u32x2 w8; w8.x = pk_fp8x4(o[0] * FP8_SA_PRE2, o[1] * FP8_SA_PRE2, o[2] * FP8_SA_PRE2, o[3] * FP8_SA_PRE2); w8.y = pk_fp8x4(o[4] * FP8_SA_PRE2, o[5] * FP8_SA_PRE2, o[6] * FP8_SA_PRE2, o[7] * FP8_SA_PRE2);
            res[u] = w8; } }
        pi0 = i0;
    }
#undef N2_LOAD
}

constexpr int N_PHASES = 16;
constexpr int LDS_BYTES = 147456;
constexpr int MISC_OFF = 131072;

__global__ void __launch_bounds__(NTHR, 2) mlstm_conformer_fwd(Params p) {
    extern __shared__ __attribute__((aligned(16))) unsigned char lds_raw[];
    Frame F; F.lds = (LAS unsigned char*)lds_raw; F.wave = __builtin_amdgcn_readfirstlane((int)threadIdx.x >> 6); F.lane = lane_id(); F.tid = F.wave * 64 + F.lane;
    F.G = gridDim.x; F.bx = blockIdx.x; F.vcu = (F.G % 8 == 0) ? (F.bx % 8) * (F.G / 8) + F.bx / 8 : F.bx;
    volatile LAS unsigned* MISC = (volatile LAS unsigned*)(F.lds + MISC_OFF);
    if (F.tid < 64) MISC[F.tid] = 0u;
    __syncthreads();
    unsigned char* ws = p.ws;
#if MK_LAUNCHES == 1
    XcdBarrier bar = xcd_barrier_post((unsigned*)(ws + WS_BAR), MISC + 8, F.wave);
#define GRID_BAR() xcd_barrier(bar)
#else
#define GRID_BAR() do { } while (0)
#endif
    const int lo = p.ph_lo, hi = p.ph_hi;
#ifndef PHMASK
#define PHMASK 0xFFFF
#endif
#define IN(k) (((PHMASK >> (k)) & 1) && lo <= (k) && (k) < hi)
#define SEAM(k) do { if (IN(k) && IN((k) + 1)) GRID_BAR(); } while (0)
    LAS unsigned char* ring = F.lds;

#ifndef P5PARTS
#define P5PARTS 7
#endif
#ifndef REPMASK
#define REPMASK 0
#endif
#define NREP(k) ((((REPMASK) >> (k)) & 1) + 1)
#define RUN(k, ...) do { if (IN(k)) { _Pragma("unroll") for (int rep = 0; rep < NREP(k); ++rep) { F.dry = rep; { int t_ = F.wave * 64 + lane_id(); asm volatile("" : "+v"(t_)); F.tid = t_; F.lane = t_ & 63; } __VA_ARGS__; if (rep + 1 < NREP(k)) GRID_BAR(); } } SEAM(k); } while (0)
    F.dry = 0;
    RUN(0, phase_prologue(F, p));
    RUN(1, {
        const bool side_first = ((F.bx & 7) & 1) != 0;
        if (side_first) { transpose_weight_fp8(F, p.w_down, INNER, DM, ws + WS_WDOWN, FP8_SB_W); __syncthreads(); }
        { g8::DenseSched S; S.init(ws + WS_XQ, ws + WS_WZQ, TT, INNER, DM, F.G, (F.G == 256) ? ((F.bx + 192) & 255) : F.bx); S.wave = F.wave;
          if (F.G == 256) { S.rag_r0 = 7; S.rag_w1 = 192; S.rag_w2 = 128; }
          EpiUp E{(bf16_t*)(ws + WS_SZ), 1, 1.0f / (FP8_SA_X * FP8_SB_WZ)};
          g8::gemm_phase<EpiUp, g8::DenseSched, false, true>(ring, DM, DM, S, E); }
        { g8::DenseSched S; S.init(ws + WS_XB, ws + WS_WUP, TT, INNER, DM * 2, F.G, F.bx); S.wave = F.wave;
          EpiUp E{(bf16_t*)(ws + WS_XM), 0, 1.0f};
          g8::gemm_phase<EpiUp, g8::DenseSched, false, false>(ring, DM * 2, DM * 2, S, E); }
        if (!side_first) transpose_weight_fp8(F, p.w_down, INNER, DM, ws + WS_WDOWN, FP8_SB_W); });
    RUN(2, phase_passA(F, p));
    RUN(3, { for (int it = F.vcu; it < 32; it += F.G) scan_prompt(F, p, it); });
    RUN(4, { for (int it = F.G - 1 - F.vcu; it < 128; it += F.G) sample_prep(F, p, it);
             phase_passB(F, p); });
    RUN(5, {
        const bool cell_first = ((F.bx & 7) & 1) != 0;
        if ((P5PARTS & 4) && cell_first) _Pragma("unroll") for (int r2 = 0; r2 < NREP(18); ++r2) phase_sample_cell(F, p);
        if (P5PARTS & 1) _Pragma("unroll") for (int r2 = 0; r2 < NREP(16); ++r2) {
          { SchedS S{(const char*)(ws + WS_QP), (const char*)(ws + WS_XA), F.G, F.vcu, 0, F.wave};
            EpiS E{(bf16_t*)(ws + WS_S), (const float*)(ws + WS_CS), (const float*)(ws + WS_MX), (float*)(ws + WS_DEN), F.dry | r2, 1.0f, 0};
            g8::gemm_phase<EpiS, SchedS, false, false>(ring, INNER * 2, INNER * 2, S, E); }
          { SchedS S{(const char*)p.out + O8_Q8, (const char*)p.out + O8_XA8, F.G, (F.G == 256) ? ((F.vcu + 32) & 255) : F.vcu, 1, F.wave};
            EpiS E{(bf16_t*)(ws + WS_S), (const float*)(ws + WS_CS), (const float*)(ws + WS_MX), (float*)(ws + WS_DEN), F.dry | r2, 1.0f, 1};
            g8::gemm_phase<EpiS, SchedS, false, true>(ring, INNER, INNER, S, E, 0x75757575  , 0x7b7b7b7b  ); } }
        if (P5PARTS & 2) _Pragma("unroll") for (int r2 = 0; r2 < NREP(17); ++r2) { SchedState S{(const char*)(ws + WS_KWT), (const char*)(ws + WS_VT), F.G, F.vcu, F.wave};
          EpiState E{p.out + O_PC};
          g8::gemm_phase<EpiState, SchedState, false>(ring, TPP * 2, TPP * 2, S, E); }
        if ((P5PARTS & 4) && !cell_first) _Pragma("unroll") for (int r2 = 0; r2 < NREP(18); ++r2) phase_sample_cell(F, p); });
    RUN(6, {
        SchedSV S{(const char*)(ws + WS_S8), (const char*)(ws + WS_S16), (const char*)(ws + WS_VT8), (const char*)(ws + WS_VT), F.G, F.vcu, F.wave};
        EpiSV E{(bf16_t*)(ws + WS_H), (const float*)(ws + WS_DEN), (const float*)(ws + WS_EM)};
        g8::gemm_phase_mixed<EpiSV, SchedSV>(ring, P8, TPP * 2, S, E, 0x7b7b7b7b  , 0x79797979  ); });
    RUN(7, phase_predown(F, p));
    RUN(8, {
        const bool side_first = ((F.bx & 7) & 1) != 0;
        if (side_first) { transpose_weight(F, p.w_cin, DM, 3 * DM, (bf16_t*)(ws + WS_WCIN), true, ws + WS_WCINQ, FP8_SB_WCIN); transpose_weight_fp8(F, p.w_cout, DM, DM, ws + WS_WCOUT, FP8_SB_W); __syncthreads(); }
        g8::DenseSched S; S.init(ws + WS_PRE, ws + WS_WDOWN, TT, DM, INNER, F.G, F.bx, TP / 256, 8); S.wave = F.wave;
        EpiRes E{p.x_prompt, p.x_sample, nullptr, (bf16_t*)(ws + WS_R), (float*)(ws + WS_PART), 1.0f / (FP8_SA_PRE * FP8_SB_W), (float*)(ws + WS_RST0), nullptr, nullptr, nullptr, nullptr};
        g8::gemm_phase<EpiRes, g8::DenseSched, false, true>(ring, INNER, INNER, S, E);
        if (!side_first) { transpose_weight(F, p.w_cin, DM, 3 * DM, (bf16_t*)(ws + WS_WCIN), true, ws + WS_WCINQ, FP8_SB_WCIN); transpose_weight_fp8(F, p.w_cout, DM, DM, ws + WS_WCOUT, FP8_SB_W); } });
    RUN(9, {
        ln_rows(F, (const bf16_t*)(ws + WS_R), (const float*)(ws + WS_RST0), (const float*)(ws + WS_PART), p.pln_g, p.pln_b, nullptr, (float*)(ws + WS_X1F), (bf16_t*)(ws + WS_X1B), ws + WS_X1Q, (float*)(ws + WS_LNST));
        });
    RUN(10, {
        { g8::DenseSched S; if (F.G == 256) S.init(ws + WS_X1B, ws + WS_WCIN, 6 * 256, 3 * DM, DM * 2, 144, F.bx < 144 ? F.bx : 100000); else S.init(ws + WS_X1B, ws + WS_WCIN, 6 * 256, 3 * DM, DM * 2, F.G, F.bx);
          S.wave = F.wave; S.pmode = 2;
          EpiCin E{(bf16_t*)(ws + WS_U), (bf16_t*)(ws + WS_SZG), p.b_cin, 1.0f};
          g8::gemm_phase<EpiCin, g8::DenseSched, false, false>(ring, DM * 2, DM * 2, S, E); }
        { g8::DenseSched S; S.init(ws + WS_X1Q, ws + WS_WCINQ, 60 * 256, 3 * DM, DM, F.G, (F.G == 256) ? ((F.bx + 112) & 255) : F.bx); S.wave = F.wave; S.pmode = 1;
          if (F.G == 256) { S.rag_r0 = 10; S.rag_w1 = 112; S.rag_w2 = 112; S.rag_w3 = 96; }
          EpiCin E{(bf16_t*)(ws + WS_U), (bf16_t*)(ws + WS_SZG), p.b_cin, 1.0f / (FP8_SA_X1 * FP8_SB_WCIN)};
          g8::gemm_phase<EpiCin, g8::DenseSched, false, true>(ring, DM, DM, S, E); } });
    RUN(11, phase_conv31(F, p));
    RUN(12, phase_norm2(F, p));
    RUN(13, {
        g8::DenseSched S; S.init(ws + WS_PRE2, ws + WS_WCOUT, TT, DM, DM, F.G, F.bx, TP / 256, 8); S.wave = F.wave;
        EpiRes E{nullptr, (const float*)(ws + WS_X1F), p.b_cout, (bf16_t*)(ws + WS_R2), (float*)(ws + WS_PART), 1.0f / (FP8_SA_PRE2 * FP8_SB_W), (float*)(ws + WS_RST1), (const bf16_t*)(ws + WS_R), (const float*)(ws + WS_LNST), p.pln_g, p.pln_b};
        g8::gemm_phase<EpiRes, g8::DenseSched, false, true>(ring, DM, DM, S, E); });
    RUN(14, ln_rows(F, (const bf16_t*)(ws + WS_R2), (const float*)(ws + WS_RST1), (const float*)(ws + WS_PART), p.pln_g + DM, p.pln_b + DM, p.out + O_YP, p.out + O_YS, nullptr, nullptr, nullptr));
#undef RUN
#undef NREP
#undef IN
#undef SEAM
}

extern "C" void kernel_launch(void* const* d_in, const int* in_sizes, int n_in, void* d_out, int out_size, void* d_ws, size_t ws_size, hipStream_t stream) {
    static int grid = 0;
    if (grid == 0) {
        if (n_in != 28 || (size_t)out_size != O_END || ws_size < WS_END) { fprintf(stderr, "kernel_launch: unexpected shapes (n_in %d, out %d, ws %zu); nothing launched\n", n_in, out_size, ws_size); grid = -1; return; }
        int dev = 0, cus = 0;
        if (hipGetDevice(&dev) != hipSuccess || hipDeviceGetAttribute(&cus, hipDeviceAttributeMultiprocessorCount, dev) != hipSuccess) { grid = -1; return; }
        if (hipFuncSetAttribute((const void*)mlstm_conformer_fwd, hipFuncAttributeMaxDynamicSharedMemorySize, LDS_BYTES) != hipSuccess) { fprintf(stderr, "kernel_launch: hipFuncSetAttribute failed\n"); grid = -1; return; }
        int per_cu = 0;
        if (hipOccupancyMaxActiveBlocksPerMultiprocessor(&per_cu, (const void*)mlstm_conformer_fwd, NTHR, LDS_BYTES) != hipSuccess || per_cu < 1) { fprintf(stderr, "kernel_launch: occupancy query says %d\n", per_cu); }
        (void)hipGetLastError();
        grid = cus;
    }
    if (grid < 0) return;
    (void)hipMemsetAsync((char*)d_ws, 0, WS_GATES, stream);
    Params p{};
    const float** pf = (const float**)&p;
    for (int i = 0; i < 28; ++i) pf[i] = (const float*)d_in[i];
    p.out = (float*)d_out; p.ws = (unsigned char*)d_ws;
#if MK_LAUNCHES == 1
    p.ph_lo = 0; p.ph_hi = N_PHASES;
    hipLaunchKernelGGL(mlstm_conformer_fwd, dim3(grid), dim3(NTHR), LDS_BYTES, stream, p);
#else
    for (int k = 0; k < 15; ++k) { p.ph_lo = k; p.ph_hi = k + 1; hipLaunchKernelGGL(mlstm_conformer_fwd, dim3(grid), dim3(NTHR), LDS_BYTES, stream, p); }
#endif
}
```
